# Optimizing an MI355X kernel written in HIP

```python
import jax, jax.numpy as jnp
from jax import lax
import numpy as np

D_MODEL = 1024
BATCH = 2
SEQ = 8192
DEPTH = 2
DEC_BATCH = 128
DEC_SEQ = 8
PAST_LEN = 2048
PAGE_SIZE = 128

N_A = DEPTH // 2
N_B = DEPTH - N_A
D_CONV = D_MODEL
CONV_W = 3
N_HEADS = 16
HEAD_DIM = D_MODEL // N_HEADS
N_KV_HEADS = 4
GROUP = N_HEADS // N_KV_HEADS
CMP_BLK = 32
CMP_STRIDE = 16
CMP_RATIO = CMP_BLK // CMP_STRIDE
CMP_HID = HEAD_DIM
SEL_BLK = 64
TOP_N = 16
WINDOW = 512
Q_BLK = 64
D_FF = ((8 * D_MODEL // 3 + 255) // 256) * 256
RMS_EPS = 1e-6
BIG = 1e9
NEG = -1e30

kernel_name = 'yoco_shortconv_nsa_decode_step'


def rmsnorm(x, w):
    xf = x.astype(jnp.float32)
    y = xf * lax.rsqrt(jnp.mean(xf * xf, axis=-1, keepdims=True) + RMS_EPS)
    return (y * w.astype(jnp.float32)).astype(x.dtype)


def swiglu(x, w_in, w_out):
    g, u = jnp.split(x @ w_in, 2, axis=-1)
    return (jax.nn.silu(g) * u) @ w_out


def short_conv_mixer(xn, w_in, conv_w, w_out, prefix):
    b, c, u = jnp.split(xn @ w_in, 3, axis=-1)
    v = c * u
    vp = jnp.concatenate([prefix.astype(v.dtype), v], axis=1)
    T = v.shape[1]
    conv = conv_w[0] * vp[:, 0:T]
    for j in range(1, CONV_W):
        conv = conv + conv_w[j] * vp[:, j:j + T]
    return (b * conv) @ w_out, vp[:, -(CONV_W - 1):]


def masked_softmax(s, mask):
    s = jnp.where(mask, s, NEG)
    m = jnp.max(s, axis=-1, keepdims=True)
    e = jnp.where(mask, jnp.exp(s - m), 0.0)
    return e / jnp.maximum(jnp.sum(e, axis=-1, keepdims=True), 1e-30)


def shared_kv(h, kv_norm_w, kv_w):
    N, T, _ = h.shape
    return (rmsnorm(h, kv_norm_w) @ kv_w).reshape(N, T, 3, 2, N_KV_HEADS, HEAD_DIM)


def compress(kv, cmp_pe, cmp_w1, cmp_w2):
    N, L = kv.shape[:2]
    kv = jnp.pad(kv, ((0, 0), (0, (-L) % CMP_STRIDE), (0, 0), (0, 0), (0, 0)))
    C = kv.shape[1] // CMP_STRIDE
    NC = C - CMP_RATIO + 1
    chunks = kv.reshape(N, C, CMP_STRIDE, 2, N_KV_HEADS, HEAD_DIM)
    w1 = cmp_w1.reshape(2, CMP_RATIO, CMP_STRIDE, HEAD_DIM, CMP_HID)
    part = jnp.einsum('ncjkgd,krjdh->rnckgh', chunks, w1)
    pre = part[0, :, 0:NC]
    for r in range(1, CMP_RATIO):
        pre = pre + part[r, :, r:r + NC]
    pe_bias = jnp.einsum('kjd,kjdh->kh', cmp_pe, cmp_w1)
    hid = jax.nn.silu(pre + pe_bias[:, None, :])
    out = jnp.einsum('nckgh,khe->nckge', hid, cmp_w2)
    ends = jnp.arange(NC) * CMP_STRIDE + CMP_BLK - 1
    return out, ends


def sel_blocks(kv):
    N, L = kv.shape[:2]
    kv = jnp.pad(kv, ((0, 0), (0, (-L) % SEL_BLK), (0, 0), (0, 0), (0, 0)))
    kv = kv.reshape(N, -1, SEL_BLK, 2, N_KV_HEADS, HEAD_DIM)
    return jnp.moveaxis(kv, 4, 1)


def query_side(xn, w_in):
    N, T, _ = xn.shape
    proj = xn @ w_in
    q = proj[..., :N_HEADS * HEAD_DIM].reshape(N, T, N_KV_HEADS, GROUP, HEAD_DIM) * (HEAD_DIM ** -0.5)
    g = jax.nn.sigmoid(proj[..., N_HEADS * HEAD_DIM:].astype(jnp.float32)).astype(xn.dtype)
    return q, g.reshape(N, T, N_KV_HEADS, GROUP, 3)


def nsa_block(q, g, q_pos, kvc, cmp_end, kvs, kvw, kw_pos):
    N, T = q.shape[:2]
    s_c = jnp.einsum('ntgrd,ncgd->ntgrc', q, kvc[:, :, 0]).astype(jnp.float32)
    mask_c = (cmp_end[None, :] <= q_pos[:, None])[None, :, None, None, :]
    p_c = masked_softmax(s_c, mask_c)
    o_c = jnp.einsum('ntgrc,ncgd->ntgrd', p_c.astype(kvc.dtype), kvc[:, :, 1])
    NC = kvc.shape[1]
    NSEL = kvs.shape[2]
    c_start = jnp.arange(NC) * CMP_STRIDE
    s_start = jnp.arange(NSEL) * SEL_BLK
    overlap = jnp.clip(jnp.minimum(c_start[:, None] + CMP_BLK, s_start[None, :] + SEL_BLK)
                       - jnp.maximum(c_start[:, None], s_start[None, :]), 0, None)
    agg = overlap.astype(jnp.float32) / CMP_STRIDE
    imp = jnp.einsum('ntgrc,cj->ntgj', p_c, agg)
    valid = s_start[None, :] <= q_pos[:, None]
    cur = (q_pos // SEL_BLK)[:, None]
    j = jnp.arange(NSEL)[None, :]
    forced = (j == 0) | (j == cur) | (j == cur - 1)
    score = jnp.where((valid & forced)[None, :, None, :], BIG,
                      jnp.where(valid[None, :, None, :], imp, -BIG))
    _, idx = lax.top_k(score, min(TOP_N, NSEL))
    K = idx.shape[-1]
    n_ix = jnp.arange(N)[:, None, None, None]
    g_ix = jnp.arange(N_KV_HEADS)[None, None, :, None]
    sel = kvs[n_ix, g_ix, idx]
    sel = sel.reshape(N, T, N_KV_HEADS, K * SEL_BLK, 2, HEAD_DIM)
    tok = (idx[..., None] * SEL_BLK + jnp.arange(SEL_BLK)).reshape(N, T, N_KV_HEADS, K * SEL_BLK)
    mask_s = (tok <= q_pos[None, :, None, None])[:, :, :, None, :]
    s_s = jnp.einsum('ntgrd,ntgkd->ntgrk', q, sel[..., 0, :]).astype(jnp.float32)
    p_s = masked_softmax(s_s, mask_s)
    o_s = jnp.einsum('ntgrk,ntgkd->ntgrd', p_s.astype(sel.dtype), sel[..., 1, :])
    s_w = jnp.einsum('ntgrd,nkgd->ntgrk', q, kvw[:, :, 0]).astype(jnp.float32)
    mask_w = ((kw_pos[None, :] <= q_pos[:, None]) & (kw_pos[None, :] >= q_pos[:, None] - WINDOW)
              & (kw_pos[None, :] >= 0))[None, :, None, None, :]
    p_w = masked_softmax(s_w, mask_w)
    o_w = jnp.einsum('ntgrk,nkgd->ntgrd', p_w.astype(kvw.dtype), kvw[:, :, 1])
    return g[..., 0:1] * o_c + g[..., 1:2] * o_s + g[..., 2:3] * o_w


def nsa_prompt(xn, w_in, w_out, ctx):
    kvc, cmp_end, kvs, kvw = ctx
    N, T, _ = xn.shape
    q, g = query_side(xn, w_in)
    nb = T // Q_BLK
    kvw_pad = jnp.pad(kvw, ((0, 0), (WINDOW, 0), (0, 0), (0, 0), (0, 0)))

    def block(args):
        qb, gb, start = args
        q_pos = start + jnp.arange(Q_BLK)
        kw = lax.dynamic_slice_in_dim(kvw_pad, start, WINDOW + Q_BLK, axis=1)
        kw_pos = start - WINDOW + jnp.arange(WINDOW + Q_BLK)
        return nsa_block(qb, gb, q_pos, kvc, cmp_end, kvs, kw, kw_pos)

    def to_blocks(a):
        return a.reshape(N, nb, Q_BLK, *a.shape[2:]).swapaxes(0, 1)

    o = lax.map(block, (to_blocks(q), to_blocks(g), jnp.arange(nb) * Q_BLK))
    o = o.swapaxes(0, 1).reshape(N, T, N_HEADS * HEAD_DIM)
    return o @ w_out


def nsa_sample(xn, w_in, w_out, ctx):
    kvc, cmp_end, kvs, kvw, kw_pos = ctx
    N, T, _ = xn.shape
    q, g = query_side(xn, w_in)

    def step(args):
        qt, gt, pos = args
        return nsa_block(qt[:, None], gt[:, None], pos[None], kvc, cmp_end, kvs, kvw, kw_pos)[:, 0]

    o = lax.map(step, (q.swapaxes(0, 1), g.swapaxes(0, 1), PAST_LEN + jnp.arange(T)))
    o = o.swapaxes(0, 1).reshape(N, T, N_HEADS * HEAD_DIM)
    return o @ w_out


def prompt_kv_side(h, kv_norm_w, kv_w, cmp_pe, cmp_w1, cmp_w2):
    kv = shared_kv(h, kv_norm_w, kv_w)
    kvc, ends = compress(kv[:, :, 0], cmp_pe, cmp_w1, cmp_w2)
    kvs = sel_blocks(kv[:, :, 1])
    kvw = kv[:, :, 2]
    keep = min(WINDOW, h.shape[1])
    return (kvc, ends, kvs, kvw), (kv[:, :, 0], kv[:, :, 1], kvw[:, -keep:])


def sample_kv_side(h, cache_cmp_kv, cache_slc_kv, state_win_kv, page_table, kv_norm_w, kv_w, cmp_pe, cmp_w1, cmp_w2):
    N, T, _ = h.shape
    kv = shared_kv(h, kv_norm_w, kv_w)

    def past(pool):
        return pool[page_table].reshape(N, -1, 2, N_KV_HEADS, HEAD_DIM)

    full_cmp = jnp.concatenate([past(cache_cmp_kv), kv[:, :, 0]], axis=1)
    full_slc = jnp.concatenate([past(cache_slc_kv), kv[:, :, 1]], axis=1)
    kvc, ends = compress(full_cmp, cmp_pe, cmp_w1, cmp_w2)
    kvs = sel_blocks(full_slc)
    win = jnp.concatenate([state_win_kv, kv[:, :, 2]], axis=1)
    w_len = state_win_kv.shape[1]
    kw_pos = PAST_LEN - w_len + jnp.arange(w_len + T)
    keep = min(WINDOW, PAST_LEN + T)
    return (kvc, ends, kvs, win, kw_pos), (kv[:, :, 0], kv[:, :, 1], win[:, -keep:])


def trunk(x, conv_prefix, kv_side, nsa_mixer, norm_w, final_norm_w, a_in_w, a_conv_w, a_out_w,
          b_in_w, b_out_w, ffn_in_w, ffn_out_w):
    h = x
    conv_states = []
    ctx, kv_rows = None, None
    for l in range(DEPTH):
        xn = rmsnorm(h, norm_w[l, 0])
        if l < N_A:
            y, st = short_conv_mixer(xn, a_in_w[l], a_conv_w[l], a_out_w[l], conv_prefix[l])
            conv_states.append(st)
        else:
            if l == N_A:
                ctx, kv_rows = kv_side(h)
            y = nsa_mixer(xn, b_in_w[l - N_A], b_out_w[l - N_A], ctx)
        h = h + y
        h = h + swiglu(rmsnorm(h, norm_w[l, 1]), ffn_in_w[l], ffn_out_w[l])
    return rmsnorm(h, final_norm_w), jnp.stack(conv_states), kv_rows


def setup_inputs(seed: int = 0) -> dict:
    key = jax.random.key(seed)
    ks = jax.random.split(key, 24)
    f32 = jnp.float32

    def nrm(k, shape, scale):
        return jax.random.normal(k, shape, f32) * scale

    n_pages = PAST_LEN // PAGE_SIZE
    n_used = DEC_BATCH * n_pages
    n_pool = n_used + max(1, n_used // 4)
    page_table = jax.random.permutation(ks[0], n_pool)[:n_used].reshape(DEC_BATCH, n_pages).astype(jnp.int32)
    kv_row = (2, N_KV_HEADS, HEAD_DIM)
    qg = N_HEADS * HEAD_DIM + 3 * N_HEADS
    return {
        'x_prompt': nrm(ks[1], (BATCH, SEQ, D_MODEL), 1.0),
        'x_sample': nrm(ks[2], (DEC_BATCH, DEC_SEQ, D_MODEL), 1.0),
        'cache_cmp_kv': nrm(ks[3], (n_pool, PAGE_SIZE) + kv_row, 1.0),
        'cache_slc_kv': nrm(ks[4], (n_pool, PAGE_SIZE) + kv_row, 1.0),
        'state_win_kv': nrm(ks[5], (DEC_BATCH, min(WINDOW, PAST_LEN)) + kv_row, 1.0),
        'state_conv': nrm(ks[6], (N_A, DEC_BATCH, CONV_W - 1, D_CONV), 1.0),
        'page_table': page_table,
        'norm_w': 1.0 + nrm(ks[7], (DEPTH, 2, D_MODEL), 0.02),
        'final_norm_w': 1.0 + nrm(ks[8], (D_MODEL,), 0.02),
        'a_in_w': nrm(ks[9], (N_A, D_MODEL, 3 * D_CONV), D_MODEL ** -0.5),
        'a_conv_w': nrm(ks[10], (N_A, CONV_W, D_CONV), CONV_W ** -0.5),
        'a_out_w': nrm(ks[11], (N_A, D_CONV, D_MODEL), D_CONV ** -0.5),
        'b_in_w': nrm(ks[12], (N_B, D_MODEL, qg), D_MODEL ** -0.5),
        'b_out_w': nrm(ks[13], (N_B, N_HEADS * HEAD_DIM, D_MODEL), (N_HEADS * HEAD_DIM) ** -0.5),
        'kv_norm_w': 1.0 + nrm(ks[14], (D_MODEL,), 0.02),
        'kv_w': nrm(ks[15], (D_MODEL, 3 * 2 * N_KV_HEADS * HEAD_DIM), D_MODEL ** -0.5),
        'cmp_pe': nrm(ks[16], (2, CMP_BLK, HEAD_DIM), 0.1),
        'cmp_w1': nrm(ks[17], (2, CMP_BLK, HEAD_DIM, CMP_HID), (CMP_BLK * HEAD_DIM) ** -0.5),
        'cmp_w2': nrm(ks[18], (2, CMP_HID, HEAD_DIM), CMP_HID ** -0.5),
        'ffn_in_w': nrm(ks[19], (DEPTH, D_MODEL, 2 * D_FF), D_MODEL ** -0.5),
        'ffn_out_w': nrm(ks[20], (DEPTH, D_FF, D_MODEL), D_FF ** -0.5),
    }


def reference(x_prompt, x_sample, cache_cmp_kv, cache_slc_kv, state_win_kv, state_conv, page_table,
              norm_w, final_norm_w, a_in_w, a_conv_w, a_out_w, b_in_w, b_out_w, kv_norm_w, kv_w,
              cmp_pe, cmp_w1, cmp_w2, ffn_in_w, ffn_out_w):
    conv_zero = jnp.zeros((N_A, x_prompt.shape[0], CONV_W - 1, D_CONV), x_prompt.dtype)
    y_prompt, conv_p, kv_rows_p = trunk(
        x_prompt, conv_zero,
        lambda h: prompt_kv_side(h, kv_norm_w, kv_w, cmp_pe, cmp_w1, cmp_w2),
        nsa_prompt, norm_w, final_norm_w, a_in_w, a_conv_w, a_out_w, b_in_w, b_out_w, ffn_in_w, ffn_out_w)
    y_sample, conv_s, kv_rows_s = trunk(
        x_sample, state_conv,
        lambda h: sample_kv_side(h, cache_cmp_kv, cache_slc_kv, state_win_kv, page_table,
                                 kv_norm_w, kv_w, cmp_pe, cmp_w1, cmp_w2),
        nsa_sample, norm_w, final_norm_w, a_in_w, a_conv_w, a_out_w, b_in_w, b_out_w, ffn_in_w, ffn_out_w)
    cmp_p, slc_p, win_p = kv_rows_p
    cmp_s, slc_s, win_s = kv_rows_s
    return (y_prompt, y_sample, conv_p, conv_s, cmp_p, cmp_s, slc_p, slc_s, win_p, win_s)
```

```cpp
#include <hip/hip_runtime.h>
#include <cstdio>
#include <cstdint>
namespace pg8 {
#define PG8_LAS __attribute__((address_space(3)))
typedef unsigned short bf16_t;
typedef short bf16x8 __attribute__((ext_vector_type(8)));
typedef float f32x4 __attribute__((ext_vector_type(4)));
typedef unsigned u32x4 __attribute__((ext_vector_type(4)));
constexpr int BM = 256, BK = 64, HALF = 128, HTB = HALF * BK * 2  , STAGE_BYTES = 8 * HTB, NXCD = 8, WGM = 8;

__host__ __device__ __forceinline__ int lds_byte(int r, int c) { const int st = (r >> 4) * 2 + (c >> 5), rr = r & 15, cc = c & 31, ob = rr * 64 + cc * 2; return st * 1024 + (ob ^ (((ob >> 9) & 1) << 5)); }
__host__ __device__ __forceinline__ void stage_rc(int b, int& R, int& C) { const int st = b / 1024, sb = b % 1024, swz = sb ^ (((sb >> 9) & 1) << 5); R = (st >> 1) * 16 + swz / 64; C = (st & 1) * 32 + (swz % 64) / 2; }
__host__ __device__ __forceinline__ int perm32(int rho) { const int n = rho >> 4, i = rho & 15; return 8 * (i >> 2) + 4 * n + (i & 3); }

struct Unit { int pm, pn; };
struct Gemm { const bf16_t* A; const bf16_t* Bt; int M, N, K; };

struct StaticOrder {
    int nM, nN, nwg, G, c;
    __host__ __device__ void init(int M, int N, int G_, int c_) { nM = M / BM; nN = N / BM; nwg = nM * nN; G = G_; c = c_; }
    __host__ __device__ bool next(int i, Unit& u) const {
        const long L = (long)i * G + c; if (L >= nwg) return false;
        int wgid = (int)L; { const int q = nwg / NXCD, r = nwg % NXCD, xcd = wgid % NXCD, off = wgid / NXCD; wgid = (xcd < r ? xcd * (q + 1) : r * (q + 1) + (xcd - r) * q) + off; }
        const int nig = WGM * nN, gid = wgid / nig, fm = gid * WGM, gsz = (nM - fm) < WGM ? (nM - fm) : WGM;
        u.pm = fm + ((wgid % nig) % gsz); u.pn = (wgid % nig) / gsz; return true;
    }
    __device__ __forceinline__ void a_ready(const Unit&) const {}
    __device__ __forceinline__ void done(const Unit&) const {}
};

__device__ __forceinline__ unsigned cvt_pk_bf16(float lo, float hi) { unsigned r; asm volatile("v_cvt_pk_bf16_f32 %0, %1, %2" : "=v"(r) : "v"(lo), "v"(hi)); return r; }
constexpr int E_MP = 16384;
constexpr float E_EPS = 1e-6f;
__device__ __forceinline__ float row_rstd16(const float* ssqp, int row, int fq) {
    const f32x4 p = *(const f32x4*)(ssqp + (size_t)row * 16 + fq * 4);
    float s = (p[0] + p[1]) + (p[2] + p[3]); s += __shfl_xor(s, 16); s += __shfl_xor(s, 32);
    return __builtin_amdgcn_rsqf(s * (1.0f / 1024.0f) + E_EPS);
}
__device__ __forceinline__ u32x4 pack8(const f32x4 a, const f32x4 b) { u32x4 w; w.x = cvt_pk_bf16(a[0], a[1]); w.y = cvt_pk_bf16(a[2], a[3]); w.z = cvt_pk_bf16(b[0], b[1]); w.w = cvt_pk_bf16(b[2], b[3]); return w; }

struct EpiAin {
    static constexpr bool PERM = true, AFTER_DRAIN = false;
    bf16_t* VB; bf16_t* BB; const float* rstd;
    __device__ __forceinline__ void operator()(const f32x4 (&acc)[2][2][4][2], const Unit& u, int wr, int wc, int fr, int fq) const {
        const int row0 = u.pm * BM + wr * 64 + fr;
        if (u.pn < 8) {
            const int ch = u.pn * 128 + wc * 32 + 8 * fq;
#pragma unroll
            for (int ai = 0; ai < 2; ++ai)
#pragma unroll
                for (int m = 0; m < 4; ++m) { const int row = row0 + ai * HALF + m * 16; const float r = rstd[row], r2 = r * r;
                    const f32x4 v0 = acc[ai][0][m][0] * acc[ai][1][m][0] * r2, v1 = acc[ai][0][m][1] * acc[ai][1][m][1] * r2;
                    *(u32x4*)(VB + (size_t)row * 1024 + ch) = pack8(v0, v1); }
        } else {
            const int ch = (u.pn - 8) * 256 + wc * 32 + 8 * fq;
#pragma unroll
            for (int ai = 0; ai < 2; ++ai)
#pragma unroll
                for (int m = 0; m < 4; ++m) { const int row = row0 + ai * HALF + m * 16; const float r = rstd[row];
#pragma unroll
                    for (int bj = 0; bj < 2; ++bj) *(u32x4*)(BB + (size_t)row * 1024 + ch + bj * HALF) = pack8(acc[ai][bj][m][0] * r, acc[ai][bj][m][1] * r); }
        }
    }
};
struct EpiRes {
    static constexpr bool PERM = true, AFTER_DRAIN = false;
    const float* base_p; const float* base_s; float* H; bf16_t* HB; float* ssqp;
    __device__ __forceinline__ void operator()(const f32x4 (&acc)[2][2][4][2], const Unit& u, int wr, int wc, int fr, int fq) const {
        const int row0 = u.pm * BM + wr * 64 + fr, col0 = u.pn * BM + wc * 32 + 8 * fq;
#pragma unroll
        for (int ai = 0; ai < 2; ++ai)
#pragma unroll
            for (int m = 0; m < 4; ++m) { const int row = row0 + ai * HALF + m * 16;
                const float* b = (row < E_MP ? base_p + (size_t)row * 1024 : base_s + (size_t)(row - E_MP) * 1024) + col0;
                float* h = H + (size_t)row * 1024 + col0; float ss = 0.f;
#pragma unroll
                for (int bj = 0; bj < 2; ++bj) {
                    const f32x4 h0 = *(const f32x4*)(b + bj * HALF) + acc[ai][bj][m][0], h1 = *(const f32x4*)(b + bj * HALF + 4) + acc[ai][bj][m][1];
                    *(f32x4*)(h + bj * HALF) = h0; *(f32x4*)(h + bj * HALF + 4) = h1;
                    if (HB) *(u32x4*)(HB + (size_t)row * 1024 + col0 + bj * HALF) = pack8(h0, h1);
                    ss += (h0[0] * h0[0] + h0[1] * h0[1]) + (h0[2] * h0[2] + h0[3] * h0[3]) + (h1[0] * h1[0] + h1[1] * h1[1]) + (h1[2] * h1[2] + h1[3] * h1[3]); }
                ss += __shfl_xor(ss, 16); ss += __shfl_xor(ss, 32);
                if (fq == 0 && ssqp) ssqp[(size_t)row * 16 + u.pn * 4 + wc] = ss;
                if (m & 1) asm volatile("" ::: "memory"); }
    }
};
struct EpiFfn {
    static constexpr bool PERM = true, AFTER_DRAIN = false;
    bf16_t* ACT; const float* ssqp;
    __device__ __forceinline__ void operator()(const f32x4 (&acc)[2][2][4][2], const Unit& u, int wr, int wc, int fr, int fq) const {
        const int row0 = u.pm * BM + wr * 64 + fr, ch = u.pn * 128 + wc * 32 + 8 * fq;
#pragma unroll
        for (int ai = 0; ai < 2; ++ai)
#pragma unroll
            for (int m = 0; m < 4; ++m) { const int row = row0 + ai * HALF + m * 16; const float r = row_rstd16(ssqp, row, fq);
                f32x4 o[2];
#pragma unroll
                for (int n = 0; n < 2; ++n)
#pragma unroll
                    for (int e = 0; e < 4; ++e) { const float g = acc[ai][0][m][n][e] * r, up = acc[ai][1][m][n][e] * r;
                        o[n][e] = g * up * __builtin_amdgcn_rcpf(1.0f + __builtin_amdgcn_exp2f(g * -1.4426950408889634f)); }
                *(u32x4*)(ACT + (size_t)row * 2816 + ch) = pack8(o[0], o[1]); }
    }
};
struct EpiKvq {
    static constexpr bool PERM = true, AFTER_DRAIN = false;
    bf16_t* KVB; bf16_t* QB; float* GT; const float* ssqp;
    float *cmp_p, *cmp_s, *slc_p, *slc_s, *win_p, *win_s;
    __device__ __forceinline__ void operator()(const f32x4 (&acc)[2][2][4][2], const Unit& u, int wr, int wc, int fr, int fq) const {
        const int row0 = u.pm * BM + wr * 64 + fr, cw = wc * 32 + 8 * fq;
#pragma unroll
        for (int ai = 0; ai < 2; ++ai)
#pragma unroll
            for (int m = 0; m < 4; ++m) { const int row = row0 + ai * HALF + m * 16; const float r = row_rstd16(ssqp, row, fq);
                if (u.pn < 6) {
                    const int br = u.pn >> 1; float* orow = nullptr;
                    if (row < E_MP) { if (br == 0) orow = cmp_p + (size_t)row * 512; else if (br == 1) orow = slc_p + (size_t)row * 512;
                        else { const int t = row & 8191; if (t >= 7680) orow = win_p + ((size_t)(row >> 13) * 512 + (t - 7680)) * 512; } }
                    else { const int rs = row - E_MP; if (br == 0) orow = cmp_s + (size_t)rs * 512; else if (br == 1) orow = slc_s + (size_t)rs * 512;
                        else orow = win_s + ((size_t)(rs >> 3) * 512 + 504 + (rs & 7)) * 512; }
#pragma unroll
                    for (int bj = 0; bj < 2; ++bj) { const int col = u.pn * BM + bj * HALF + cw; const f32x4 a = acc[ai][bj][m][0] * r, b = acc[ai][bj][m][1] * r;
                        *(u32x4*)(KVB + (size_t)row * 1536 + col) = pack8(a, b);
                        if (orow) { *(f32x4*)(orow + (col & 511)) = a; *(f32x4*)(orow + (col & 511) + 4) = b; } }
                } else if (u.pn < 10) {
#pragma unroll
                    for (int bj = 0; bj < 2; ++bj) { const int col = (u.pn - 6) * BM + bj * HALF + cw;
                        *(u32x4*)(QB + (size_t)row * 1024 + col) = pack8(acc[ai][0 + bj][m][0] * r, acc[ai][0 + bj][m][1] * r); }
                } else {
                    if (cw < 48) {
                        f32x4 s0, s1;
#pragma unroll
                        for (int e = 0; e < 4; ++e) { s0[e] = __builtin_amdgcn_rcpf(1.0f + __builtin_amdgcn_exp2f(acc[ai][0][m][0][e] * r * -1.4426950408889634f));
                                                      s1[e] = __builtin_amdgcn_rcpf(1.0f + __builtin_amdgcn_exp2f(acc[ai][0][m][1][e] * r * -1.4426950408889634f)); }
                        *(f32x4*)(GT + (size_t)row * 48 + cw) = s0; *(f32x4*)(GT + (size_t)row * 48 + cw + 4) = s1; }
                }
            }
    }
};
template <class Epi, class Sched, bool ALIGN_EPI = false, bool SP2 = false>
__device__ __forceinline__ void gemm_phase(PG8_LAS unsigned char* lds, const Gemm g, const Sched& S, const Epi& E) {
    const int tid = threadIdx.x, wid = __builtin_amdgcn_readfirstlane(tid >> 6), lane = tid & 63, wr = wid >> 2, wc = wid & 3, fr = lane & 15, fq = lane >> 4;
    const int K = g.K, nt = K / BK;
    unsigned voffA[2], voffB[2];
#pragma unroll
    for (int i = 0; i < 2; ++i) { int R, C; stage_rc(tid * 16 + i * 8192, R, C); const int Rb = Epi::PERM ? ((R & ~31) + perm32(R & 31)) : R;
        voffA[i] = (unsigned)(R * K + C) * 2u; voffB[i] = (unsigned)(Rb * K + C) * 2u; }
    const size_t kstep = (size_t)(BK * 2);
    const size_t hstep = (size_t)HALF * K * 2;
    const size_t tstep = 2 * hstep;
    const unsigned ldsw = (unsigned)wid * 1024u;
    const int aoff = lds_byte(wr * 64 + fr, fq * 8), boff = lds_byte(wc * 32 + fr, fq * 8);
#define PG8_SA(b, h) (((b) * 2 + (h)) * HTB)
#define PG8_SB(b, h) ((4 + (b) * 2 + (h)) * HTB)
#define PG8_STAGE(bufoff, gbase, voff) do { _Pragma("unroll") for (int _i = 0; _i < 2; ++_i) \
        __builtin_amdgcn_global_load_lds((const unsigned*)((const char*)(gbase) + (voff)[_i]), (PG8_LAS unsigned*)(lds + (bufoff) + ldsw + _i * 8192), 16, 0, 0); } while (0)
#define PG8_LDA(dst, b, h) do { _Pragma("unroll") for (int m = 0; m < 4; ++m) _Pragma("unroll") for (int k = 0; k < 2; ++k) dst[m][k] = *(const PG8_LAS bf16x8*)(lds + PG8_SA(b, h) + aoff + m * 2048 + k * 1024); } while (0)
#define PG8_LDB(dst, b, h) do { _Pragma("unroll") for (int n = 0; n < 2; ++n) _Pragma("unroll") for (int k = 0; k < 2; ++k) dst[n][k] = *(const PG8_LAS bf16x8*)(lds + PG8_SB(b, h) + boff + n * 2048 + k * 1024); } while (0)
#define PG8_MMA(ai, bj, At, Bt) do { __builtin_amdgcn_s_setprio(1); _Pragma("unroll") for (int m = 0; m < 4; ++m) _Pragma("unroll") for (int n = 0; n < 2; ++n) _Pragma("unroll") for (int k = 0; k < 2; ++k) \
        acc[ai][bj][m][n] = __builtin_amdgcn_mfma_f32_16x16x32_bf16(Bt[n][k], At[m][k], acc[ai][bj][m][n], 0, 0, 0); __builtin_amdgcn_s_setprio(0); } while (0)
#define PG8_WAIT_V(n) asm volatile("s_waitcnt vmcnt(" #n ")" ::: "memory")
#define PG8_WAIT_L(n) asm volatile("s_waitcnt lgkmcnt(" #n ")" ::: "memory")
#define PG8_BAR __builtin_amdgcn_s_barrier()
#define PG8_SCHED __builtin_amdgcn_sched_barrier(0)
    Unit cur, nxt; int ui = 0;
    if (!S.next(0, cur)) return;
    f32x4 acc[2][2][4][2];
#pragma unroll
    for (int a = 0; a < 2; ++a)
#pragma unroll
        for (int b = 0; b < 2; ++b)
#pragma unroll
            for (int m = 0; m < 4; ++m)
#pragma unroll
                for (int n = 0; n < 2; ++n) acc[a][b][m][n] = (f32x4){0.f, 0.f, 0.f, 0.f};
    bf16x8 At[4][2], B0[2][2], B1[2][2];
    const char* cA = (const char*)g.A + (size_t)cur.pm * tstep; const char* cB = (const char*)g.Bt + (size_t)cur.pn * tstep;
    S.a_ready(cur);
    if constexpr (SP2) {
        PG8_STAGE(PG8_SB(0, 0), cB, voffB); PG8_STAGE(PG8_SB(0, 1), cB + hstep, voffB); PG8_STAGE(PG8_SA(0, 0), cA, voffA); PG8_STAGE(PG8_SA(0, 1), cA + hstep, voffA);
        if (wr == 1) PG8_BAR;
        PG8_WAIT_V(2); PG8_BAR;
        PG8_STAGE(PG8_SB(1, 0), cB + kstep, voffB); PG8_STAGE(PG8_SA(1, 0), cA + kstep, voffA); PG8_STAGE(PG8_SB(1, 1), cB + hstep + kstep, voffB);
        PG8_WAIT_V(6); PG8_BAR;
    } else {
        PG8_STAGE(PG8_SB(0, 0), cB, voffB); PG8_STAGE(PG8_SA(0, 0), cA, voffA); PG8_STAGE(PG8_SB(0, 1), cB + hstep, voffB); PG8_STAGE(PG8_SA(0, 1), cA + hstep, voffA);
        if (wr == 1) PG8_BAR;
        PG8_WAIT_V(4); PG8_BAR;
        PG8_STAGE(PG8_SB(1, 0), cB + kstep, voffB); PG8_STAGE(PG8_SA(1, 0), cA + kstep, voffA); PG8_STAGE(PG8_SB(1, 1), cB + hstep + kstep, voffB);
        PG8_WAIT_V(6); PG8_BAR;
    }
    for (;;) {
        const bool has_next = S.next(ui + 1, nxt);
        const char* nA = has_next ? (const char*)g.A + (size_t)nxt.pm * tstep : cA; const char* nB = has_next ? (const char*)g.Bt + (size_t)nxt.pn * tstep : cB;
        for (int t = 0; t < nt; t += 2) {
            const bool last = (t == nt - 2);
            const char* a1 = cA + (size_t)(t + 1) * kstep;
            const char* a2 = last ? nA : cA + (size_t)(t + 2) * kstep; const char* b2 = last ? nB : cB + (size_t)(t + 2) * kstep;
            const char* a3 = a2 + kstep; const char* b3 = b2 + kstep;
            if (last && has_next) S.a_ready(nxt);
            if constexpr (SP2) {
            PG8_LDB(B0, 0, 0); PG8_LDB(B1, 0, 1); PG8_SCHED; PG8_LDA(At, 0, 0); PG8_STAGE(PG8_SA(1, 1), a1 + hstep, voffA);
            PG8_WAIT_V(8); PG8_WAIT_L(0); PG8_BAR; PG8_MMA(0, 0, At, B0); PG8_MMA(0, 1, At, B1); PG8_BAR; PG8_SCHED;
            PG8_LDA(At, 0, 1); PG8_STAGE(PG8_SB(0, 0), b2, voffB); PG8_STAGE(PG8_SB(0, 1), b2 + hstep, voffB); PG8_STAGE(PG8_SA(0, 0), a2, voffA);
            PG8_WAIT_V(8); PG8_WAIT_L(0); PG8_BAR; PG8_MMA(1, 0, At, B0); PG8_MMA(1, 1, At, B1); PG8_BAR; PG8_SCHED;
            PG8_LDB(B0, 1, 0); PG8_LDB(B1, 1, 1); PG8_SCHED; PG8_LDA(At, 1, 0); PG8_STAGE(PG8_SA(0, 1), a2 + hstep, voffA);
            PG8_WAIT_V(8); PG8_WAIT_L(0); PG8_BAR; PG8_MMA(0, 0, At, B0); PG8_MMA(0, 1, At, B1); PG8_BAR; PG8_SCHED;
            PG8_LDA(At, 1, 1); PG8_STAGE(PG8_SB(1, 0), b3, voffB); PG8_STAGE(PG8_SB(1, 1), b3 + hstep, voffB); PG8_STAGE(PG8_SA(1, 0), a3, voffA);
            PG8_WAIT_V(8); PG8_WAIT_L(0); PG8_BAR; PG8_MMA(1, 0, At, B0); PG8_MMA(1, 1, At, B1); PG8_BAR; PG8_SCHED;
            } else {
            PG8_LDB(B0, 0, 0); PG8_SCHED; PG8_LDA(At, 0, 0); PG8_STAGE(PG8_SA(1, 1), a1 + hstep, voffA);
            PG8_WAIT_L(8); PG8_BAR; PG8_WAIT_L(0); PG8_MMA(0, 0, At, B0); PG8_BAR; PG8_SCHED;
            PG8_LDB(B1, 0, 1); PG8_STAGE(PG8_SB(0, 0), b2, voffB);
            PG8_BAR; PG8_WAIT_L(0); PG8_MMA(0, 1, At, B1); PG8_BAR;
            PG8_LDA(At, 0, 1); PG8_STAGE(PG8_SA(0, 0), a2, voffA);
            PG8_BAR; PG8_WAIT_L(0); PG8_MMA(1, 0, At, B0); PG8_BAR; PG8_SCHED;
            PG8_STAGE(PG8_SB(0, 1), b2 + hstep, voffB);
            PG8_WAIT_V(6); PG8_BAR; PG8_MMA(1, 1, At, B1); PG8_BAR;
            PG8_LDB(B0, 1, 0); PG8_SCHED; PG8_LDA(At, 1, 0); PG8_STAGE(PG8_SA(0, 1), a2 + hstep, voffA);
            PG8_WAIT_L(8); PG8_BAR; PG8_WAIT_L(0); PG8_MMA(0, 0, At, B0); PG8_BAR; PG8_SCHED;
            PG8_LDB(B1, 1, 1); PG8_STAGE(PG8_SB(1, 0), b3, voffB);
            PG8_BAR; PG8_WAIT_L(0); PG8_MMA(0, 1, At, B1); PG8_BAR;
            PG8_LDA(At, 1, 1); PG8_STAGE(PG8_SA(1, 0), a3, voffA);
            PG8_BAR; PG8_WAIT_L(0); PG8_MMA(1, 0, At, B0); PG8_BAR; PG8_SCHED;
            PG8_STAGE(PG8_SB(1, 1), b3 + hstep, voffB);
            PG8_WAIT_V(6); PG8_BAR; PG8_MMA(1, 1, At, B1); PG8_BAR;
            }
        }
        if constexpr (ALIGN_EPI) { if (wr == 0) PG8_BAR; }
        if constexpr (!Epi::AFTER_DRAIN) { E(acc, cur, wr, wc, fr, fq); S.done(cur); }
        if (!has_next) break;
#pragma unroll
        for (int a = 0; a < 2; ++a)
#pragma unroll
            for (int b = 0; b < 2; ++b)
#pragma unroll
                for (int m = 0; m < 4; ++m)
#pragma unroll
                    for (int n = 0; n < 2; ++n) acc[a][b][m][n] = (f32x4){0.f, 0.f, 0.f, 0.f};
        cur = nxt; cA = nA; cB = nB; ++ui;
        if constexpr (ALIGN_EPI) { if (wr == 1) PG8_BAR; }
    }
    PG8_WAIT_V(0);
    if constexpr (!ALIGN_EPI) { if (wr == 0) PG8_BAR; }
    PG8_BAR;
    if constexpr (Epi::AFTER_DRAIN) { E.fused(acc, cur, wr, wc, fr, fq, lds, wid, lane); S.done(cur); }
#undef PG8_SA
#undef PG8_SB
#undef PG8_STAGE
#undef PG8_LDA
#undef PG8_LDB
#undef PG8_MMA
#undef PG8_WAIT_V
#undef PG8_WAIT_L
#undef PG8_BAR
#undef PG8_SCHED
}
}
#ifndef PG8_SP2
#define PG8_SP2 true
#endif
#ifndef PG8_ALIGN
#define PG8_ALIGN true
#endif
constexpr int NWAVES = 8;
constexpr int DM = 1024, TP = 8192, NBP = 2, MP = NBP * TP, NBS = 128, TS = 8, MS = NBS * TS, MT = MP + MS;
constexpr int DFF = 2816, NFF = 2 * DFF, NAIN = 3 * DM, NKVQ = 2816, NKV = 1536, PAST = 2048, NPAGE = 16, PAGE = 128;
constexpr int NCP = 511, NCS = 127;
constexpr float RMS_EPS = 1e-6f;
constexpr float QSCALE = 0.125f * 1.4426950408889634f;
constexpr size_t O_YP = 0, O_YS = O_YP + (size_t)MP * DM, O_CONVP = O_YS + (size_t)MS * DM, O_CONVS = O_CONVP + 2 * 2 * DM, O_CMPP = O_CONVS + (size_t)NBS * 2 * DM,
                 O_CMPS = O_CMPP + (size_t)MP * 512, O_SLCP = O_CMPS + (size_t)MS * 512, O_SLCS = O_SLCP + (size_t)MP * 512, O_WINP = O_SLCS + (size_t)MS * 512,
                 O_WINS = O_WINP + (size_t)NBP * 512 * 512, O_END = O_WINS + (size_t)NBS * 512 * 512;
static_assert(O_END == 69996544, "output size");
constexpr size_t MiB = 1u << 20;
constexpr size_t WS_CTL = 0, CTL_ZERO_BYTES = 1 * MiB;
constexpr size_t WS_WAIN = 2 * MiB, WS_WAOUT = 8 * MiB, WS_WFIN0 = 10 * MiB, WS_WFIN1 = 21 * MiB, WS_WFOUT0 = 32 * MiB, WS_WFOUT1 = 38 * MiB, WS_WKVQ = 44 * MiB, WS_WBOUT = 50 * MiB,
                 WS_W1T = 52 * MiB, WS_W2T = 53 * MiB, WS_PEB = 53 * MiB + 65536, WS_RSTD0 = 54 * MiB, WS_SSQ = 55 * MiB  , WS_GT = 60 * MiB  ,
                 WS_KCP = 64 * MiB  , WS_KCS = 65 * MiB  , WS_SELS = 82 * MiB,
                 WS_XB = 96 * MiB, WS_BB = 132 * MiB, WS_VB = 168 * MiB, WS_Z = 204 * MiB, WS_H = 240 * MiB, WS_HB = 312 * MiB, WS_ACT = 348 * MiB, WS_KVB = 444 * MiB, WS_QB = 496 * MiB, WS_O = 532 * MiB, WS_END = 568 * MiB;
static_assert(WS_XB + (size_t)MT * DM * 2 <= WS_BB && WS_H + (size_t)MT * DM * 4 <= WS_HB && WS_ACT + (size_t)MT * DFF * 2 <= WS_KVB && WS_KVB + (size_t)MT * NKV * 2 <= WS_QB && WS_O + (size_t)MT * DM * 2 <= WS_END, "ws map");
static_assert(WS_SSQ + 4 * (size_t)MT * 16 * 4 <= WS_GT && WS_GT + (size_t)MT * 48 * 4 <= WS_KCP && WS_KCS + (size_t)NBS * 128 * 512 * 2 <= WS_SELS, "ws map 2");
constexpr int CW_TMO = 0, CW_CODE = 1, CW_BAR = 4096;
constexpr int RING_OFF = 0, RING_BYTES = 155648, LDSCTL_OFF = RING_BYTES, MISC_OFF = LDSCTL_OFF + 320, LDS_BYTES = 159744;

#define GAS __attribute__((address_space(1)))
#define LAS __attribute__((address_space(3)))
typedef unsigned short bf16;
typedef unsigned v4u __attribute__((ext_vector_type(4)));
typedef unsigned v2u __attribute__((ext_vector_type(2)));
typedef float f32x4 __attribute__((ext_vector_type(4)));
typedef short bf16x8 __attribute__((ext_vector_type(8)));
typedef GAS unsigned gu32;
#define RLX_AGENT __ATOMIC_RELAXED, __HIP_MEMORY_SCOPE_AGENT
#define LDS_WAIT() asm volatile("s_waitcnt lgkmcnt(0)" ::: "memory")
#define VM_WAIT() asm volatile("s_waitcnt vmcnt(0)" ::: "memory")
__device__ __forceinline__ unsigned f2bf(float f) { unsigned u = __builtin_bit_cast(unsigned, f); return (u + 0x7fffu + ((u >> 16) & 1u)) >> 16; }
__device__ __forceinline__ unsigned pk2(float lo, float hi) { return f2bf(lo) | (f2bf(hi) << 16); }
__device__ __forceinline__ float bf2f(unsigned h) { return __builtin_bit_cast(float, h << 16); }
#define XB_TMO      128
#define XB_XCNT(j)  (256  + 64 * (j))
#define XB_XSUB(j)  (1280 + 64 * (j))
#define XB_XGEN(j)  (2304 + 64 * (j))
#define XB_TOP      3328
#define XB_TOPGEN   3392
#define XCD_BAR_WORDS 3456
#define XB_SPIN_CAP (1u << 18)

__device__ __forceinline__ unsigned xb_ld(unsigned* p)              { return __hip_atomic_load(p, __ATOMIC_RELAXED, __HIP_MEMORY_SCOPE_AGENT); }
__device__ __forceinline__ unsigned xb_add(unsigned* p, unsigned v) { return __hip_atomic_fetch_add(p, v, __ATOMIC_RELAXED, __HIP_MEMORY_SCOPE_AGENT); }
__device__ __forceinline__ unsigned xb_xcc_id() { return (unsigned)__builtin_amdgcn_s_getreg((3 << 11) | 20) & 0xFu; }
#define XB_SPIN(cond, bar) do { unsigned _sp = 0; while (cond) { __builtin_amdgcn_s_sleep(1); \
    if ((++_sp & 255u) == 0u) { if (xb_ld(&(bar)[XB_TMO])) break; if (_sp > XB_SPIN_CAP) { atomicAdd(&(bar)[XB_TMO], 1u); break; } } } } while (0)

struct XcdBarrier {
    unsigned* bar; unsigned x;
    volatile LAS unsigned* st;
};

__device__ __forceinline__ XcdBarrier xcd_barrier_post(unsigned* bar, volatile LAS unsigned* st) {
    XcdBarrier b; b.bar = bar; b.x = xb_xcc_id(); b.st = st;
    if (threadIdx.x == 0) (void)xb_add(&bar[XB_XCNT(b.x)], 1u);
    return b;
}
__device__ __forceinline__ void xcd_barrier_complete(unsigned* bar, unsigned x, unsigned& nloc, unsigned& nx) {
    const unsigned G = gridDim.x * gridDim.y * gridDim.z;
    unsigned sum, cnt, mine, sp = 0u;
    for (;;) {
        sum = 0u; cnt = 0u; mine = 0u;
#pragma unroll
        for (unsigned j = 0; j < 16; ++j) { const unsigned c = xb_ld(&bar[XB_XCNT(j)]); sum += c; cnt += (c > 0u) ? 1u : 0u; mine = (j == x) ? c : mine; }
        if (sum == G) break;
        __builtin_amdgcn_s_sleep(1);
        if ((++sp & 255u) == 0u) { if (xb_ld(&bar[XB_TMO])) break; if (sp > XB_SPIN_CAP) { atomicAdd(&bar[XB_TMO], 1u); break; } }
    }
    nloc = mine > 0u ? mine : 1u; nx = cnt > 0u ? cnt : 1u;
}

__device__ __forceinline__ void xcd_barrier(const XcdBarrier& b) {
    asm volatile("s_waitcnt vmcnt(0)" ::: "memory");
    __syncthreads();
    if (threadIdx.x == 0) {
        unsigned* bar = b.bar;
        __builtin_amdgcn_s_waitcnt(0);
        unsigned nloc = b.st[0], nx = b.st[1];
        if (nloc == 0u) { xcd_barrier_complete(bar, b.x, nloc, nx); b.st[0] = nloc; b.st[1] = nx; }
        const unsigned old = xb_add(&bar[XB_XSUB(b.x)], 1u);
        const unsigned gen = old / nloc;
        if (old + 1u == (gen + 1u) * nloc) {
            __builtin_amdgcn_fence(__ATOMIC_RELEASE, "agent");
            asm volatile("s_waitcnt vmcnt(0)" ::: "memory");
            const unsigned og = xb_add(&bar[XB_TOP], 1u);
            const unsigned tg = og / nx;
            if (og + 1u == (tg + 1u) * nx) xb_add(&bar[XB_TOPGEN], 1u);
            else XB_SPIN(xb_ld(&bar[XB_TOPGEN]) == tg, bar);
            __builtin_amdgcn_fence(__ATOMIC_ACQUIRE, "agent");
            xb_add(&bar[XB_XGEN(b.x)], 1u);
            asm volatile("s_waitcnt vmcnt(0)" ::: "memory");
        } else {
            XB_SPIN(xb_ld(&bar[XB_XGEN(b.x)]) == gen, bar);
            __builtin_amdgcn_fence(__ATOMIC_ACQUIRE, "agent");
            asm volatile("s_waitcnt vmcnt(0)" ::: "memory");
        }
    }
    __syncthreads();
}

struct Args { const float* in[21]; float* out; unsigned char* ws; int ph_lo, ph_hi; };
struct Frame {
    LAS unsigned char* lds; volatile LAS unsigned* MISC; gu32* ctl;
    int tid, lane, wave, vcu, G;
};
__device__ __forceinline__ float wave_sum(float v) {
#pragma unroll
    for (int o = 1; o < 64; o <<= 1) v += __shfl_xor(v, o);
    return v;
}
__device__ __forceinline__ void tr_item(const float* src, int ldsrc, int scol, int nvalid, const float* kscale, float cscale, bf16* dst, int K, int n0, int k0, LAS float* scr, int lane) {
#pragma unroll 8
    for (int i = 0; i < 32; ++i) { const int kk = 2 * i + (lane >> 5), c = lane & 31;
        float v = 0.f; if (c < nvalid) { v = src[(size_t)(k0 + kk) * ldsrc + scol + c] * cscale; if (kscale) v *= kscale[k0 + kk]; }
        scr[kk * 33 + c] = v; }
    LDS_WAIT(); asm volatile("" ::: "memory");
    const int c = lane & 7;
#pragma unroll
    for (int j = 0; j < 4; ++j) { const int n = (lane >> 3) + 8 * j; const LAS float* s = scr + (8 * c) * 33 + n;
        v4u o; o.x = pk2(s[0 * 33], s[1 * 33]); o.y = pk2(s[2 * 33], s[3 * 33]); o.z = pk2(s[4 * 33], s[5 * 33]); o.w = pk2(s[6 * 33], s[7 * 33]);
        *(GAS v4u*)(dst + (size_t)(n0 + n) * K + k0 + 8 * c) = o; }
    LDS_WAIT(); asm volatile("" ::: "memory");
}
enum { I_XP = 0, I_XS, I_CCMP, I_CSLC, I_SWIN, I_SCONV, I_PT, I_NORMW, I_FNORMW, I_AIN, I_ACONV, I_AOUT, I_BIN, I_BOUT, I_KVNORM, I_KVW, I_PE, I_W1, I_W2, I_FIN, I_FOUT };

__device__ __forceinline__ void p0_prologue(Frame& F, const Args& A) {
    unsigned char* ws = A.ws;
    LAS float* scr = (LAS float*)(F.lds + RING_OFF + F.wave * 16384);
    const int gw = F.vcu * NWAVES + F.wave, NGW = F.G * NWAVES;
    const float* normw = A.in[I_NORMW];
    constexpr int IT_AIN = (NAIN / 32) * (DM / 64), IT_SQ = (DM / 32) * (DM / 64), IT_FIN = (NFF / 32) * (DM / 64), IT_FOUT = (DM / 32) * (DFF / 64), IT_KVQ = (NKVQ / 32) * (DM / 64),
                  IT_W1 = 2 * (64 / 32) * (2048 / 64), IT_W2 = 2 * 2;
    constexpr int NITEMS = IT_AIN + 2 * IT_SQ + 2 * IT_FIN + 2 * IT_FOUT + IT_KVQ + IT_W1 + IT_W2;
    for (int it = gw; it < NITEMS; it += NGW) {
        int r = it;
        if (r < IT_AIN) { const int ng = r / 16, kb = r % 16, n0 = ng * 32, pn = n0 >> 8, w = n0 & 255;
            const int scol = pn < 8 ? (w < 128 ? 1024 + pn * 128 + w : 2048 + pn * 128 + (w - 128)) : (pn - 8) * 256 + w;
            tr_item(A.in[I_AIN], NAIN, scol, 32, normw, 1.f, (bf16*)(ws + WS_WAIN), DM, n0, kb * 64, scr, F.lane); continue; } r -= IT_AIN;
        if (r < IT_SQ) { const int ng = r / 16, kb = r % 16; tr_item(A.in[I_AOUT], DM, ng * 32, 32, nullptr, 1.f, (bf16*)(ws + WS_WAOUT), DM, ng * 32, kb * 64, scr, F.lane); continue; } r -= IT_SQ;
        if (r < IT_SQ) { const int ng = r / 16, kb = r % 16; tr_item(A.in[I_BOUT], DM, ng * 32, 32, nullptr, 1.f, (bf16*)(ws + WS_WBOUT), DM, ng * 32, kb * 64, scr, F.lane); continue; } r -= IT_SQ;
        if (r < 2 * IT_FIN) { const int l = r / IT_FIN, q = r % IT_FIN, ng = q / 16, kb = q % 16, n0 = ng * 32, pn = n0 >> 8, w = n0 & 255;
            const int scol = w < 128 ? pn * 128 + w : DFF + pn * 128 + (w - 128);
            tr_item(A.in[I_FIN] + (size_t)l * DM * NFF, NFF, scol, 32, normw + (l * 2 + 1) * DM, 1.f, (bf16*)(ws + (l ? WS_WFIN1 : WS_WFIN0)), DM, n0, kb * 64, scr, F.lane); continue; } r -= 2 * IT_FIN;
        if (r < 2 * IT_FOUT) { const int l = r / IT_FOUT, q = r % IT_FOUT, ng = q / 44, kb = q % 44;
            tr_item(A.in[I_FOUT] + (size_t)l * DFF * DM, DM, ng * 32, 32, nullptr, 1.f, (bf16*)(ws + (l ? WS_WFOUT1 : WS_WFOUT0)), DFF, ng * 32, kb * 64, scr, F.lane); continue; } r -= 2 * IT_FOUT;
        if (r < IT_KVQ) { const int ng = r / 16, kb = r % 16, n0 = ng * 32; bf16* dst = (bf16*)(ws + WS_WKVQ);
            if (n0 < NKV) tr_item(A.in[I_KVW], NKV, n0, 32, A.in[I_KVNORM], 1.f, dst, DM, n0, kb * 64, scr, F.lane);
            else if (n0 < NKV + 1024) tr_item(A.in[I_BIN], 1072, n0 - NKV, 32, normw + 2 * DM, QSCALE, dst, DM, n0, kb * 64, scr, F.lane);
            else { const int g0 = n0 - (NKV + 1024); const int nv = g0 >= 48 ? 0 : (48 - g0 < 32 ? 48 - g0 : 32);
                tr_item(A.in[I_BIN], 1072, 1024 + (nv ? g0 : 0), nv, normw + 2 * DM, 1.f, dst, DM, n0, kb * 64, scr, F.lane); }
            continue; } r -= IT_KVQ;
        if (r < IT_W1) { const int k = r / 64, q = r % 64, ng = q / 32, kb = q % 32;
            tr_item(A.in[I_W1] + (size_t)k * 2048 * 64, 64, ng * 32, 32, nullptr, 1.f, (bf16*)(ws + WS_W1T) + (size_t)k * 64 * 2048, 2048, ng * 32, kb * 64, scr, F.lane); continue; } r -= IT_W1;
        { const int k = r / 2, ng = r % 2;
            tr_item(A.in[I_W2] + (size_t)k * 64 * 64, 64, ng * 32, 32, nullptr, 1.f, (bf16*)(ws + WS_W2T) + (size_t)k * 64 * 64, 64, ng * 32, 0, scr, F.lane); }
    }
    for (int o = gw; o < 128; o += NGW) { const int k = o >> 6, h = o & 63; const float* pe = A.in[I_PE] + (size_t)k * 2048; const float* w1 = A.in[I_W1] + (size_t)k * 2048 * 64 + h;
        float s = 0.f; for (int i = F.lane; i < 2048; i += 64) s += pe[i] * w1[(size_t)i * 64];
        s = wave_sum(s); if (F.lane == 0) ((float*)(ws + WS_PEB))[o] = s; }
    for (int m = gw; m < MT; m += NGW) {
        const float* xrow = m < MP ? A.in[I_XP] + (size_t)m * DM : A.in[I_XS] + (size_t)(m - MP) * DM;
        const GAS f32x4* xr = (const GAS f32x4*)xrow + F.lane; f32x4 v[4]; float s = 0.f;
#pragma unroll
        for (int j = 0; j < 4; ++j) { v[j] = xr[64 * j]; s += (v[j].x * v[j].x + v[j].y * v[j].y) + (v[j].z * v[j].z + v[j].w * v[j].w); }
        s = wave_sum(s);
        GAS v2u* o8 = (GAS v2u*)((bf16*)(ws + WS_XB) + (size_t)m * DM) + F.lane;
#pragma unroll
        for (int j = 0; j < 4; ++j) { v2u w; w.x = pk2(v[j].x, v[j].y); w.y = pk2(v[j].z, v[j].w); o8[64 * j] = w; }
        if (F.lane == 0) ((float*)(ws + WS_RSTD0))[m] = __builtin_amdgcn_rsqf(s * (1.0f / DM) + RMS_EPS);
    }
    { const GAS f32x4* src = (const GAS f32x4*)A.in[I_SWIN]; GAS f32x4* dst = (GAS f32x4*)(A.out + O_WINS);
      const size_t per = (size_t)504 * 128, total = (size_t)NBS * per; const size_t gt = (size_t)F.vcu * 512 + F.tid, GT_ = (size_t)F.G * 512;
      for (size_t i = gt; i < total; i += GT_) { const size_t n = i / per, rem = i % per; dst[n * (512 * 128) + rem] = src[n * (512 * 128) + 8 * 128 + rem]; } }
}
__device__ __forceinline__ void p2_conv(Frame& F, const Args& A) {
    unsigned char* ws = A.ws; const bf16* VB = (const bf16*)(ws + WS_VB); const bf16* BB = (const bf16*)(ws + WS_BB); bf16* Z = (bf16*)(ws + WS_Z);
    const float* cw = A.in[I_ACONV]; const float* sc = A.in[I_SCONV];
    const size_t gt = (size_t)F.vcu * 512 + F.tid, GT_ = (size_t)F.G * 512, total = (size_t)MT * 128;
    for (size_t i = gt; i < total; i += GT_) {
        const int row = (int)(i >> 7), c8 = (int)(i & 127) * 8; int t, tlen; const float* pre = nullptr;
        if (row < MP) { t = row & (TP - 1); tlen = TP; } else { const int rs = row - MP; t = rs & 7; tlen = TS; pre = sc + (size_t)(rs >> 3) * 2 * DM; }
        const v4u vb = *(const GAS v4u*)(BB + (size_t)row * DM + c8), v2 = *(const GAS v4u*)(VB + (size_t)row * DM + c8);
        float f1[8], f0[8];
        if (t >= 1) { const v4u q = *(const GAS v4u*)(VB + (size_t)(row - 1) * DM + c8);
#pragma unroll
            for (int e = 0; e < 4; ++e) { f1[2 * e] = bf2f(q[e] & 0xffffu); f1[2 * e + 1] = bf2f(q[e] >> 16); } }
        else {
#pragma unroll
            for (int e = 0; e < 8; ++e) f1[e] = pre ? pre[DM + c8 + e] : 0.f; }
        if (t >= 2) { const v4u q = *(const GAS v4u*)(VB + (size_t)(row - 2) * DM + c8);
#pragma unroll
            for (int e = 0; e < 4; ++e) { f0[2 * e] = bf2f(q[e] & 0xffffu); f0[2 * e + 1] = bf2f(q[e] >> 16); } }
        else {
#pragma unroll
            for (int e = 0; e < 8; ++e) f0[e] = pre ? pre[(size_t)t * DM + c8 + e] : 0.f; }
        float z[8], vv[8];
#pragma unroll
        for (int e = 0; e < 4; ++e) { vv[2 * e] = bf2f(v2[e] & 0xffffu); vv[2 * e + 1] = bf2f(v2[e] >> 16); }
#pragma unroll
        for (int e = 0; e < 8; ++e) { const float b = bf2f((vb[e >> 1] >> ((e & 1) * 16)) & 0xffffu);
            z[e] = b * (cw[c8 + e] * f0[e] + cw[DM + c8 + e] * f1[e] + cw[2 * DM + c8 + e] * vv[e]); }
        v4u o; o.x = pk2(z[0], z[1]); o.y = pk2(z[2], z[3]); o.z = pk2(z[4], z[5]); o.w = pk2(z[6], z[7]);
        *(GAS v4u*)(Z + (size_t)row * DM + c8) = o;
        if (t >= tlen - 2) { float* dst = row < MP ? A.out + O_CONVP + ((size_t)(row >> 13) * 2 + (t - (tlen - 2))) * DM + c8
                                                  : A.out + O_CONVS + ((size_t)((row - MP) >> 3) * 2 + (t - (tlen - 2))) * DM + c8;
#pragma unroll
            for (int e = 0; e < 8; ++e) dst[e] = vv[e]; }
    }
}
__device__ __forceinline__ void p_final(Frame& F, const Args& A) {
    const float* H = (const float*)(A.ws + WS_H); const GAS f32x4* fw = (const GAS f32x4*)A.in[I_FNORMW] + F.lane;
    const int gw = F.vcu * NWAVES + F.wave, NGW = F.G * NWAVES;
    f32x4 w[4];
#pragma unroll
    for (int j = 0; j < 4; ++j) w[j] = fw[64 * j];
    for (int m = gw; m < MT; m += NGW) {
        const GAS f32x4* xr = (const GAS f32x4*)(H + (size_t)m * DM) + F.lane; f32x4 v[4]; float s = 0.f;
#pragma unroll
        for (int j = 0; j < 4; ++j) { v[j] = xr[64 * j]; s += (v[j].x * v[j].x + v[j].y * v[j].y) + (v[j].z * v[j].z + v[j].w * v[j].w); }
        const float r = __builtin_amdgcn_rsqf(wave_sum(s) * (1.0f / DM) + RMS_EPS);
        GAS f32x4* o = (GAS f32x4*)(A.out + (m < MP ? O_YP + (size_t)m * DM : O_YS + (size_t)(m - MP) * DM)) + F.lane;
#pragma unroll
        for (int j = 0; j < 4; ++j) o[64 * j] = v[j] * r * w[j];
    }
}
__device__ __forceinline__ void p_zero16(Frame& F, void* p, size_t bytes) {
    GAS v4u* d = (GAS v4u*)p; const size_t n = bytes / 16, gt = (size_t)F.vcu * 512 + F.tid, GT_ = (size_t)F.G * 512;
    for (size_t i = gt; i < n; i += GT_) d[i] = (v4u){0u, 0u, 0u, 0u};
}
constexpr int P7_IMG = 0, P7_IMG_BYTES = 144 * 512, P7_HID = P7_IMG_BYTES, P7_HID_STRIDE = 144;
constexpr int P7_UNITS_P = NBP * 64 * 2, P7_UNITS_S = NBS * NPAGE * 2, P7_UNITS = P7_UNITS_P + P7_UNITS_S;
__device__ __forceinline__ int p7_swz(int pos_l, int g, int dchunk) { return pos_l * 512 + g * 128 + ((dchunk ^ ((pos_l >> 4) & 3) ^ ((g >> 1) << 2)) << 4); }
__device__ __forceinline__ void p7_compress(Frame& F, const Args& A) {
    unsigned char* ws = A.ws; LAS unsigned char* img = F.lds + RING_OFF + P7_IMG; LAS unsigned char* hidp = F.lds + RING_OFF + P7_HID; LAS float* red = (LAS float*)img;
    const bf16* W1T = (const bf16*)(ws + WS_W1T); const bf16* W2T = (const bf16*)(ws + WS_W2T); const float* PEB = (const float*)(ws + WS_PEB);
    const bf16* KVB = (const bf16*)(ws + WS_KVB); const int* ptab = (const int*)A.in[I_PT]; const float* cache = A.in[I_CCMP];
    const int lane = F.lane, w = F.wave, tid = F.tid, l15 = lane & 15, lq = lane >> 4;
    for (int u = F.vcu; u < P7_UNITS; u += F.G) {
        const bool isp = u < P7_UNITS_P; int seq, seg, k;
        if (isp) { seq = u >> 7; seg = (u >> 1) & 63; k = u & 1; } else { const int v = u - P7_UNITS_P; seq = v >> 5; seg = (v >> 1) & 15; k = v & 1; }
        const int pos0 = seg * 128, plimit = isp ? TP : PAST, ntok = (isp ? seg == 63 : seg == 15) ? 7 : 8;
        if (isp) {
            v4u r[9];
#pragma unroll
            for (int i = 0; i < 9; ++i) { const int c = tid + i * 512, pos_l = c >> 5, g = (c >> 3) & 3, dc = c & 7, pos = pos0 + pos_l;
                r[i] = (v4u){0u, 0u, 0u, 0u}; if (pos < plimit) r[i] = *(const GAS v4u*)(KVB + ((size_t)seq * TP + pos) * NKV + k * 256 + g * 64 + dc * 8); }
#pragma unroll
            for (int i = 0; i < 9; ++i) { const int c = tid + i * 512, pos_l = c >> 5, g = (c >> 3) & 3, dc = c & 7; *(LAS v4u*)(img + p7_swz(pos_l, g, dc)) = r[i]; }
        } else {
            const int pgA = ptab[seq * NPAGE + seg], pgB = seg < 15 ? ptab[seq * NPAGE + seg + 1] : 0;
            f32x4 ra[9], rb[9];
#pragma unroll
            for (int i = 0; i < 9; ++i) { const int c = tid + i * 512, pos_l = c >> 5, g = (c >> 3) & 3, dc = c & 7, pos = pos0 + pos_l;
                ra[i] = (f32x4){0.f, 0.f, 0.f, 0.f}; rb[i] = ra[i];
                if (pos < plimit) { const float* s = cache + ((size_t)(pos_l < 128 ? pgA : pgB) * PAGE + (pos_l & 127)) * 512 + k * 256 + g * 64 + dc * 8; ra[i] = *(const GAS f32x4*)s; rb[i] = *(const GAS f32x4*)(s + 4); } }
#pragma unroll
            for (int i = 0; i < 9; ++i) { const int c = tid + i * 512, pos_l = c >> 5, g = (c >> 3) & 3, dc = c & 7;
                v4u o; o.x = pg8::cvt_pk_bf16(ra[i][0], ra[i][1]); o.y = pg8::cvt_pk_bf16(ra[i][2], ra[i][3]); o.z = pg8::cvt_pk_bf16(rb[i][0], rb[i][1]); o.w = pg8::cvt_pk_bf16(rb[i][2], rb[i][3]);
                *(LAS v4u*)(img + p7_swz(pos_l, g, dc)) = o; }
        }
        __syncthreads();
        f32x4 acc[2][4];
#pragma unroll
        for (int a = 0; a < 2; ++a)
#pragma unroll
            for (int b = 0; b < 4; ++b) acc[a][b] = (f32x4){0.f, 0.f, 0.f, 0.f};
#pragma unroll 2
        for (int kl = 0; kl < 8; ++kl) { const int ks = 8 * w + kl, j = ks >> 1, dh = ks & 1;
            bf16x8 bfr[4], afr[2];
#pragma unroll
            for (int nt = 0; nt < 4; ++nt) bfr[nt] = *(const GAS bf16x8*)(W1T + ((size_t)(k * 64 + nt * 16 + l15)) * 2048 + ks * 32 + lq * 8);
#pragma unroll
            for (int mt = 0; mt < 2; ++mt) { const int tok = mt * 4 + (l15 >> 2), g = l15 & 3, pos_l = 16 * tok + j; afr[mt] = *(const LAS bf16x8*)(img + p7_swz(pos_l, g, dh * 4 + lq)); }
#pragma unroll
            for (int mt = 0; mt < 2; ++mt)
#pragma unroll
                for (int nt = 0; nt < 4; ++nt) acc[mt][nt] = __builtin_amdgcn_mfma_f32_16x16x32_bf16(afr[mt], bfr[nt], acc[mt][nt], 0, 0, 0);
        }
        __syncthreads();
#pragma unroll
        for (int mt = 0; mt < 2; ++mt)
#pragma unroll
            for (int nt = 0; nt < 4; ++nt)
#pragma unroll
                for (int rg = 0; rg < 4; ++rg) red[(w * 32 + mt * 16 + 4 * lq + rg) * 64 + nt * 16 + l15] = acc[mt][nt][rg];
        __syncthreads();
        { const int row = tid >> 4, col = (tid & 15) * 4; f32x4 s = *(const LAS f32x4*)(red + row * 64 + col);
#pragma unroll
            for (int ww = 1; ww < 8; ++ww) s += *(const LAS f32x4*)(red + (ww * 32 + row) * 64 + col);
            const f32x4 pb = *(const GAS f32x4*)(PEB + k * 64 + col); float h[4];
#pragma unroll
            for (int e = 0; e < 4; ++e) { const float x = s[e] + pb[e]; h[e] = x * __builtin_amdgcn_rcpf(1.0f + __builtin_amdgcn_exp2f(x * -1.4426950408889634f)); }
            v2u o; o.x = pg8::cvt_pk_bf16(h[0], h[1]); o.y = pg8::cvt_pk_bf16(h[2], h[3]); *(LAS v2u*)(hidp + row * P7_HID_STRIDE + col * 2) = o; }
        __syncthreads();
        { const int mt = w >> 2, nt = w & 3; f32x4 a2 = (f32x4){0.f, 0.f, 0.f, 0.f};
#pragma unroll
            for (int k2 = 0; k2 < 2; ++k2) { const bf16x8 af = *(const LAS bf16x8*)(hidp + (mt * 16 + l15) * P7_HID_STRIDE + k2 * 64 + lq * 16);
                const bf16x8 bf = *(const GAS bf16x8*)(W2T + ((size_t)(k * 64 + nt * 16 + l15)) * 64 + k2 * 32 + lq * 8);
                a2 = __builtin_amdgcn_mfma_f32_16x16x32_bf16(af, bf, a2, 0, 0, 0); }
            const int tok = mt * 4 + lq; bf16* kc = isp ? (bf16*)(ws + WS_KCP) + (((size_t)seq * 512 + seg * 8 + tok) * 2 + k) * 256 : (bf16*)(ws + WS_KCS) + (((size_t)seq * 128 + seg * 8 + tok) * 2 + k) * 256;
#pragma unroll
            for (int rg = 0; rg < 4; ++rg) kc[rg * 64 + nt * 16 + l15] = (bf16)(tok < ntok ? f2bf(a2[rg]) : 0u); }
        __syncthreads();
    }
}
#define P7_BODY p7_compress(F, args);
constexpr int KT_STRIDE = 144, VT_STRIDE = 160;
constexpr float S_NEG = -1.0e30f, M_INIT = -1000.0f, RESC_THR = 8.0f;
typedef short s16x4 __attribute__((ext_vector_type(4)));
struct AttState { float m[2], l[2]; f32x4 o[2][4]; };
__device__ __forceinline__ void att_init(AttState& st) {
#pragma unroll
    for (int c = 0; c < 2; ++c) { st.m[c] = M_INIT; st.l[c] = 0.f;
#pragma unroll
        for (int d = 0; d < 4; ++d) st.o[c][d] = (f32x4){0.f, 0.f, 0.f, 0.f}; }
}
__device__ __forceinline__ s16x4 tr_read(const LAS unsigned char* p) { return __builtin_bit_cast(s16x4, __builtin_amdgcn_ds_read_tr16_b64_v4i16((LAS s16x4*)p)); }
template <int NKT, int MODE>
__device__ __forceinline__ void wave_block(const LAS unsigned char* kt, const LAS unsigned char* vt, const bf16x8 (&qf)[2][2], AttState& st, const float (&bias)[2], const bool (&act)[2],
                                           bool boundary, const int (&lo)[2], const int (&hi)[2], int lane, LAS float* imp_row0, int imp_blk0, int imp_stride) {
    const int l15 = lane & 15, lq = lane >> 4;
    if (!act[0] && !act[1]) return;
    bf16x8 kf[NKT][2];
#pragma unroll
    for (int t = 0; t < NKT; ++t)
#pragma unroll
        for (int ks = 0; ks < 2; ++ks) kf[t][ks] = *(const LAS bf16x8*)(kt + (t * 16 + l15) * KT_STRIDE + ks * 64 + lq * 16);
    bf16x8 pfr[2][NKT / 2];
#pragma unroll
    for (int c = 0; c < 2; ++c) {
        if (!act[c]) continue;
        const float c0 = bias[c] - st.m[c];
        f32x4 s[NKT];
#pragma unroll
        for (int t = 0; t < NKT; ++t) { s[t] = (f32x4){c0, c0, c0, c0};
            s[t] = __builtin_amdgcn_mfma_f32_16x16x32_bf16(kf[t][0], qf[c][0], s[t], 0, 0, 0);
            s[t] = __builtin_amdgcn_mfma_f32_16x16x32_bf16(kf[t][1], qf[c][1], s[t], 0, 0, 0); }
        if (boundary) { const int l2 = lo[c] - 4 * lq, h2 = hi[c] - 4 * lq;
#pragma unroll
            for (int t = 0; t < NKT; ++t)
#pragma unroll
                for (int r = 0; r < 4; ++r) { const int kk = t * 16 + r; if (kk < l2 || kk > h2) s[t][r] = S_NEG; } }
        float mx = s[0][0];
#pragma unroll
        for (int t = 0; t < NKT; ++t)
#pragma unroll
            for (int r = 0; r < 4; ++r) mx = fmaxf(mx, s[t][r]);
        mx = fmaxf(mx, __shfl_xor(mx, 16)); mx = fmaxf(mx, __shfl_xor(mx, 32));
        if (MODE == 1) {
            const float dl = fmaxf(mx, 0.f), f = __builtin_amdgcn_exp2f(-dl); st.m[c] += dl; float a = 0.f;
#pragma unroll
            for (int t = 0; t < NKT; ++t)
#pragma unroll
                for (int r = 0; r < 4; ++r) a += __builtin_amdgcn_exp2f(s[t][r] - dl);
            st.l[c] = st.l[c] * f + a;
            continue;
        }
        if (MODE == 0) {
            if (__any(mx > RESC_THR)) {
                const float dl = fmaxf(mx, 0.f), f = __builtin_amdgcn_exp2f(-dl); st.m[c] += dl; st.l[c] *= f;
#pragma unroll
                for (int t = 0; t < NKT; ++t) s[t] = s[t] - dl;
#pragma unroll
                for (int r = 0; r < 4; ++r) { const float fr = __shfl(f, 4 * lq + r);
#pragma unroll
                    for (int dt = 0; dt < 4; ++dt) st.o[c][dt][r] *= fr; }
            }
        }
        float a = 0.f;
#pragma unroll
        for (int t = 0; t < NKT; ++t)
#pragma unroll
            for (int r = 0; r < 4; ++r) { s[t][r] = __builtin_amdgcn_exp2f(s[t][r]); a += s[t][r]; }
        if (MODE == 0) st.l[c] += a;
        if (MODE == 2) {
            const float li = st.l[c];
#pragma unroll
            for (int t = 0; t < NKT; ++t) { s[t] = s[t] * li;
                float ia = 2.f * (s[t][0] + s[t][1] + s[t][2]) + s[t][3], ib = s[t][3];
                ia += __shfl_xor(ia, 1); ia += __shfl_xor(ia, 2); ib += __shfl_xor(ib, 1); ib += __shfl_xor(ib, 2);
                if ((l15 & 3) == 0) { LAS float* ir = imp_row0 + (c * 4 + (l15 >> 2)) * imp_stride + imp_blk0 + 4 * t + lq; atomicAdd((float*)ir, ia); atomicAdd((float*)(ir + 1), ib); } }
        }
#pragma unroll
        for (int G = 0; G < NKT / 2; ++G) {
            v4u pw; pw.x = pg8::cvt_pk_bf16(s[2 * G][0], s[2 * G][1]); pw.y = pg8::cvt_pk_bf16(s[2 * G][2], s[2 * G][3]); pw.z = pg8::cvt_pk_bf16(s[2 * G + 1][0], s[2 * G + 1][1]); pw.w = pg8::cvt_pk_bf16(s[2 * G + 1][2], s[2 * G + 1][3]);
            pfr[c][G] = __builtin_bit_cast(bf16x8, pw); }
    }
    if (MODE == 1) return;
    asm volatile("" ::: "memory");
    const LAS unsigned char* vb = vt + (4 * lq + (l15 >> 2)) * VT_STRIDE + (l15 & 3) * 8;
#pragma unroll
    for (int G = 0; G < NKT / 2; ++G) {
        bf16x8 vf[4];
#pragma unroll
        for (int dt = 0; dt < 4; ++dt) { const s16x4 a = tr_read(vb + (32 * G) * VT_STRIDE + dt * 32), b = tr_read(vb + (32 * G + 16) * VT_STRIDE + dt * 32);
            vf[dt] = (bf16x8){a[0], a[1], a[2], a[3], b[0], b[1], b[2], b[3]}; }
#pragma unroll
        for (int c = 0; c < 2; ++c) { if (!act[c]) continue;
#pragma unroll
            for (int dt = 0; dt < 4; ++dt) st.o[c][dt] = __builtin_amdgcn_mfma_f32_16x16x32_bf16(pfr[c][G], vf[dt], st.o[c][dt], 0, 0, 0); }
        asm volatile("" ::: "memory");
    }
}
__device__ __forceinline__ void att_finish(const AttState& st, int c, int lane, float (&linv)[4]) {
    float l = st.l[c]; l += __shfl_xor(l, 16); l += __shfl_xor(l, 32);
    const float li = 1.0f / fmaxf(l, 1e-30f);
#pragma unroll
    for (int r = 0; r < 4; ++r) linv[r] = __shfl(li, 4 * (lane >> 4) + r);
}
__device__ __forceinline__ void select_blocks(float v0, float v1, int cur, int lane, unsigned long long& sel0, unsigned long long& sel1) {
    const unsigned k0 = __float_as_uint(v0), k1 = __float_as_uint(v1);
    const bool e0 = lane >= 1 && lane <= cur - 2, e1 = (lane + 64) <= cur - 2;
    const int nforced = cur >= 2 ? 3 : cur + 1, need = 16 - nforced, nelig = cur - 2 > 0 ? cur - 2 : 0;
    unsigned long long s0 = 1ull, s1 = 0ull;
    if (cur < 64) s0 |= 1ull << cur; else s1 |= 1ull << (cur - 64);
    if (cur >= 1) { if (cur - 1 < 64) s0 |= 1ull << (cur - 1); else s1 |= 1ull << (cur - 65); }
    if (nelig <= need) { s0 |= __ballot(e0); s1 |= __ballot(e1); }
    else {
        unsigned T = 0u;
        for (int bit = 30; bit >= 0; --bit) { const unsigned cand = T | (1u << bit);
            const int cnt = __popcll(__ballot(e0 && k0 >= cand)) + __popcll(__ballot(e1 && k1 >= cand));
            if (cnt >= need) T = cand; }
        const unsigned long long g0 = __ballot(e0 && k0 > T), g1 = __ballot(e1 && k1 > T);
        unsigned long long q0 = __ballot(e0 && k0 == T), q1 = __ballot(e1 && k1 == T);
        int rem = need - (__popcll(g0) + __popcll(g1));
        s0 |= g0; s1 |= g1;
        while (rem > 0 && (q0 | q1)) { if (q0) { const unsigned long long b = q0 & (~q0 + 1ull); s0 |= b; q0 ^= b; } else { const unsigned long long b = q1 & (~q1 + 1ull); s1 |= b; q1 ^= b; } --rem; }
    }
    sel0 = s0; sel1 = s1;
}

__device__ __forceinline__ unsigned pick4(const unsigned (&a)[4], int i) { return i == 0 ? a[0] : i == 1 ? a[1] : i == 2 ? a[2] : a[3]; }
constexpr int P8_KT = 0, P8_VT = 2 * 64 * KT_STRIDE, P8_IMP = P8_VT + 2 * 64 * VT_STRIDE, P8_SELB = P8_IMP + 64 * 132 * 4, P8_OT = P8_SELB + 64 * 16, P8_END = P8_OT + 8 * 8192;
static_assert(P8_END <= RING_BYTES, "attention LDS");
__device__ __forceinline__ void p8_load(const bf16* kbase, const bf16* vbase, size_t row_stride, int tid, v4u& kr, v4u& vr) {
    asm volatile("" : "+v"(tid));
    const int row = tid >> 3, ch = tid & 7; kr = *(const GAS v4u*)(kbase + (size_t)row * row_stride + ch * 8); vr = *(const GAS v4u*)(vbase + (size_t)row * row_stride + ch * 8); }
__device__ __forceinline__ void p8_store(LAS unsigned char* kt, LAS unsigned char* vt, int tid, const v4u& kr, const v4u& vr) {
    asm volatile("" : "+v"(tid));
    const int row = tid >> 3, ch = tid & 7; *(LAS v4u*)(kt + row * KT_STRIDE + ch * 16) = kr; *(LAS v4u*)(vt + row * VT_STRIDE + ch * 16) = vr; }

__device__ __forceinline__ void p8_prompt_unit(Frame& F, const Args& A, int b, int qb, int g) {
    unsigned char* ws = A.ws; const bf16* KVB = (const bf16*)(ws + WS_KVB); const bf16* QB = (const bf16*)(ws + WS_QB); const bf16* KCP = (const bf16*)(ws + WS_KCP);
    const float* GT = (const float*)(ws + WS_GT); bf16* O = (bf16*)(ws + WS_O);
    LAS unsigned char* L = F.lds + RING_OFF; LAS float* IMP = (LAS float*)(L + P8_IMP); LAS unsigned* SELB = (LAS unsigned*)(L + P8_SELB);
    const int lane = F.lane, w = F.wave, tid = F.tid, l15 = lane & 15, lq = lane >> 4;
    const size_t rowbase = (size_t)b * TP + (size_t)qb * 64;
    bf16x8 qf[2][2];
#pragma unroll
    for (int c = 0; c < 2; ++c)
#pragma unroll
        for (int ks = 0; ks < 2; ++ks) qf[c][ks] = *(const GAS bf16x8*)(QB + (rowbase + 8 * w + 4 * c + (l15 >> 2)) * DM + g * 256 + (l15 & 3) * 64 + ks * 32 + lq * 8);
    int tl[2]; tl[0] = 8 * w + (l15 >> 2); tl[1] = tl[0] + 4;
    for (int i = lane; i < 8 * 132; i += 64) IMP[w * 8 * 132 + i] = 0.f;
    LAS float* OT = (LAS float*)(L + P8_OT) + w * 2048 + lane;
    AttState st; v4u kr, vr; const float zb[2] = {0.f, 0.f}; const bool on[2] = {true, true};
    auto combine = [&](int br) {
#pragma unroll
        for (int c = 0; c < 2; ++c) { float linv[4]; if (br == 0) {
#pragma unroll
                for (int r = 0; r < 4; ++r) linv[r] = 1.f; } else att_finish(st, c, lane, linv);
#pragma unroll
            for (int r = 0; r < 4; ++r) { const float gt = GT[(rowbase + 8 * w + 4 * c + lq) * 48 + g * 12 + r * 3 + br] * linv[r];
#pragma unroll
                for (int d = 0; d < 4; ++d) { LAS float* p = OT + ((c * 4 + d) * 4 + r) * 64; const float v = gt * st.o[c][d][r]; *p = br == 0 ? v : *p + v; } } }
    };
    const int ncv = 4 * qb + 3, ncb = (ncv + 63) >> 6;
    const bf16* kc0 = KCP + (size_t)b * 512 * 512 + g * 64;
    int clo[2] = {0, 0}, chi[2];
    att_init(st);
    for (int pass = 0; pass < 2; ++pass) {
        if (pass == 1) {
#pragma unroll
            for (int c = 0; c < 2; ++c) { float l = st.l[c]; l += __shfl_xor(l, 16); l += __shfl_xor(l, 32); st.l[c] = 1.0f / fmaxf(l, 1e-30f); } }
        __syncthreads();
        p8_load(kc0, kc0 + 256, 512, tid, kr, vr); p8_store(L + P8_KT, L + P8_VT, tid, kr, vr);
        __syncthreads();
        for (int blk = 0; blk < ncb; ++blk) {
            const int buf = blk & 1;
            if (blk + 1 < ncb) p8_load(kc0 + (size_t)(blk + 1) * 64 * 512, kc0 + (size_t)(blk + 1) * 64 * 512 + 256, 512, tid, kr, vr);
#pragma unroll
            for (int c = 0; c < 2; ++c) chi[c] = ((qb * 64 + tl[c] - 31) >> 4) - 64 * blk;
            if (pass == 0) wave_block<4, 1>(L + P8_KT + buf * 64 * KT_STRIDE, L + P8_VT + buf * 64 * VT_STRIDE, qf, st, zb, on, true, clo, chi, lane, nullptr, 0, 0);
            else           wave_block<4, 2>(L + P8_KT + buf * 64 * KT_STRIDE, L + P8_VT + buf * 64 * VT_STRIDE, qf, st, zb, on, true, clo, chi, lane, IMP + w * 8 * 132, blk * 16, 132);
            if (blk + 1 < ncb) p8_store(L + P8_KT + (buf ^ 1) * 64 * KT_STRIDE, L + P8_VT + (buf ^ 1) * 64 * VT_STRIDE, tid, kr, vr);
            __syncthreads();
        }
    }
    combine(0);
    LDS_WAIT();
    for (int t8 = 0; t8 < 8; ++t8) { const LAS float* ir = IMP + (w * 8 + t8) * 132; unsigned long long s0, s1;
        select_blocks(ir[lane], ir[lane + 64], qb, lane, s0, s1);
        if (lane == 0) { LAS unsigned* sb = SELB + (w * 8 + t8) * 4; sb[0] = (unsigned)s0; sb[1] = (unsigned)(s0 >> 32); sb[2] = (unsigned)s1; sb[3] = (unsigned)(s1 >> 32); } }
    LDS_WAIT();
    unsigned mysel[2][4], usel[2][4];
#pragma unroll
    for (int c = 0; c < 2; ++c)
#pragma unroll
        for (int i = 0; i < 4; ++i) { mysel[c][i] = SELB[tl[c] * 4 + i];
            usel[c][i] = __builtin_amdgcn_readfirstlane(SELB[(8 * w + 4 * c + 0) * 4 + i] | SELB[(8 * w + 4 * c + 1) * 4 + i] | SELB[(8 * w + 4 * c + 2) * 4 + i] | SELB[(8 * w + 4 * c + 3) * 4 + i]); }
    {
        att_init(st);
        const bf16* k0 = KVB + (size_t)b * TP * NKV + 512 + g * 64; int lo2[2] = {0, 0}, hi2[2] = {tl[0], tl[1]};
        __syncthreads();
        p8_load(k0, k0 + 256, NKV, tid, kr, vr); p8_store(L + P8_KT, L + P8_VT, tid, kr, vr);
        __syncthreads();
        for (int jb = 0; jb <= qb; ++jb) {
            const int buf = jb & 1;
            if (jb < qb) p8_load(k0 + (size_t)(jb + 1) * 64 * NKV, k0 + (size_t)(jb + 1) * 64 * NKV + 256, NKV, tid, kr, vr);
            float bias[2]; bool act[2];
#pragma unroll
            for (int c = 0; c < 2; ++c) { bias[c] = ((pick4(mysel[c], jb >> 5) >> (jb & 31)) & 1u) ? 0.f : S_NEG; act[c] = ((pick4(usel[c], jb >> 5) >> (jb & 31)) & 1u) != 0u; }
            wave_block<4, 0>(L + P8_KT + buf * 64 * KT_STRIDE, L + P8_VT + buf * 64 * VT_STRIDE, qf, st, bias, act, jb == qb, lo2, hi2, lane, nullptr, 0, 0);
            if (jb < qb) p8_store(L + P8_KT + (buf ^ 1) * 64 * KT_STRIDE, L + P8_VT + (buf ^ 1) * 64 * VT_STRIDE, tid, kr, vr);
            __syncthreads();
        }
        combine(1);
    }
    {
        att_init(st);
        const int jb0 = qb >= 8 ? qb - 8 : 0;
        const bf16* k0 = KVB + (size_t)b * TP * NKV + 1024 + g * 64;
        __syncthreads();
        p8_load(k0 + (size_t)jb0 * 64 * NKV, k0 + (size_t)jb0 * 64 * NKV + 256, NKV, tid, kr, vr); p8_store(L + P8_KT, L + P8_VT, tid, kr, vr);
        __syncthreads();
        for (int jb = jb0; jb <= qb; ++jb) {
            const int buf = (jb - jb0) & 1;
            if (jb < qb) p8_load(k0 + (size_t)(jb + 1) * 64 * NKV, k0 + (size_t)(jb + 1) * 64 * NKV + 256, NKV, tid, kr, vr);
            int lo2[2], hi2[2]; const bool low = (qb >= 8 && jb == qb - 8), top = (jb == qb);
#pragma unroll
            for (int c = 0; c < 2; ++c) { lo2[c] = low ? tl[c] : 0; hi2[c] = top ? tl[c] : 63; }
            wave_block<4, 0>(L + P8_KT + buf * 64 * KT_STRIDE, L + P8_VT + buf * 64 * VT_STRIDE, qf, st, zb, on, low || top, lo2, hi2, lane, nullptr, 0, 0);
            if (jb < qb) p8_store(L + P8_KT + (buf ^ 1) * 64 * KT_STRIDE, L + P8_VT + (buf ^ 1) * 64 * VT_STRIDE, tid, kr, vr);
            __syncthreads();
        }
        combine(2);
    }
#pragma unroll
    for (int c = 0; c < 2; ++c)
#pragma unroll
        for (int r = 0; r < 4; ++r)
#pragma unroll
            for (int d = 0; d < 4; ++d) O[(rowbase + 8 * w + 4 * c + lq) * DM + g * 256 + r * 64 + d * 16 + l15] = (bf16)f2bf(OT[((c * 4 + d) * 4 + r) * 64]);
}

constexpr int P8S_WAVE = 19456, P8S_KT = 0, P8S_VT = 32 * KT_STRIDE, P8S_IMP = P8S_VT + 32 * VT_STRIDE, P8S_OT = P8S_IMP + 8 * 40 * 4, P8S_END = P8S_OT + 8192;
static_assert(P8S_END <= P8S_WAVE && 8 * P8S_WAVE <= RING_BYTES, "sample attention LDS");
__device__ __forceinline__ void p8s_stage_f32(const float* kp, const float* vp, size_t stride, LAS unsigned char* kt, LAS unsigned char* vt, int lane) {
    asm volatile("" : "+v"(lane));
    const int r0 = lane >> 4, ch = lane & 15;
    { f32x4 rk[8];
#pragma unroll
    for (int i = 0; i < 8; ++i) rk[i] = *(const GAS f32x4*)(kp + (size_t)(4 * i + r0) * stride + ch * 4);
#pragma unroll
    for (int i = 0; i < 8; ++i) { v2u a; a.x = pg8::cvt_pk_bf16(rk[i][0], rk[i][1]); a.y = pg8::cvt_pk_bf16(rk[i][2], rk[i][3]); *(LAS v2u*)(kt + (4 * i + r0) * KT_STRIDE + ch * 8) = a; } }
    asm volatile("" ::: "memory");
    { f32x4 rv[8];
#pragma unroll
    for (int i = 0; i < 8; ++i) rv[i] = *(const GAS f32x4*)(vp + (size_t)(4 * i + r0) * stride + ch * 4);
#pragma unroll
    for (int i = 0; i < 8; ++i) { v2u b; b.x = pg8::cvt_pk_bf16(rv[i][0], rv[i][1]); b.y = pg8::cvt_pk_bf16(rv[i][2], rv[i][3]); *(LAS v2u*)(vt + (4 * i + r0) * VT_STRIDE + ch * 8) = b; } }
}
__device__ __forceinline__ void p8s_stage_bf16(const bf16* kp, const bf16* vp, size_t stride, int nrows, LAS unsigned char* kt, LAS unsigned char* vt, int lane) {
    asm volatile("" : "+v"(lane));
    v4u rk[4], rv[4]; const int r0 = lane >> 3, ch = lane & 7;
#pragma unroll
    for (int i = 0; i < 4; ++i) { const int row = 8 * i + r0; rk[i] = (v4u){0u, 0u, 0u, 0u}; rv[i] = rk[i];
        if (row < nrows) { rk[i] = *(const GAS v4u*)(kp + (size_t)row * stride + ch * 8); rv[i] = *(const GAS v4u*)(vp + (size_t)row * stride + ch * 8); } }
#pragma unroll
    for (int i = 0; i < 4; ++i) { const int row = 8 * i + r0; *(LAS v4u*)(kt + row * KT_STRIDE + ch * 16) = rk[i]; *(LAS v4u*)(vt + row * VT_STRIDE + ch * 16) = rv[i]; }
}
__device__ __forceinline__ void p8_sample_unit(Frame& F, const Args& A, int n, int g) {
    unsigned char* ws = A.ws; const bf16* KVB = (const bf16*)(ws + WS_KVB); const bf16* QB = (const bf16*)(ws + WS_QB); const bf16* KCS = (const bf16*)(ws + WS_KCS);
    const float* GT = (const float*)(ws + WS_GT); bf16* O = (bf16*)(ws + WS_O); const int* ptab = (const int*)A.in[I_PT];
    LAS unsigned char* L = F.lds + RING_OFF + F.wave * P8S_WAVE; LAS unsigned char* kt = L + P8S_KT; LAS unsigned char* vt = L + P8S_VT; LAS float* IMP = (LAS float*)(L + P8S_IMP);
    const int lane = F.lane, l15 = lane & 15, lq = lane >> 4;
    const size_t rowbase = (size_t)MP + (size_t)n * TS;
    bf16x8 qf[2][2];
#pragma unroll
    for (int c = 0; c < 2; ++c)
#pragma unroll
        for (int ks = 0; ks < 2; ++ks) qf[c][ks] = *(const GAS bf16x8*)(QB + (rowbase + 4 * c + (l15 >> 2)) * DM + g * 256 + (l15 & 3) * 64 + ks * 32 + lq * 8);
    int tl[2]; tl[0] = l15 >> 2; tl[1] = tl[0] + 4;
    for (int i = lane; i < 8 * 40; i += 64) IMP[i] = 0.f;
    LAS float* OT = (LAS float*)(L + P8S_OT) + lane;
    AttState st; const float zb[2] = {0.f, 0.f}; const bool on[2] = {true, true};
    auto combine = [&](int br) {
#pragma unroll
        for (int c = 0; c < 2; ++c) { float linv[4]; if (br == 0) {
#pragma unroll
                for (int r = 0; r < 4; ++r) linv[r] = 1.f; } else att_finish(st, c, lane, linv);
#pragma unroll
            for (int r = 0; r < 4; ++r) { const float gt = GT[(rowbase + 4 * c + lq) * 48 + g * 12 + r * 3 + br] * linv[r];
#pragma unroll
                for (int d = 0; d < 4; ++d) { LAS float* p = OT + ((c * 4 + d) * 4 + r) * 64; const float v = gt * st.o[c][d][r]; *p = br == 0 ? v : *p + v; } } }
    };
#define WSYNC() do { LDS_WAIT(); asm volatile("" ::: "memory"); } while (0)
    const bf16* kc0 = KCS + (size_t)n * 128 * 512 + g * 64;
    int clo[2] = {0, 0}, chi[2];
    att_init(st);
    for (int pass = 0; pass < 2; ++pass) {
        if (pass == 1) {
#pragma unroll
            for (int c = 0; c < 2; ++c) { float l = st.l[c]; l += __shfl_xor(l, 16); l += __shfl_xor(l, 32); st.l[c] = 1.0f / fmaxf(l, 1e-30f); } }
        for (int hb = 0; hb < 4; ++hb) {
            WSYNC(); p8s_stage_bf16(kc0 + (size_t)hb * 32 * 512, kc0 + (size_t)hb * 32 * 512 + 256, 512, 32, kt, vt, lane); WSYNC();
            chi[0] = 126 - 32 * hb; chi[1] = chi[0];
            if (pass == 0) wave_block<2, 1>(kt, vt, qf, st, zb, on, hb == 3, clo, chi, lane, nullptr, 0, 0);
            else           wave_block<2, 2>(kt, vt, qf, st, zb, on, hb == 3, clo, chi, lane, IMP, hb * 8, 40);
        }
    }
    combine(0);
    WSYNC();
    unsigned selw[8][2];
#pragma unroll
    for (int t8 = 0; t8 < 8; ++t8) { unsigned long long s0, s1; const float v0 = lane < 33 ? IMP[t8 * 40 + lane] : 0.f; select_blocks(v0, 0.f, 32, lane, s0, s1); selw[t8][0] = (unsigned)s0; selw[t8][1] = (unsigned)(s0 >> 32); }
    unsigned mysel[2][2], usel[2][2];
#pragma unroll
    for (int c = 0; c < 2; ++c)
#pragma unroll
        for (int i = 0; i < 2; ++i) { const int tt = l15 >> 2; const unsigned a0 = selw[4 * c + 0][i], a1 = selw[4 * c + 1][i], a2 = selw[4 * c + 2][i], a3 = selw[4 * c + 3][i];
            mysel[c][i] = tt == 0 ? a0 : tt == 1 ? a1 : tt == 2 ? a2 : a3; usel[c][i] = __builtin_amdgcn_readfirstlane(a0 | a1 | a2 | a3); }
    {
        att_init(st);
        const float* cache = A.in[I_CSLC]; int lo2[2] = {0, 0}, hi2[2] = {tl[0], tl[1]};
        for (int hb = 0; hb <= 64; ++hb) {
            const int jb = hb >> 1; float bias[2]; bool act[2];
#pragma unroll
            for (int c = 0; c < 2; ++c) { const unsigned wm = jb < 32 ? mysel[c][0] : mysel[c][1], wu = jb < 32 ? usel[c][0] : usel[c][1];
                bias[c] = ((wm >> (jb & 31)) & 1u) ? 0.f : S_NEG; act[c] = ((wu >> (jb & 31)) & 1u) != 0u; }
            if (!act[0] && !act[1]) continue;
            WSYNC();
            if (hb < 64) { const int pg = ptab[n * NPAGE + (hb >> 2)]; const float* kp = cache + ((size_t)pg * PAGE + (hb & 3) * 32) * 512 + g * 64; p8s_stage_f32(kp, kp + 256, 512, kt, vt, lane); }
            else { const bf16* kp = KVB + rowbase * NKV + 512 + g * 64; p8s_stage_bf16(kp, kp + 256, NKV, 8, kt, vt, lane); }
            WSYNC();
            wave_block<2, 0>(kt, vt, qf, st, bias, act, hb == 64, lo2, hi2, lane, nullptr, 0, 0);
        }
        combine(1);
    }
    {
        att_init(st);
        const float* sw = A.in[I_SWIN] + (size_t)n * 512 * 512 + 1 * 0 + g * 64;
        for (int hb = 0; hb <= 16; ++hb) {
            WSYNC();
            if (hb < 16) p8s_stage_f32(sw + (size_t)hb * 32 * 512, sw + (size_t)hb * 32 * 512 + 256, 512, kt, vt, lane);
            else { const bf16* kp = KVB + rowbase * NKV + 1024 + g * 64; p8s_stage_bf16(kp, kp + 256, NKV, 8, kt, vt, lane); }
            WSYNC();
            int lo2[2], hi2[2];
#pragma unroll
            for (int c = 0; c < 2; ++c) { lo2[c] = tl[c] - 32 * hb; hi2[c] = 512 + tl[c] - 32 * hb; }
            wave_block<2, 0>(kt, vt, qf, st, zb, on, hb == 0 || hb == 16, lo2, hi2, lane, nullptr, 0, 0);
        }
        combine(2);
    }
#undef WSYNC
#pragma unroll
    for (int c = 0; c < 2; ++c)
#pragma unroll
        for (int r = 0; r < 4; ++r)
#pragma unroll
            for (int d = 0; d < 4; ++d) O[(rowbase + 4 * c + lq) * DM + g * 256 + r * 64 + d * 16 + l15] = (bf16)f2bf(OT[((c * 4 + d) * 4 + r) * 64]);
}
__device__ __forceinline__ void p8_attention(Frame& F, const Args& A) {
    for (int u = F.vcu + F.G * F.wave; u < NBS * 4; u += F.G * NWAVES) p8_sample_unit(F, A, u >> 2, u & 3);
    __syncthreads();
    for (int u = F.vcu; u < NBP * 128 * 4; u += F.G) { const int qb = 127 - (u >> 3), b = (u >> 2) & 1, g = u & 3; p8_prompt_unit(F, A, b, qb, g); }
}
#define P8_BODY p8_attention(F, args);
constexpr int N_PHASES = 14;
__global__ void __launch_bounds__(NWAVES * 64, 2) yoco_fwd(Args args) {
    extern __shared__ __attribute__((aligned(16))) unsigned char lds[];
    Frame F;
    F.lds = (LAS unsigned char*)lds; F.MISC = (volatile LAS unsigned*)(F.lds + MISC_OFF);
    F.tid = threadIdx.x; F.lane = F.tid & 63; F.wave = __builtin_amdgcn_readfirstlane(F.tid >> 6);
    F.G = gridDim.x; { const int bx = blockIdx.x; F.vcu = (F.G % 8 == 0) ? (bx % 8) * (F.G / 8) + bx / 8 : bx; }
    unsigned char* ws = args.ws;
    F.ctl = (gu32*)(ws + WS_CTL);
    for (int u = F.tid; u < (LDS_BYTES - LDSCTL_OFF) / 4; u += NWAVES * 64) ((LAS unsigned*)(F.lds + LDSCTL_OFF))[u] = 0u;
    __syncthreads();
    const int lo = args.ph_lo, hi = args.ph_hi;
    const bool multi = (hi - lo) > 1;
    XcdBarrier bar; bar.bar = (unsigned*)(F.ctl + CW_BAR); bar.x = 0; bar.st = nullptr;
    if (multi) bar = xcd_barrier_post((unsigned*)(F.ctl + CW_BAR), F.MISC + 8);
#define IN(k) (lo <= (k) && (k) < hi)
#define SEAM(k) do { if (IN(k) && IN((k) + 1)) xcd_barrier(bar); } while (0)
    bf16* const XB = (bf16*)(ws + WS_XB); bf16* const BBp = (bf16*)(ws + WS_BB); bf16* const VBp = (bf16*)(ws + WS_VB); bf16* const Zp = (bf16*)(ws + WS_Z);
    float* const Hp = (float*)(ws + WS_H); bf16* const HBp = (bf16*)(ws + WS_HB); bf16* const ACTp = (bf16*)(ws + WS_ACT); bf16* const KVBp = (bf16*)(ws + WS_KVB);
    bf16* const QBp = (bf16*)(ws + WS_QB); bf16* const Op = (bf16*)(ws + WS_O); float* const GTp = (float*)(ws + WS_GT);
    float* const SSQ = (float*)(ws + WS_SSQ); constexpr size_t SSQ_STRIDE = (size_t)MT * 16;
    const int c = (int)blockIdx.x;

    if (IN(0)) { p0_prologue(F, args); }
    SEAM(0);
    if (IN(1)) { pg8::Gemm g{XB, (const bf16*)(ws + WS_WAIN), MT, NAIN, DM}; pg8::StaticOrder S; S.init(MT, NAIN, F.G, c);
        pg8::EpiAin E{VBp, BBp, (const float*)(ws + WS_RSTD0)};
        pg8::gemm_phase<pg8::EpiAin, pg8::StaticOrder, PG8_ALIGN, PG8_SP2>(F.lds + RING_OFF, g, S, E); }
    SEAM(1);
    if (IN(2)) { p2_conv(F, args); }
    SEAM(2);
    if (IN(3)) { pg8::Gemm g{Zp, (const bf16*)(ws + WS_WAOUT), MT, DM, DM}; pg8::StaticOrder S; S.init(MT, DM, F.G, c);
        pg8::EpiRes E{args.in[I_XP], args.in[I_XS], Hp, HBp, SSQ + 0 * SSQ_STRIDE};
        pg8::gemm_phase<pg8::EpiRes, pg8::StaticOrder, PG8_ALIGN, PG8_SP2>(F.lds + RING_OFF, g, S, E); }
    SEAM(3);
    if (IN(4)) { pg8::Gemm g{HBp, (const bf16*)(ws + WS_WFIN0), MT, NFF, DM}; pg8::StaticOrder S; S.init(MT, NFF, F.G, c);
        pg8::EpiFfn E{ACTp, SSQ + 0 * SSQ_STRIDE};
        pg8::gemm_phase<pg8::EpiFfn, pg8::StaticOrder, PG8_ALIGN, PG8_SP2>(F.lds + RING_OFF, g, S, E); }
    SEAM(4);
    if (IN(5)) { pg8::Gemm g{ACTp, (const bf16*)(ws + WS_WFOUT0), MT, DM, DFF}; pg8::StaticOrder S; S.init(MT, DM, F.G, c);
        pg8::EpiRes E{Hp, Hp + (size_t)MP * DM, Hp, HBp, SSQ + 1 * SSQ_STRIDE};
        pg8::gemm_phase<pg8::EpiRes, pg8::StaticOrder, PG8_ALIGN, PG8_SP2>(F.lds + RING_OFF, g, S, E); }
    SEAM(5);
    if (IN(6)) { pg8::Gemm g{HBp, (const bf16*)(ws + WS_WKVQ), MT, NKVQ, DM}; pg8::StaticOrder S; S.init(MT, NKVQ, F.G, c);
        pg8::EpiKvq E{KVBp, QBp, GTp, SSQ + 1 * SSQ_STRIDE, args.out + O_CMPP, args.out + O_CMPS, args.out + O_SLCP, args.out + O_SLCS, args.out + O_WINP, args.out + O_WINS};
        pg8::gemm_phase<pg8::EpiKvq, pg8::StaticOrder, PG8_ALIGN, PG8_SP2>(F.lds + RING_OFF, g, S, E); }
    SEAM(6);
    if (IN(7)) { P7_BODY }
    SEAM(7);
    if (IN(8)) { P8_BODY }
    SEAM(8);
    if (IN(9)) { pg8::Gemm g{Op, (const bf16*)(ws + WS_WBOUT), MT, DM, DM}; pg8::StaticOrder S; S.init(MT, DM, F.G, c);
        pg8::EpiRes E{Hp, Hp + (size_t)MP * DM, Hp, HBp, SSQ + 2 * SSQ_STRIDE};
        pg8::gemm_phase<pg8::EpiRes, pg8::StaticOrder, PG8_ALIGN, PG8_SP2>(F.lds + RING_OFF, g, S, E); }
    SEAM(9);
    if (IN(10)) { pg8::Gemm g{HBp, (const bf16*)(ws + WS_WFIN1), MT, NFF, DM}; pg8::StaticOrder S; S.init(MT, NFF, F.G, c);
        pg8::EpiFfn E{ACTp, SSQ + 2 * SSQ_STRIDE};
        pg8::gemm_phase<pg8::EpiFfn, pg8::StaticOrder, PG8_ALIGN, PG8_SP2>(F.lds + RING_OFF, g, S, E); }
    SEAM(10);
    if (IN(11)) { pg8::Gemm g{ACTp, (const bf16*)(ws + WS_WFOUT1), MT, DM, DFF}; pg8::StaticOrder S; S.init(MT, DM, F.G, c);
        pg8::EpiRes E{Hp, Hp + (size_t)MP * DM, Hp, nullptr, nullptr};
        pg8::gemm_phase<pg8::EpiRes, pg8::StaticOrder, PG8_ALIGN, PG8_SP2>(F.lds + RING_OFF, g, S, E); }
    SEAM(11);
    if (IN(12)) { p_final(F, args); }
#undef IN
#undef SEAM
}

#ifndef MK_PER_PHASE
#define MK_PER_PHASE 0
#endif
extern "C" void kernel_launch(void* const* d_in, const int* in_sizes, int n_in, void* d_out, int out_size, void* d_ws, size_t ws_size, hipStream_t stream) {
    static int grid = 0;
    if (grid == 0) {
        if (n_in != 21 || out_size != (int)O_END || ws_size < WS_END) { fprintf(stderr, "kernel_launch: unexpected shapes (n_in %d out %d ws %zu)\n", n_in, out_size, ws_size); grid = -1; return; }
        int dev = 0, cus = 0, per_cu = 0;
        if (hipGetDevice(&dev) != hipSuccess || hipDeviceGetAttribute(&cus, hipDeviceAttributeMultiprocessorCount, dev) != hipSuccess) { grid = -1; return; }
        if (hipFuncSetAttribute((const void*)yoco_fwd, hipFuncAttributeMaxDynamicSharedMemorySize, LDS_BYTES) != hipSuccess) { fprintf(stderr, "kernel_launch: hipFuncSetAttribute failed\n"); grid = -1; return; }
        if (hipOccupancyMaxActiveBlocksPerMultiprocessor(&per_cu, (const void*)yoco_fwd, NWAVES * 64, LDS_BYTES) != hipSuccess || per_cu < 1) { fprintf(stderr, "kernel_launch: occupancy query says %d\n", per_cu); }
        (void)hipGetLastError();
        grid = cus;
    }
    if (grid < 0) return;
    if (hipMemsetAsync((char*)d_ws + WS_CTL, 0, CTL_ZERO_BYTES, stream) != hipSuccess) return;
    Args a{};
    for (int i = 0; i < 21; ++i) a.in[i] = (const float*)d_in[i];
    a.out = (float*)d_out; a.ws = (unsigned char*)d_ws;
#if MK_PER_PHASE
    for (int p = 0; p < N_PHASES - 1; ++p) { a.ph_lo = p; a.ph_hi = p + 1; hipLaunchKernelGGL(yoco_fwd, dim3(grid), dim3(NWAVES * 64), LDS_BYTES, stream, a); }
#else
    a.ph_lo = 0; a.ph_hi = N_PHASES; hipLaunchKernelGGL(yoco_fwd, dim3(grid), dim3(NWAVES * 64), LDS_BYTES, stream, a);
#endif
}
```

```cpp
#include <hip/hip_runtime.h>
#include <cstdio>
#include <cstdint>
namespace pg8 {
#define PG8_LAS __attribute__((address_space(3)))
typedef unsigned short bf16_t;
typedef short bf16x8 __attribute__((ext_vector_type(8)));
typedef float f32x4 __attribute__((ext_vector_type(4)));
typedef unsigned u32x4 __attribute__((ext_vector_type(4)));
constexpr int BM = 256, BK = 64, HALF = 128, HTB = HALF * BK * 2  , STAGE_BYTES = 8 * HTB, NXCD = 8, WGM = 8;

__host__ __device__ __forceinline__ int lds_byte(int r, int c) { const int st = (r >> 4) * 2 + (c >> 5), rr = r & 15, cc = c & 31, ob = rr * 64 + cc * 2; return st * 1024 + (ob ^ (((ob >> 9) & 1) << 5)); }
__host__ __device__ __forceinline__ void stage_rc(int b, int& R, int& C) { const int st = b / 1024, sb = b % 1024, swz = sb ^ (((sb >> 9) & 1) << 5); R = (st >> 1) * 16 + swz / 64; C = (st & 1) * 32 + (swz % 64) / 2; }
__host__ __device__ __forceinline__ int perm32(int rho) { const int n = rho >> 4, i = rho & 15; return 8 * (i >> 2) + 4 * n + (i & 3); }

struct Unit { int pm, pn; };
struct Gemm { const bf16_t* A; const bf16_t* Bt; int M, N, K; };

struct StaticOrder {
    int nM, nN, nwg, G, c;
    __host__ __device__ void init(int M, int N, int G_, int c_) { nM = M / BM; nN = N / BM; nwg = nM * nN; G = G_; c = c_; }
    __host__ __device__ bool next(int i, Unit& u) const {
        const long L = (long)i * G + c; if (L >= nwg) return false;
        int wgid = (int)L; { const int q = nwg / NXCD, r = nwg % NXCD, xcd = wgid % NXCD, off = wgid / NXCD; wgid = (xcd < r ? xcd * (q + 1) : r * (q + 1) + (xcd - r) * q) + off; }
        const int nig = WGM * nN, gid = wgid / nig, fm = gid * WGM, gsz = (nM - fm) < WGM ? (nM - fm) : WGM;
        u.pm = fm + ((wgid % nig) % gsz); u.pn = (wgid % nig) / gsz; return true;
    }
    __device__ __forceinline__ void a_ready(const Unit&) const {}
    __device__ __forceinline__ void done(const Unit&) const {}
};

__device__ __forceinline__ unsigned cvt_pk_bf16(float lo, float hi) { unsigned r; asm volatile("v_cvt_pk_bf16_f32 %0, %1, %2" : "=v"(r) : "v"(lo), "v"(hi)); return r; }
constexpr int E_MP = 16384;
constexpr float E_EPS = 1e-6f;
__device__ __forceinline__ float row_rstd16(const float* ssqp, int row, int fq) {
    const f32x4 p = *(const f32x4*)(ssqp + (size_t)row * 16 + fq * 4);
    float s = (p[0] + p[1]) + (p[2] + p[3]); s += __shfl_xor(s, 16); s += __shfl_xor(s, 32);
    return __builtin_amdgcn_rsqf(s * (1.0f / 1024.0f) + E_EPS);
}
__device__ __forceinline__ u32x4 pack8(const f32x4 a, const f32x4 b) { u32x4 w; w.x = cvt_pk_bf16(a[0], a[1]); w.y = cvt_pk_bf16(a[2], a[3]); w.z = cvt_pk_bf16(b[0], b[1]); w.w = cvt_pk_bf16(b[2], b[3]); return w; }

struct EpiAin {
    static constexpr bool PERM = true, AFTER_DRAIN = false;
    bf16_t* VB; bf16_t* BB; const float* rstd;
    __device__ __forceinline__ void operator()(const f32x4 (&acc)[2][2][4][2], const Unit& u, int wr, int wc, int fr, int fq) const {
        const int row0 = u.pm * BM + wr * 64 + fr;
        if (u.pn < 8) {
            const int ch = u.pn * 128 + wc * 32 + 8 * fq;
#pragma unroll
            for (int ai = 0; ai < 2; ++ai)
#pragma unroll
                for (int m = 0; m < 4; ++m) { const int row = row0 + ai * HALF + m * 16; const float r = rstd[row], r2 = r * r;
                    const f32x4 v0 = acc[ai][0][m][0] * acc[ai][1][m][0] * r2, v1 = acc[ai][0][m][1] * acc[ai][1][m][1] * r2;
                    *(u32x4*)(VB + (size_t)row * 1024 + ch) = pack8(v0, v1); }
        } else {
            const int ch = (u.pn - 8) * 256 + wc * 32 + 8 * fq;
#pragma unroll
            for (int ai = 0; ai < 2; ++ai)
#pragma unroll
                for (int m = 0; m < 4; ++m) { const int row = row0 + ai * HALF + m * 16; const float r = rstd[row];
#pragma unroll
                    for (int bj = 0; bj < 2; ++bj) *(u32x4*)(BB + (size_t)row * 1024 + ch + bj * HALF) = pack8(acc[ai][bj][m][0] * r, acc[ai][bj][m][1] * r); }
        }
    }
};
struct EpiRes {
    static constexpr bool PERM = true, AFTER_DRAIN = false;
    const float* base_p; const float* base_s; float* H; bf16_t* HB; float* ssqp;
    __device__ __forceinline__ void operator()(const f32x4 (&acc)[2][2][4][2], const Unit& u, int wr, int wc, int fr, int fq) const {
        const int row0 = u.pm * BM + wr * 64 + fr, col0 = u.pn * BM + wc * 32 + 8 * fq;
#pragma unroll
        for (int ai = 0; ai < 2; ++ai)
#pragma unroll
            for (int m = 0; m < 4; ++m) { const int row = row0 + ai * HALF + m * 16;
                const float* b = (row < E_MP ? base_p + (size_t)row * 1024 : base_s + (size_t)(row - E_MP) * 1024) + col0;
                float* h = H + (size_t)row * 1024 + col0; float ss = 0.f;
#pragma unroll
                for (int bj = 0; bj < 2; ++bj) {
                    const f32x4 h0 = *(const f32x4*)(b + bj * HALF) + acc[ai][bj][m][0], h1 = *(const f32x4*)(b + bj * HALF + 4) + acc[ai][bj][m][1];
                    *(f32x4*)(h + bj * HALF) = h0; *(f32x4*)(h + bj * HALF + 4) = h1;
                    if (HB) *(u32x4*)(HB + (size_t)row * 1024 + col0 + bj * HALF) = pack8(h0, h1);
                    ss += (h0[0] * h0[0] + h0[1] * h0[1]) + (h0[2] * h0[2] + h0[3] * h0[3]) + (h1[0] * h1[0] + h1[1] * h1[1]) + (h1[2] * h1[2] + h1[3] * h1[3]); }
                ss += __shfl_xor(ss, 16); ss += __shfl_xor(ss, 32);
                if (fq == 0 && ssqp) ssqp[(size_t)row * 16 + u.pn * 4 + wc] = ss;
                if (m & 1) asm volatile("" ::: "memory"); }
    }
};
struct EpiFfn {
    static constexpr bool PERM = true, AFTER_DRAIN = false;
    bf16_t* ACT; const float* ssqp;
    __device__ __forceinline__ void operator()(const f32x4 (&acc)[2][2][4][2], const Unit& u, int wr, int wc, int fr, int fq) const {
        const int row0 = u.pm * BM + wr * 64 + fr, ch = u.pn * 128 + wc * 32 + 8 * fq;
#pragma unroll
        for (int ai = 0; ai < 2; ++ai)
#pragma unroll
            for (int m = 0; m < 4; ++m) { const int row = row0 + ai * HALF + m * 16; const float r = row_rstd16(ssqp, row, fq);
                f32x4 o[2];
#pragma unroll
                for (int n = 0; n < 2; ++n)
#pragma unroll
                    for (int e = 0; e < 4; ++e) { const float g = acc[ai][0][m][n][e] * r, up = acc[ai][1][m][n][e] * r;
                        o[n][e] = g * up * __builtin_amdgcn_rcpf(1.0f + __builtin_amdgcn_exp2f(g * -1.4426950408889634f)); }
                *(u32x4*)(ACT + (size_t)row * 2816 + ch) = pack8(o[0], o[1]); }
    }
};
struct EpiKvq {
    static constexpr bool PERM = true, AFTER_DRAIN = false;
    bf16_t* KVB; bf16_t* QB; float* GT; const float* ssqp;
    float *cmp_p, *cmp_s, *slc_p, *slc_s, *win_p, *win_s;
    __device__ __forceinline__ void operator()(const f32x4 (&acc)[2][2][4][2], const Unit& u, int wr, int wc, int fr, int fq) const {
        const int row0 = u.pm * BM + wr * 64 + fr, cw = wc * 32 + 8 * fq;
#pragma unroll
        for (int ai = 0; ai < 2; ++ai)
#pragma unroll
            for (int m = 0; m < 4; ++m) { const int row = row0 + ai * HALF + m * 16; const float r = row_rstd16(ssqp, row, fq);
                if (u.pn < 6) {
                    const int br = u.pn >> 1; float* orow = nullptr;
                    if (row < E_MP) { if (br == 0) orow = cmp_p + (size_t)row * 512; else if (br == 1) orow = slc_p + (size_t)row * 512;
                        else { const int t = row & 8191; if (t >= 7680) orow = win_p + ((size_t)(row >> 13) * 512 + (t - 7680)) * 512; } }
                    else { const int rs = row - E_MP; if (br == 0) orow = cmp_s + (size_t)rs * 512; else if (br == 1) orow = slc_s + (size_t)rs * 512;
                        else orow = win_s + ((size_t)(rs >> 3) * 512 + 504 + (rs & 7)) * 512; }
#pragma unroll
                    for (int bj = 0; bj < 2; ++bj) { const int col = u.pn * BM + bj * HALF + cw; const f32x4 a = acc[ai][bj][m][0] * r, b = acc[ai][bj][m][1] * r;
                        *(u32x4*)(KVB + (size_t)row * 1536 + col) = pack8(a, b);
                        if (orow) { *(f32x4*)(orow + (col & 511)) = a; *(f32x4*)(orow + (col & 511) + 4) = b; } }
                } else if (u.pn < 10) {
#pragma unroll
                    for (int bj = 0; bj < 2; ++bj) { const int col = (u.pn - 6) * BM + bj * HALF + cw;
                        *(u32x4*)(QB + (size_t)row * 1024 + col) = pack8(acc[ai][0 + bj][m][0] * r, acc[ai][0 + bj][m][1] * r); }
                } else {
                    if (cw < 48) {
                        f32x4 s0, s1;
#pragma unroll
                        for (int e = 0; e < 4; ++e) { s0[e] = __builtin_amdgcn_rcpf(1.0f + __builtin_amdgcn_exp2f(acc[ai][0][m][0][e] * r * -1.4426950408889634f));
                                                      s1[e] = __builtin_amdgcn_rcpf(1.0f + __builtin_amdgcn_exp2f(acc[ai][0][m][1][e] * r * -1.4426950408889634f)); }
                        *(f32x4*)(GT + (size_t)row * 48 + cw) = s0; *(f32x4*)(GT + (size_t)row * 48 + cw + 4) = s1; }
                }
            }
    }
};
template <class Epi, class Sched, bool ALIGN_EPI = false, bool SP2 = false>
__device__ __forceinline__ void gemm_phase(PG8_LAS unsigned char* lds, const Gemm g, const Sched& S, const Epi& E) {
    const int tid = threadIdx.x, wid = __builtin_amdgcn_readfirstlane(tid >> 6), lane = tid & 63, wr = wid >> 2, wc = wid & 3, fr = lane & 15, fq = lane >> 4;
    const int K = g.K, nt = K / BK;
    unsigned voffA[2], voffB[2];
#pragma unroll
    for (int i = 0; i < 2; ++i) { int R, C; stage_rc(tid * 16 + i * 8192, R, C); const int Rb = Epi::PERM ? ((R & ~31) + perm32(R & 31)) : R;
        voffA[i] = (unsigned)(R * K + C) * 2u; voffB[i] = (unsigned)(Rb * K + C) * 2u; }
    const size_t kstep = (size_t)(BK * 2);
    const size_t hstep = (size_t)HALF * K * 2;
    const size_t tstep = 2 * hstep;
    const unsigned ldsw = (unsigned)wid * 1024u;
    const int aoff = lds_byte(wr * 64 + fr, fq * 8), boff = lds_byte(wc * 32 + fr, fq * 8);
#define PG8_SA(b, h) (((b) * 2 + (h)) * HTB)
#define PG8_SB(b, h) ((4 + (b) * 2 + (h)) * HTB)
#define PG8_STAGE(bufoff, gbase, voff) do { _Pragma("unroll") for (int _i = 0; _i < 2; ++_i) \
        __builtin_amdgcn_global_load_lds((const unsigned*)((const char*)(gbase) + (voff)[_i]), (PG8_LAS unsigned*)(lds + (bufoff) + ldsw + _i * 8192), 16, 0, 0); } while (0)
#define PG8_LDA(dst, b, h) do { _Pragma("unroll") for (int m = 0; m < 4; ++m) _Pragma("unroll") for (int k = 0; k < 2; ++k) dst[m][k] = *(const PG8_LAS bf16x8*)(lds + PG8_SA(b, h) + aoff + m * 2048 + k * 1024); } while (0)
#define PG8_LDB(dst, b, h) do { _Pragma("unroll") for (int n = 0; n < 2; ++n) _Pragma("unroll") for (int k = 0; k < 2; ++k) dst[n][k] = *(const PG8_LAS bf16x8*)(lds + PG8_SB(b, h) + boff + n * 2048 + k * 1024); } while (0)
#define PG8_MMA(ai, bj, At, Bt) do { __builtin_amdgcn_s_setprio(1); _Pragma("unroll") for (int m = 0; m < 4; ++m) _Pragma("unroll") for (int n = 0; n < 2; ++n) _Pragma("unroll") for (int k = 0; k < 2; ++k) \
        acc[ai][bj][m][n] = __builtin_amdgcn_mfma_f32_16x16x32_bf16(Bt[n][k], At[m][k], acc[ai][bj][m][n], 0, 0, 0); __builtin_amdgcn_s_setprio(0); } while (0)
#define PG8_WAIT_V(n) asm volatile("s_waitcnt vmcnt(" #n ")" ::: "memory")
#define PG8_WAIT_L(n) asm volatile("s_waitcnt lgkmcnt(" #n ")" ::: "memory")
#define PG8_BAR __builtin_amdgcn_s_barrier()
#define PG8_SCHED __builtin_amdgcn_sched_barrier(0)
    Unit cur, nxt; int ui = 0;
    if (!S.next(0, cur)) return;
    f32x4 acc[2][2][4][2];
#pragma unroll
    for (int a = 0; a < 2; ++a)
#pragma unroll
        for (int b = 0; b < 2; ++b)
#pragma unroll
            for (int m = 0; m < 4; ++m)
#pragma unroll
                for (int n = 0; n < 2; ++n) acc[a][b][m][n] = (f32x4){0.f, 0.f, 0.f, 0.f};
    bf16x8 At[4][2], B0[2][2], B1[2][2];
    const char* cA = (const char*)g.A + (size_t)cur.pm * tstep; const char* cB = (const char*)g.Bt + (size_t)cur.pn * tstep;
    S.a_ready(cur);
    if constexpr (SP2) {
        PG8_STAGE(PG8_SB(0, 0), cB, voffB); PG8_STAGE(PG8_SB(0, 1), cB + hstep, voffB); PG8_STAGE(PG8_SA(0, 0), cA, voffA); PG8_STAGE(PG8_SA(0, 1), cA + hstep, voffA);
        if (wr == 1) PG8_BAR;
        PG8_WAIT_V(2); PG8_BAR;
        PG8_STAGE(PG8_SB(1, 0), cB + kstep, voffB); PG8_STAGE(PG8_SA(1, 0), cA + kstep, voffA); PG8_STAGE(PG8_SB(1, 1), cB + hstep + kstep, voffB);
        PG8_WAIT_V(6); PG8_BAR;
    } else {
        PG8_STAGE(PG8_SB(0, 0), cB, voffB); PG8_STAGE(PG8_SA(0, 0), cA, voffA); PG8_STAGE(PG8_SB(0, 1), cB + hstep, voffB); PG8_STAGE(PG8_SA(0, 1), cA + hstep, voffA);
        if (wr == 1) PG8_BAR;
        PG8_WAIT_V(4); PG8_BAR;
        PG8_STAGE(PG8_SB(1, 0), cB + kstep, voffB); PG8_STAGE(PG8_SA(1, 0), cA + kstep, voffA); PG8_STAGE(PG8_SB(1, 1), cB + hstep + kstep, voffB);
        PG8_WAIT_V(6); PG8_BAR;
    }
    for (;;) {
        const bool has_next = S.next(ui + 1, nxt);
        const char* nA = has_next ? (const char*)g.A + (size_t)nxt.pm * tstep : cA; const char* nB = has_next ? (const char*)g.Bt + (size_t)nxt.pn * tstep : cB;
        for (int t = 0; t < nt; t += 2) {
            const bool last = (t == nt - 2);
            const char* a1 = cA + (size_t)(t + 1) * kstep;
            const char* a2 = last ? nA : cA + (size_t)(t + 2) * kstep; const char* b2 = last ? nB : cB + (size_t)(t + 2) * kstep;
            const char* a3 = a2 + kstep; const char* b3 = b2 + kstep;
            if (last && has_next) S.a_ready(nxt);
            if constexpr (SP2) {
            PG8_LDB(B0, 0, 0); PG8_LDB(B1, 0, 1); PG8_SCHED; PG8_LDA(At, 0, 0); PG8_STAGE(PG8_SA(1, 1), a1 + hstep, voffA);
            PG8_WAIT_V(8); PG8_WAIT_L(0); PG8_BAR; PG8_MMA(0, 0, At, B0); PG8_MMA(0, 1, At, B1); PG8_BAR; PG8_SCHED;
            PG8_LDA(At, 0, 1); PG8_STAGE(PG8_SB(0, 0), b2, voffB); PG8_STAGE(PG8_SB(0, 1), b2 + hstep, voffB); PG8_STAGE(PG8_SA(0, 0), a2, voffA);
            PG8_WAIT_V(8); PG8_WAIT_L(0); PG8_BAR; PG8_MMA(1, 0, At, B0); PG8_MMA(1, 1, At, B1); PG8_BAR; PG8_SCHED;
            PG8_LDB(B0, 1, 0); PG8_LDB(B1, 1, 1); PG8_SCHED; PG8_LDA(At, 1, 0); PG8_STAGE(PG8_SA(0, 1), a2 + hstep, voffA);
            PG8_WAIT_V(8); PG8_WAIT_L(0); PG8_BAR; PG8_MMA(0, 0, At, B0); PG8_MMA(0, 1, At, B1); PG8_BAR; PG8_SCHED;
            PG8_LDA(At, 1, 1); PG8_STAGE(PG8_SB(1, 0), b3, voffB); PG8_STAGE(PG8_SB(1, 1), b3 + hstep, voffB); PG8_STAGE(PG8_SA(1, 0), a3, voffA);
            PG8_WAIT_V(8); PG8_WAIT_L(0); PG8_BAR; PG8_MMA(1, 0, At, B0); PG8_MMA(1, 1, At, B1); PG8_BAR; PG8_SCHED;
            } else {
            PG8_LDB(B0, 0, 0); PG8_SCHED; PG8_LDA(At, 0, 0); PG8_STAGE(PG8_SA(1, 1), a1 + hstep, voffA);
            PG8_WAIT_L(8); PG8_BAR; PG8_WAIT_L(0); PG8_MMA(0, 0, At, B0); PG8_BAR; PG8_SCHED;
            PG8_LDB(B1, 0, 1); PG8_STAGE(PG8_SB(0, 0), b2, voffB);
            PG8_BAR; PG8_WAIT_L(0); PG8_MMA(0, 1, At, B1); PG8_BAR;
            PG8_LDA(At, 0, 1); PG8_STAGE(PG8_SA(0, 0), a2, voffA);
            PG8_BAR; PG8_WAIT_L(0); PG8_MMA(1, 0, At, B0); PG8_BAR; PG8_SCHED;
            PG8_STAGE(PG8_SB(0, 1), b2 + hstep, voffB);
            PG8_WAIT_V(6); PG8_BAR; PG8_MMA(1, 1, At, B1); PG8_BAR;
            PG8_LDB(B0, 1, 0); PG8_SCHED; PG8_LDA(At, 1, 0); PG8_STAGE(PG8_SA(0, 1), a2 + hstep, voffA);
            PG8_WAIT_L(8); PG8_BAR; PG8_WAIT_L(0); PG8_MMA(0, 0, At, B0); PG8_BAR; PG8_SCHED;
            PG8_LDB(B1, 1, 1); PG8_STAGE(PG8_SB(1, 0), b3, voffB);
            PG8_BAR; PG8_WAIT_L(0); PG8_MMA(0, 1, At, B1); PG8_BAR;
            PG8_LDA(At, 1, 1); PG8_STAGE(PG8_SA(1, 0), a3, voffA);
            PG8_BAR; PG8_WAIT_L(0); PG8_MMA(1, 0, At, B0); PG8_BAR; PG8_SCHED;
            PG8_STAGE(PG8_SB(1, 1), b3 + hstep, voffB);
            PG8_WAIT_V(6); PG8_BAR; PG8_MMA(1, 1, At, B1); PG8_BAR;
            }
        }
        if constexpr (ALIGN_EPI) { if (wr == 0) PG8_BAR; }
        if constexpr (!Epi::AFTER_DRAIN) { E(acc, cur, wr, wc, fr, fq); S.done(cur); }
        if (!has_next) break;
#pragma unroll
        for (int a = 0; a < 2; ++a)
#pragma unroll
            for (int b = 0; b < 2; ++b)
#pragma unroll
                for (int m = 0; m < 4; ++m)
#pragma unroll
                    for (int n = 0; n < 2; ++n) acc[a][b][m][n] = (f32x4){0.f, 0.f, 0.f, 0.f};
        cur = nxt; cA = nA; cB = nB; ++ui;
        if constexpr (ALIGN_EPI) { if (wr == 1) PG8_BAR; }
    }
    PG8_WAIT_V(0);
    if constexpr (!ALIGN_EPI) { if (wr == 0) PG8_BAR; }
    PG8_BAR;
    if constexpr (Epi::AFTER_DRAIN) { E.fused(acc, cur, wr, wc, fr, fq, lds, wid, lane); S.done(cur); }
#undef PG8_SA
#undef PG8_SB
#undef PG8_STAGE
#undef PG8_LDA
#undef PG8_LDB
#undef PG8_MMA
#undef PG8_WAIT_V
#undef PG8_WAIT_L
#undef PG8_BAR
#undef PG8_SCHED
}
}
#ifndef PG8_SP2
#define PG8_SP2 true
#endif
#ifndef PG8_ALIGN
#define PG8_ALIGN true
#endif
constexpr int NWAVES = 8;
constexpr int DM = 1024, TP = 8192, NBP = 2, MP = NBP * TP, NBS = 128, TS = 8, MS = NBS * TS, MT = MP + MS;
constexpr int DFF = 2816, NFF = 2 * DFF, NAIN = 3 * DM, NKVQ = 2816, NKV = 1536, PAST = 2048, NPAGE = 16, PAGE = 128;
constexpr int NCP = 511, NCS = 127;
constexpr float RMS_EPS = 1e-6f;
constexpr float QSCALE = 0.125f * 1.4426950408889634f;
constexpr size_t O_YP = 0, O_YS = O_YP + (size_t)MP * DM, O_CONVP = O_YS + (size_t)MS * DM, O_CONVS = O_CONVP + 2 * 2 * DM, O_CMPP = O_CONVS + (size_t)NBS * 2 * DM,
                 O_CMPS = O_CMPP + (size_t)MP * 512, O_SLCP = O_CMPS + (size_t)MS * 512, O_SLCS = O_SLCP + (size_t)MP * 512, O_WINP = O_SLCS + (size_t)MS * 512,
                 O_WINS = O_WINP + (size_t)NBP * 512 * 512, O_END = O_WINS + (size_t)NBS * 512 * 512;
static_assert(O_END == 69996544, "output size");
constexpr size_t MiB = 1u << 20;
constexpr size_t WS_CTL = 0, CTL_ZERO_BYTES = 1 * MiB;
constexpr size_t WS_WAIN = 2 * MiB, WS_WAOUT = 8 * MiB, WS_WFIN0 = 10 * MiB, WS_WFIN1 = 21 * MiB, WS_WFOUT0 = 32 * MiB, WS_WFOUT1 = 38 * MiB, WS_WKVQ = 44 * MiB, WS_WBOUT = 50 * MiB,
                 WS_W1T = 52 * MiB, WS_W2T = 53 * MiB, WS_PEB = 53 * MiB + 65536, WS_RSTD0 = 54 * MiB, WS_SSQ = 55 * MiB  , WS_GT = 60 * MiB  ,
                 WS_KCP = 64 * MiB  , WS_KCS = 65 * MiB  , WS_SELS = 82 * MiB,
                 WS_XB = 96 * MiB, WS_BB = 132 * MiB, WS_VB = 168 * MiB, WS_Z = 204 * MiB, WS_H = 240 * MiB, WS_HB = 312 * MiB, WS_ACT = 348 * MiB, WS_KVB = 444 * MiB, WS_QB = 496 * MiB, WS_O = 532 * MiB, WS_END = 568 * MiB;
static_assert(WS_XB + (size_t)MT * DM * 2 <= WS_BB && WS_H + (size_t)MT * DM * 4 <= WS_HB && WS_ACT + (size_t)MT * DFF * 2 <= WS_KVB && WS_KVB + (size_t)MT * NKV * 2 <= WS_QB && WS_O + (size_t)MT * DM * 2 <= WS_END, "ws map");
static_assert(WS_SSQ + 4 * (size_t)MT * 16 * 4 <= WS_GT && WS_GT + (size_t)MT * 48 * 4 <= WS_KCP && WS_KCS + (size_t)NBS * 128 * 512 * 2 <= WS_SELS, "ws map 2");
constexpr int CW_TMO = 0, CW_CODE = 1, CW_BAR = 4096;
constexpr int RING_OFF = 0, RING_BYTES = 155648, LDSCTL_OFF = RING_BYTES, MISC_OFF = LDSCTL_OFF + 320, LDS_BYTES = 159744;

#define GAS __attribute__((address_space(1)))
#define LAS __attribute__((address_space(3)))
typedef unsigned short bf16;
typedef unsigned v4u __attribute__((ext_vector_type(4)));
typedef unsigned v2u __attribute__((ext_vector_type(2)));
typedef float f32x4 __attribute__((ext_vector_type(4)));
typedef short bf16x8 __attribute__((ext_vector_type(8)));
typedef GAS unsigned gu32;
#define RLX_AGENT __ATOMIC_RELAXED, __HIP_MEMORY_SCOPE_AGENT
#define LDS_WAIT() asm volatile("s_waitcnt lgkmcnt(0)" ::: "memory")
#define VM_WAIT() asm volatile("s_waitcnt vmcnt(0)" ::: "memory")
__device__ __forceinline__ unsigned f2bf(float f) { unsigned u = __builtin_bit_cast(unsigned, f); return (u + 0x7fffu + ((u >> 16) & 1u)) >> 16; }
__device__ __forceinline__ unsigned pk2(float lo, float hi) { return f2bf(lo) | (f2bf(hi) << 16); }
__device__ __forceinline__ float bf2f(unsigned h) { return __builtin_bit_cast(float, h << 16); }
#define XB_TMO      128
#define XB_XCNT(j)  (256  + 64 * (j))
#define XB_XSUB(j)  (1280 + 64 * (j))
#define XB_XGEN(j)  (2304 + 64 * (j))
#define XB_TOP      3328
#define XB_TOPGEN   3392
#define XCD_BAR_WORDS 3456
#define XB_SPIN_CAP (1u << 18)

__device__ __forceinline__ unsigned xb_ld(unsigned* p)              { return __hip_atomic_load(p, __ATOMIC_RELAXED, __HIP_MEMORY_SCOPE_AGENT); }
__device__ __forceinline__ unsigned xb_add(unsigned* p, unsigned v) { return __hip_atomic_fetch_add(p, v, __ATOMIC_RELAXED, __HIP_MEMORY_SCOPE_AGENT); }
__device__ __forceinline__ unsigned xb_xcc_id() { return (unsigned)__builtin_amdgcn_s_getreg((3 << 11) | 20) & 0xFu; }
#define XB_SPIN(cond, bar) do { unsigned _sp = 0; while (cond) { __builtin_amdgcn_s_sleep(1); \
    if ((++_sp & 255u) == 0u) { if (xb_ld(&(bar)[XB_TMO])) break; if (_sp > XB_SPIN_CAP) { atomicAdd(&(bar)[XB_TMO], 1u); break; } } } } while (0)

struct XcdBarrier {
    unsigned* bar; unsigned x;
    volatile LAS unsigned* st;
};

__device__ __forceinline__ XcdBarrier xcd_barrier_post(unsigned* bar, volatile LAS unsigned* st) {
    XcdBarrier b; b.bar = bar; b.x = xb_xcc_id(); b.st = st;
    if (threadIdx.x == 0) (void)xb_add(&bar[XB_XCNT(b.x)], 1u);
    return b;
}
__device__ __forceinline__ void xcd_barrier_complete(unsigned* bar, unsigned x, unsigned& nloc, unsigned& nx) {
    const unsigned G = gridDim.x * gridDim.y * gridDim.z;
    unsigned sum, cnt, mine, sp = 0u;
    for (;;) {
        sum = 0u; cnt = 0u; mine = 0u;
#pragma unroll
        for (unsigned j = 0; j < 16; ++j) { const unsigned c = xb_ld(&bar[XB_XCNT(j)]); sum += c; cnt += (c > 0u) ? 1u : 0u; mine = (j == x) ? c : mine; }
        if (sum == G) break;
        __builtin_amdgcn_s_sleep(1);
        if ((++sp & 255u) == 0u) { if (xb_ld(&bar[XB_TMO])) break; if (sp > XB_SPIN_CAP) { atomicAdd(&bar[XB_TMO], 1u); break; } }
    }
    nloc = mine > 0u ? mine : 1u; nx = cnt > 0u ? cnt : 1u;
}

__device__ __forceinline__ void xcd_barrier(const XcdBarrier& b) {
    asm volatile("s_waitcnt vmcnt(0)" ::: "memory");
    __syncthreads();
    if (threadIdx.x == 0) {
        unsigned* bar = b.bar;
        __builtin_amdgcn_s_waitcnt(0);
        unsigned nloc = b.st[0], nx = b.st[1];
        if (nloc == 0u) { xcd_barrier_complete(bar, b.x, nloc, nx); b.st[0] = nloc; b.st[1] = nx; }
        const unsigned old = xb_add(&bar[XB_XSUB(b.x)], 1u);
        const unsigned gen = old / nloc;
        if (old + 1u == (gen + 1u) * nloc) {
            __builtin_amdgcn_fence(__ATOMIC_RELEASE, "agent");
            asm volatile("s_waitcnt vmcnt(0)" ::: "memory");
            const unsigned og = xb_add(&bar[XB_TOP], 1u);
            const unsigned tg = og / nx;
            if (og + 1u == (tg + 1u) * nx) xb_add(&bar[XB_TOPGEN], 1u);
            else XB_SPIN(xb_ld(&bar[XB_TOPGEN]) == tg, bar);
            __builtin_amdgcn_fence(__ATOMIC_ACQUIRE, "agent");
            xb_add(&bar[XB_XGEN(b.x)], 1u);
            asm volatile("s_waitcnt vmcnt(0)" ::: "memory");
        } else {
            XB_SPIN(xb_ld(&bar[XB_XGEN(b.x)]) == gen, bar);
            __builtin_amdgcn_fence(__ATOMIC_ACQUIRE, "agent");
            asm volatile("s_waitcnt vmcnt(0)" ::: "memory");
        }
    }
    __syncthreads();
}

struct Args { const float* in[21]; float* out; unsigned char* ws; int ph_lo, ph_hi; };
struct Frame {
    LAS unsigned char* lds; volatile LAS unsigned* MISC; gu32* ctl;
    int tid, lane, wave, vcu, G;
};
__device__ __forceinline__ float wave_sum(float v) {
#pragma unroll
    for (int o = 1; o < 64; o <<= 1) v += __shfl_xor(v, o);
    return v;
}
__device__ __forceinline__ void tr_item(const float* src, int ldsrc, int scol, int nvalid, const float* kscale, float cscale, bf16* dst, int K, int n0, int k0, LAS float* scr, int lane) {
#pragma unroll 8
    for (int i = 0; i < 32; ++i) { const int kk = 2 * i + (lane >> 5), c = lane & 31;
        float v = 0.f; if (c < nvalid) { v = src[(size_t)(k0 + kk) * ldsrc + scol + c] * cscale; if (kscale) v *= kscale[k0 + kk]; }
        scr[kk * 33 + c] = v; }
    LDS_WAIT(); asm volatile("" ::: "memory");
    const int c = lane & 7;
#pragma unroll
    for (int j = 0; j < 4; ++j) { const int n = (lane >> 3) + 8 * j; const LAS float* s = scr + (8 * c) * 33 + n;
        v4u o; o.x = pk2(s[0 * 33], s[1 * 33]); o.y = pk2(s[2 * 33], s[3 * 33]); o.z = pk2(s[4 * 33], s[5 * 33]); o.w = pk2(s[6 * 33], s[7 * 33]);
        *(GAS v4u*)(dst + (size_t)(n0 + n) * K + k0 + 8 * c) = o; }
    LDS_WAIT(); asm volatile("" ::: "memory");
}
enum { I_XP = 0, I_XS, I_CCMP, I_CSLC, I_SWIN, I_SCONV, I_PT, I_NORMW, I_FNORMW, I_AIN, I_ACONV, I_AOUT, I_BIN, I_BOUT, I_KVNORM, I_KVW, I_PE, I_W1, I_W2, I_FIN, I_FOUT };

__device__ __forceinline__ void p0_prologue(Frame& F, const Args& A) {
    unsigned char* ws = A.ws;
    LAS float* scr = (LAS float*)(F.lds + RING_OFF + F.wave * 16384);
    const int gw = F.vcu * NWAVES + F.wave, NGW = F.G * NWAVES;
    const float* normw = A.in[I_NORMW];
    constexpr int IT_AIN = (NAIN / 32) * (DM / 64), IT_SQ = (DM / 32) * (DM / 64), IT_FIN = (NFF / 32) * (DM / 64), IT_FOUT = (DM / 32) * (DFF / 64), IT_KVQ = (NKVQ / 32) * (DM / 64),
                  IT_W1 = 2 * (64 / 32) * (2048 / 64), IT_W2 = 2 * 2;
    constexpr int NITEMS = IT_AIN + 2 * IT_SQ + 2 * IT_FIN + 2 * IT_FOUT + IT_KVQ + IT_W1 + IT_W2;
    for (int it = gw; it < NITEMS; it += NGW) {
        int r = it;
        if (r < IT_AIN) { const int ng = r / 16, kb = r % 16, n0 = ng * 32, pn = n0 >> 8, w = n0 & 255;
            const int scol = pn < 8 ? (w < 128 ? 1024 + pn * 128 + w : 2048 + pn * 128 + (w - 128)) : (pn - 8) * 256 + w;
            tr_item(A.in[I_AIN], NAIN, scol, 32, normw, 1.f, (bf16*)(ws + WS_WAIN), DM, n0, kb * 64, scr, F.lane); continue; } r -= IT_AIN;
        if (r < IT_SQ) { const int ng = r / 16, kb = r % 16; tr_item(A.in[I_AOUT], DM, ng * 32, 32, nullptr, 1.f, (bf16*)(ws + WS_WAOUT), DM, ng * 32, kb * 64, scr, F.lane); continue; } r -= IT_SQ;
        if (r < IT_SQ) { const int ng = r / 16, kb = r % 16; tr_item(A.in[I_BOUT], DM, ng * 32, 32, nullptr, 1.f, (bf16*)(ws + WS_WBOUT), DM, ng * 32, kb * 64, scr, F.lane); continue; } r -= IT_SQ;
        if (r < 2 * IT_FIN) { const int l = r / IT_FIN, q = r % IT_FIN, ng = q / 16, kb = q % 16, n0 = ng * 32, pn = n0 >> 8, w = n0 & 255;
            const int scol = w < 128 ? pn * 128 + w : DFF + pn * 128 + (w - 128);
            tr_item(A.in[I_FIN] + (size_t)l * DM * NFF, NFF, scol, 32, normw + (l * 2 + 1) * DM, 1.f, (bf16*)(ws + (l ? WS_WFIN1 : WS_WFIN0)), DM, n0, kb * 64, scr, F.lane); continue; } r -= 2 * IT_FIN;
        if (r < 2 * IT_FOUT) { const int l = r / IT_FOUT, q = r % IT_FOUT, ng = q / 44, kb = q % 44;
            tr_item(A.in[I_FOUT] + (size_t)l * DFF * DM, DM, ng * 32, 32, nullptr, 1.f, (bf16*)(ws + (l ? WS_WFOUT1 : WS_WFOUT0)), DFF, ng * 32, kb * 64, scr, F.lane); continue; } r -= 2 * IT_FOUT;
        if (r < IT_KVQ) { const int ng = r / 16, kb = r % 16, n0 = ng * 32; bf16* dst = (bf16*)(ws + WS_WKVQ);
            if (n0 < NKV) tr_item(A.in[I_KVW], NKV, n0, 32, A.in[I_KVNORM], 1.f, dst, DM, n0, kb * 64, scr, F.lane);
            else if (n0 < NKV + 1024) tr_item(A.in[I_BIN], 1072, n0 - NKV, 32, normw + 2 * DM, QSCALE, dst, DM, n0, kb * 64, scr, F.lane);
            else { const int g0 = n0 - (NKV + 1024); const int nv = g0 >= 48 ? 0 : (48 - g0 < 32 ? 48 - g0 : 32);
                tr_item(A.in[I_BIN], 1072, 1024 + (nv ? g0 : 0), nv, normw + 2 * DM, 1.f, dst, DM, n0, kb * 64, scr, F.lane); }
            continue; } r -= IT_KVQ;
        if (r < IT_W1) { const int k = r / 64, q = r % 64, ng = q / 32, kb = q % 32;
            tr_item(A.in[I_W1] + (size_t)k * 2048 * 64, 64, ng * 32, 32, nullptr, 1.f, (bf16*)(ws + WS_W1T) + (size_t)k * 64 * 2048, 2048, ng * 32, kb * 64, scr, F.lane); continue; } r -= IT_W1;
        { const int k = r / 2, ng = r % 2;
            tr_item(A.in[I_W2] + (size_t)k * 64 * 64, 64, ng * 32, 32, nullptr, 1.f, (bf16*)(ws + WS_W2T) + (size_t)k * 64 * 64, 64, ng * 32, 0, scr, F.lane); }
    }
    for (int o = gw; o < 128; o += NGW) { const int k = o >> 6, h = o & 63; const float* pe = A.in[I_PE] + (size_t)k * 2048; const float* w1 = A.in[I_W1] + (size_t)k * 2048 * 64 + h;
        float s = 0.f; for (int i = F.lane; i < 2048; i += 64) s += pe[i] * w1[(size_t)i * 64];
        s = wave_sum(s); if (F.lane == 0) ((float*)(ws + WS_PEB))[o] = s; }
    for (int m = gw; m < MT; m += NGW) {
        const float* xrow = m < MP ? A.in[I_XP] + (size_t)m * DM : A.in[I_XS] + (size_t)(m - MP) * DM;
        const GAS f32x4* xr = (const GAS f32x4*)xrow + F.lane; f32x4 v[4]; float s = 0.f;
#pragma unroll
        for (int j = 0; j < 4; ++j) { v[j] = xr[64 * j]; s += (v[j].x * v[j].x + v[j].y * v[j].y) + (v[j].z * v[j].z + v[j].w * v[j].w); }
        s = wave_sum(s);
        GAS v2u* o8 = (GAS v2u*)((bf16*)(ws + WS_XB) + (size_t)m * DM) + F.lane;
#pragma unroll
        for (int j = 0; j < 4; ++j) { v2u w; w.x = pk2(v[j].x, v[j].y); w.y = pk2(v[j].z, v[j].w); o8[64 * j] = w; }
        if (F.lane == 0) ((float*)(ws + WS_RSTD0))[m] = __builtin_amdgcn_rsqf(s * (1.0f / DM) + RMS_EPS);
    }
    { const GAS f32x4* src = (const GAS f32x4*)A.in[I_SWIN]; GAS f32x4* dst = (GAS f32x4*)(A.out + O_WINS);
      const size_t per = (size_t)504 * 128, total = (size_t)NBS * per; const size_t gt = (size_t)F.vcu * 512 + F.tid, GT_ = (size_t)F.G * 512;
      for (size_t i = gt; i < total; i += GT_) { const size_t n = i / per, rem = i % per; dst[n * (512 * 128) + rem] = src[n * (512 * 128) + 8 * 128 + rem]; } }
}
__device__ __forceinline__ void p2_conv(Frame& F, const Args& A) {
    unsigned char* ws = A.ws; const bf16* VB = (const bf16*)(ws + WS_VB); const bf16* BB = (const bf16*)(ws + WS_BB); bf16* Z = (bf16*)(ws + WS_Z);
    const float* cw = A.in[I_ACONV]; const float* sc = A.in[I_SCONV];
    const size_t gt = (size_t)F.vcu * 512 + F.tid, GT_ = (size_t)F.G * 512, total = (size_t)MT * 128;
    for (size_t i = gt; i < total; i += GT_) {
        const int row = (int)(i >> 7), c8 = (int)(i & 127) * 8; int t, tlen; const float* pre = nullptr;
        if (row < MP) { t = row & (TP - 1); tlen = TP; } else { const int rs = row - MP; t = rs & 7; tlen = TS; pre = sc + (size_t)(rs >> 3) * 2 * DM; }
        const v4u vb = *(const GAS v4u*)(BB + (size_t)row * DM + c8), v2 = *(const GAS v4u*)(VB + (size_t)row * DM + c8);
        float f1[8], f0[8];
        if (t >= 1) { const v4u q = *(const GAS v4u*)(VB + (size_t)(row - 1) * DM + c8);
#pragma unroll
            for (int e = 0; e < 4; ++e) { f1[2 * e] = bf2f(q[e] & 0xffffu); f1[2 * e + 1] = bf2f(q[e] >> 16); } }
        else {
#pragma unroll
            for (int e = 0; e < 8; ++e) f1[e] = pre ? pre[DM + c8 + e] : 0.f; }
        if (t >= 2) { const v4u q = *(const GAS v4u*)(VB + (size_t)(row - 2) * DM + c8);
#pragma unroll
            for (int e = 0; e < 4; ++e) { f0[2 * e] = bf2f(q[e] & 0xffffu); f0[2 * e + 1] = bf2f(q[e] >> 16); } }
        else {
#pragma unroll
            for (int e = 0; e < 8; ++e) f0[e] = pre ? pre[(size_t)t * DM + c8 + e] : 0.f; }
        float z[8], vv[8];
#pragma unroll
        for (int e = 0; e < 4; ++e) { vv[2 * e] = bf2f(v2[e] & 0xffffu); vv[2 * e + 1] = bf2f(v2[e] >> 16); }
#pragma unroll
        for (int e = 0; e < 8; ++e) { const float b = bf2f((vb[e >> 1] >> ((e & 1) * 16)) & 0xffffu);
            z[e] = b * (cw[c8 + e] * f0[e] + cw[DM + c8 + e] * f1[e] + cw[2 * DM + c8 + e] * vv[e]); }
        v4u o; o.x = pk2(z[0], z[1]); o.y = pk2(z[2], z[3]); o.z = pk2(z[4], z[5]); o.w = pk2(z[6], z[7]);
        *(GAS v4u*)(Z + (size_t)row * DM + c8) = o;
        if (t >= tlen - 2) { float* dst = row < MP ? A.out + O_CONVP + ((size_t)(row >> 13) * 2 + (t - (tlen - 2))) * DM + c8
                                                  : A.out + O_CONVS + ((size_t)((row - MP) >> 3) * 2 + (t - (tlen - 2))) * DM + c8;
#pragma unroll
            for (int e = 0; e < 8; ++e) dst[e] = vv[e]; }
    }
}
__device__ __forceinline__ void p_final(Frame& F, const Args& A) {
    const float* H = (const float*)(A.ws + WS_H); const GAS f32x4* fw = (const GAS f32x4*)A.in[I_FNORMW] + F.lane;
    const int gw = F.vcu * NWAVES + F.wave, NGW = F.G * NWAVES;
    f32x4 w[4];
#pragma unroll
    for (int j = 0; j < 4; ++j) w[j] = fw[64 * j];
    for (int m = gw; m < MT; m += NGW) {
        const GAS f32x4* xr = (const GAS f32x4*)(H + (size_t)m * DM) + F.lane; f32x4 v[4]; float s = 0.f;
#pragma unroll
        for (int j = 0; j < 4; ++j) { v[j] = xr[64 * j]; s += (v[j].x * v[j].x + v[j].y * v[j].y) + (v[j].z * v[j].z + v[j].w * v[j].w); }
        const float r = __builtin_amdgcn_rsqf(wave_sum(s) * (1.0f / DM) + RMS_EPS);
        GAS f32x4* o = (GAS f32x4*)(A.out + (m < MP ? O_YP + (size_t)m * DM : O_YS + (size_t)(m - MP) * DM)) + F.lane;
#pragma unroll
        for (int j = 0; j < 4; ++j) o[64 * j] = v[j] * r * w[j];
    }
}
__device__ __forceinline__ void p_zero16(Frame& F, void* p, size_t bytes) {
    GAS v4u* d = (GAS v4u*)p; const size_t n = bytes / 16, gt = (size_t)F.vcu * 512 + F.tid, GT_ = (size_t)F.G * 512;
    for (size_t i = gt; i < n; i += GT_) d[i] = (v4u){0u, 0u, 0u, 0u};
}
constexpr int P7_IMG = 0, P7_IMG_BYTES = 144 * 512, P7_HID = P7_IMG_BYTES, P7_HID_STRIDE = 144;
constexpr int P7_UNITS_P = NBP * 64 * 2, P7_UNITS_S = NBS * NPAGE * 2, P7_UNITS = P7_UNITS_P + P7_UNITS_S;
__device__ __forceinline__ int p7_swz(int pos_l, int g, int dchunk) { return pos_l * 512 + g * 128 + ((dchunk ^ ((pos_l >> 4) & 3) ^ ((g >> 1) << 2)) << 4); }
__device__ __forceinline__ void p7_compress(Frame& F, const Args& A) {
    unsigned char* ws = A.ws; LAS unsigned char* img = F.lds + RING_OFF + P7_IMG; LAS unsigned char* hidp = F.lds + RING_OFF + P7_HID; LAS float* red = (LAS float*)img;
    const bf16* W1T = (const bf16*)(ws + WS_W1T); const bf16* W2T = (const bf16*)(ws + WS_W2T); const float* PEB = (const float*)(ws + WS_PEB);
    const bf16* KVB = (const bf16*)(ws + WS_KVB); const int* ptab = (const int*)A.in[I_PT]; const float* cache = A.in[I_CCMP];
    const int lane = F.lane, w = F.wave, tid = F.tid, l15 = lane & 15, lq = lane >> 4;
    for (int u = F.vcu; u < P7_UNITS; u += F.G) {
        const bool isp = u < P7_UNITS_P; int seq, seg, k;
        if (isp) { seq = u >> 7; seg = (u >> 1) & 63; k = u & 1; } else { const int v = u - P7_UNITS_P; seq = v >> 5; seg = (v >> 1) & 15; k = v & 1; }
        const int pos0 = seg * 128, plimit = isp ? TP : PAST, ntok = (isp ? seg == 63 : seg == 15) ? 7 : 8;
        if (isp) {
            v4u r[9];
#pragma unroll
            for (int i = 0; i < 9; ++i) { const int c = tid + i * 512, pos_l = c >> 5, g = (c >> 3) & 3, dc = c & 7, pos = pos0 + pos_l;
                r[i] = (v4u){0u, 0u, 0u, 0u}; if (pos < plimit) r[i] = *(const GAS v4u*)(KVB + ((size_t)seq * TP + pos) * NKV + k * 256 + g * 64 + dc * 8); }
#pragma unroll
            for (int i = 0; i < 9; ++i) { const int c = tid + i * 512, pos_l = c >> 5, g = (c >> 3) & 3, dc = c & 7; *(LAS v4u*)(img + p7_swz(pos_l, g, dc)) = r[i]; }
        } else {
            const int pgA = ptab[seq * NPAGE + seg], pgB = seg < 15 ? ptab[seq * NPAGE + seg + 1] : 0;
            f32x4 ra[9], rb[9];
#pragma unroll
            for (int i = 0; i < 9; ++i) { const int c = tid + i * 512, pos_l = c >> 5, g = (c >> 3) & 3, dc = c & 7, pos = pos0 + pos_l;
                ra[i] = (f32x4){0.f, 0.f, 0.f, 0.f}; rb[i] = ra[i];
                if (pos < plimit) { const float* s = cache + ((size_t)(pos_l < 128 ? pgA : pgB) * PAGE + (pos_l & 127)) * 512 + k * 256 + g * 64 + dc * 8; ra[i] = *(const GAS f32x4*)s; rb[i] = *(const GAS f32x4*)(s + 4); } }
#pragma unroll
            for (int i = 0; i < 9; ++i) { const int c = tid + i * 512, pos_l = c >> 5, g = (c >> 3) & 3, dc = c & 7;
                v4u o; o.x = pg8::cvt_pk_bf16(ra[i][0], ra[i][1]); o.y = pg8::cvt_pk_bf16(ra[i][2], ra[i][3]); o.z = pg8::cvt_pk_bf16(rb[i][0], rb[i][1]); o.w = pg8::cvt_pk_bf16(rb[i][2], rb[i][3]);
                *(LAS v4u*)(img + p7_swz(pos_l, g, dc)) = o; }
        }
        __syncthreads();
        f32x4 acc[2][4];
#pragma unroll
        for (int a = 0; a < 2; ++a)
#pragma unroll
            for (int b = 0; b < 4; ++b) acc[a][b] = (f32x4){0.f, 0.f, 0.f, 0.f};
#pragma unroll 2
        for (int kl = 0; kl < 8; ++kl) { const int ks = 8 * w + kl, j = ks >> 1, dh = ks & 1;
            bf16x8 bfr[4], afr[2];
#pragma unroll
            for (int nt = 0; nt < 4; ++nt) bfr[nt] = *(const GAS bf16x8*)(W1T + ((size_t)(k * 64 + nt * 16 + l15)) * 2048 + ks * 32 + lq * 8);
#pragma unroll
            for (int mt = 0; mt < 2; ++mt) { const int tok = mt * 4 + (l15 >> 2), g = l15 & 3, pos_l = 16 * tok + j; afr[mt] = *(const LAS bf16x8*)(img + p7_swz(pos_l, g, dh * 4 + lq)); }
#pragma unroll
            for (int mt = 0; mt < 2; ++mt)
#pragma unroll
                for (int nt = 0; nt < 4; ++nt) acc[mt][nt] = __builtin_amdgcn_mfma_f32_16x16x32_bf16(afr[mt], bfr[nt], acc[mt][nt], 0, 0, 0);
        }
        __syncthreads();
#pragma unroll
        for (int mt = 0; mt < 2; ++mt)
#pragma unroll
            for (int nt = 0; nt < 4; ++nt)
#pragma unroll
                for (int rg = 0; rg < 4; ++rg) red[(w * 32 + mt * 16 + 4 * lq + rg) * 64 + nt * 16 + l15] = acc[mt][nt][rg];
        __syncthreads();
        { const int row = tid >> 4, col = (tid & 15) * 4; f32x4 s = *(const LAS f32x4*)(red + row * 64 + col);
#pragma unroll
            for (int ww = 1; ww < 8; ++ww) s += *(const LAS f32x4*)(red + (ww * 32 + row) * 64 + col);
            const f32x4 pb = *(const GAS f32x4*)(PEB + k * 64 + col); float h[4];
#pragma unroll
            for (int e = 0; e < 4; ++e) { const float x = s[e] + pb[e]; h[e] = x * __builtin_amdgcn_rcpf(1.0f + __builtin_amdgcn_exp2f(x * -1.4426950408889634f)); }
            v2u o; o.x = pg8::cvt_pk_bf16(h[0], h[1]); o.y = pg8::cvt_pk_bf16(h[2], h[3]); *(LAS v2u*)(hidp + row * P7_HID_STRIDE + col * 2) = o; }
        __syncthreads();
        { const int mt = w >> 2, nt = w & 3; f32x4 a2 = (f32x4){0.f, 0.f, 0.f, 0.f};
#pragma unroll
            for (int k2 = 0; k2 < 2; ++k2) { const bf16x8 af = *(const LAS bf16x8*)(hidp + (mt * 16 + l15) * P7_HID_STRIDE + k2 * 64 + lq * 16);
                const bf16x8 bf = *(const GAS bf16x8*)(W2T + ((size_t)(k * 64 + nt * 16 + l15)) * 64 + k2 * 32 + lq * 8);
                a2 = __builtin_amdgcn_mfma_f32_16x16x32_bf16(af, bf, a2, 0, 0, 0); }
            const int tok = mt * 4 + lq; bf16* kc = isp ? (bf16*)(ws + WS_KCP) + (((size_t)seq * 512 + seg * 8 + tok) * 2 + k) * 256 : (bf16*)(ws + WS_KCS) + (((size_t)seq * 128 + seg * 8 + tok) * 2 + k) * 256;
#pragma unroll
            for (int rg = 0; rg < 4; ++rg) kc[rg * 64 + nt * 16 + l15] = (bf16)(tok < ntok ? f2bf(a2[rg]) : 0u); }
        __syncthreads();
    }
}
#define P7_BODY p7_compress(F, args);
constexpr int KT_STRIDE = 144, VT_STRIDE = 160;
constexpr float S_NEG = -1.0e30f, M_INIT = -1000.0f, RESC_THR = 8.0f;
typedef short s16x4 __attribute__((ext_vector_type(4)));
struct AttState { float m[2], l[2]; f32x4 o[2][4]; };
__device__ __forceinline__ void att_init(AttState& st) {
#pragma unroll
    for (int c = 0; c < 2; ++c) { st.m[c] = M_INIT; st.l[c] = 0.f;
#pragma unroll
        for (int d = 0; d < 4; ++d) st.o[c][d] = (f32x4){0.f, 0.f, 0.f, 0.f}; }
}
__device__ __forceinline__ s16x4 tr_read(const LAS unsigned char* p) { return __builtin_bit_cast(s16x4, __builtin_amdgcn_ds_read_tr16_b64_v4i16((LAS s16x4*)p)); }
template <int NKT, int MODE>
__device__ __forceinline__ void wave_block(const LAS unsigned char* kt, const LAS unsigned char* vt, const bf16x8 (&qf)[2][2], AttState& st, const float (&bias)[2], const bool (&act)[2],
                                           bool boundary, const int (&lo)[2], const int (&hi)[2], int lane, LAS float* imp_row0, int imp_blk0, int imp_stride) {
    const int l15 = lane & 15, lq = lane >> 4;
    if (!act[0] && !act[1]) return;
    bf16x8 kf[NKT][2];
#pragma unroll
    for (int t = 0; t < NKT; ++t)
#pragma unroll
        for (int ks = 0; ks < 2; ++ks) kf[t][ks] = *(const LAS bf16x8*)(kt + (t * 16 + l15) * KT_STRIDE + ks * 64 + lq * 16);
    bf16x8 pfr[2][NKT / 2];
#pragma unroll
    for (int c = 0; c < 2; ++c) {
        if (!act[c]) continue;
        const float c0 = bias[c] - st.m[c];
        f32x4 s[NKT];
#pragma unroll
        for (int t = 0; t < NKT; ++t) { s[t] = (f32x4){c0, c0, c0, c0};
            s[t] = __builtin_amdgcn_mfma_f32_16x16x32_bf16(kf[t][0], qf[c][0], s[t], 0, 0, 0);
            s[t] = __builtin_amdgcn_mfma_f32_16x16x32_bf16(kf[t][1], qf[c][1], s[t], 0, 0, 0); }
        if (boundary) { const int l2 = lo[c] - 4 * lq, h2 = hi[c] - 4 * lq;
#pragma unroll
            for (int t = 0; t < NKT; ++t)
#pragma unroll
                for (int r = 0; r < 4; ++r) { const int kk = t * 16 + r; if (kk < l2 || kk > h2) s[t][r] = S_NEG; } }
        float mx = s[0][0];
#pragma unroll
        for (int t = 0; t < NKT; ++t)
#pragma unroll
            for (int r = 0; r < 4; ++r) mx = fmaxf(mx, s[t][r]);
        mx = fmaxf(mx, __shfl_xor(mx, 16)); mx = fmaxf(mx, __shfl_xor(mx, 32));
        if (MODE == 1) {
            const float dl = fmaxf(mx, 0.f), f = __builtin_amdgcn_exp2f(-dl); st.m[c] += dl; float a = 0.f;
#pragma unroll
            for (int t = 0; t < NKT; ++t)
#pragma unroll
                for (int r = 0; r < 4; ++r) a += __builtin_amdgcn_exp2f(s[t][r] - dl);
            st.l[c] = st.l[c] * f + a;
            continue;
        }
        if (MODE == 0) {
            if (__any(mx > RESC_THR)) {
                const float dl = fmaxf(mx, 0.f), f = __builtin_amdgcn_exp2f(-dl); st.m[c] += dl; st.l[c] *= f;
#pragma unroll
                for (int t = 0; t < NKT; ++t) s[t] = s[t] - dl;
#pragma unroll
                for (int r = 0; r < 4; ++r) { const float fr = __shfl(f, 4 * lq + r);
#pragma unroll
                    for (int dt = 0; dt < 4; ++dt) st.o[c][dt][r] *= fr; }
            }
        }
        float a = 0.f;
#pragma unroll
        for (int t = 0; t < NKT; ++t)
#pragma unroll
            for (int r = 0; r < 4; ++r) { s[t][r] = __builtin_amdgcn_exp2f(s[t][r]); a += s[t][r]; }
        if (MODE == 0) st.l[c] += a;
        if (MODE == 2) {
            const float li = st.l[c];
#pragma unroll
            for (int t = 0; t < NKT; ++t) { s[t] = s[t] * li;
                float ia = 2.f * (s[t][0] + s[t][1] + s[t][2]) + s[t][3], ib = s[t][3];
                ia += __shfl_xor(ia, 1); ia += __shfl_xor(ia, 2); ib += __shfl_xor(ib, 1); ib += __shfl_xor(ib, 2);
                if ((l15 & 3) == 0) { LAS float* ir = imp_row0 + (c * 4 + (l15 >> 2)) * imp_stride + imp_blk0 + 4 * t + lq; atomicAdd((float*)ir, ia); atomicAdd((float*)(ir + 1), ib); } }
        }
#pragma unroll
        for (int G = 0; G < NKT / 2; ++G) {
            v4u pw; pw.x = pg8::cvt_pk_bf16(s[2 * G][0], s[2 * G][1]); pw.y = pg8::cvt_pk_bf16(s[2 * G][2], s[2 * G][3]); pw.z = pg8::cvt_pk_bf16(s[2 * G + 1][0], s[2 * G + 1][1]); pw.w = pg8::cvt_pk_bf16(s[2 * G + 1][2], s[2 * G + 1][3]);
            pfr[c][G] = __builtin_bit_cast(bf16x8, pw); }
    }
    if (MODE == 1) return;
    asm volatile("" ::: "memory");
    const LAS unsigned char* vb = vt + (4 * lq + (l15 >> 2)) * VT_STRIDE + (l15 & 3) * 8;
#pragma unroll
    for (int G = 0; G < NKT / 2; ++G) {
        bf16x8 vf[4];
#pragma unroll
        for (int dt = 0; dt < 4; ++dt) { const s16x4 a = tr_read(vb + (32 * G) * VT_STRIDE + dt * 32), b = tr_read(vb + (32 * G + 16) * VT_STRIDE + dt * 32);
            vf[dt] = (bf16x8){a[0], a[1], a[2], a[3], b[0], b[1], b[2], b[3]}; }
#pragma unroll
        for (int c = 0; c < 2; ++c) { if (!act[c]) continue;
#pragma unroll
            for (int dt = 0; dt < 4; ++dt) st.o[c][dt] = __builtin_amdgcn_mfma_f32_16x16x32_bf16(pfr[c][G], vf[dt], st.o[c][dt], 0, 0, 0); }
        asm volatile("" ::: "memory");
    }
}
__device__ __forceinline__ void att_finish(const AttState& st, int c, int lane, float (&linv)[4]) {
    float l = st.l[c]; l += __shfl_xor(l, 16); l += __shfl_xor(l, 32);
    const float li = 1.0f / fmaxf(l, 1e-30f);
#pragma unroll
    for (int r = 0; r < 4; ++r) linv[r] = __shfl(li, 4 * (lane >> 4) + r);
}
__device__ __forceinline__ void select_blocks(float v0, float v1, int cur, int lane, unsigned long long& sel0, unsigned long long& sel1) {
    const unsigned k0 = __float_as_uint(v0), k1 = __float_as_uint(v1);
    const bool e0 = lane >= 1 && lane <= cur - 2, e1 = (lane + 64) <= cur - 2;
    const int nforced = cur >= 2 ? 3 : cur + 1, need = 16 - nforced, nelig = cur - 2 > 0 ? cur - 2 : 0;
    unsigned long long s0 = 1ull, s1 = 0ull;
    if (cur < 64) s0 |= 1ull << cur; else s1 |= 1ull << (cur - 64);
    if (cur >= 1) { if (cur - 1 < 64) s0 |= 1ull << (cur - 1); else s1 |= 1ull << (cur - 65); }
    if (nelig <= need) { s0 |= __ballot(e0); s1 |= __ballot(e1); }
    else {
        unsigned T = 0u;
        for (int bit = 30; bit >= 0; --bit) { const unsigned cand = T | (1u << bit);
            const int cnt = __popcll(__ballot(e0 && k0 >= cand)) + __popcll(__ballot(e1 && k1 >= cand));
            if (cnt >= need) T = cand; }
        const unsigned long long g0 = __ballot(e0 && k0 > T), g1 = __ballot(e1 && k1 > T);
        unsigned long long q0 = __ballot(e0 && k0 == T), q1 = __ballot(e1 && k1 == T);
        int rem = need - (__popcll(g0) + __popcll(g1));
        s0 |= g0; s1 |= g1;
        while (rem > 0 && (q0 | q1)) { if (q0) { const unsigned long long b = q0 & (~q0 + 1ull); s0 |= b; q0 ^= b; } else { const unsigned long long b = q1 & (~q1 + 1ull); s1 |= b; q1 ^= b; } --rem; }
    }
    sel0 = s0; sel1 = s1;
}

__device__ __forceinline__ unsigned pick4(const unsigned (&a)[4], int i) { return i == 0 ? a[0] : i == 1 ? a[1] : i == 2 ? a[2] : a[3]; }
constexpr int P8_KT = 0, P8_VT = 2 * 64 * KT_STRIDE, P8_IMP = P8_VT + 2 * 64 * VT_STRIDE, P8_SELB = P8_IMP + 64 * 132 * 4, P8_OT = P8_SELB + 64 * 16, P8_END = P8_OT + 8 * 8192;
static_assert(P8_END <= RING_BYTES, "attention LDS");
__device__ __forceinline__ void p8_load(const bf16* kbase, const bf16* vbase, size_t row_stride, int tid, v4u& kr, v4u& vr) {
    asm volatile("" : "+v"(tid));
    const int row = tid >> 3, ch = tid & 7; kr = *(const GAS v4u*)(kbase + (size_t)row * row_stride + ch * 8); vr = *(const GAS v4u*)(vbase + (size_t)row * row_stride + ch * 8); }
__device__ __forceinline__ void p8_store(LAS unsigned char* kt, LAS unsigned char* vt, int tid, const v4u& kr, const v4u& vr) {
    asm volatile("" : "+v"(tid));
    const int row = tid >> 3, ch = tid & 7; *(LAS v4u*)(kt + row * KT_STRIDE + ch * 16) = kr; *(LAS v4u*)(vt + row * VT_STRIDE + ch * 16) = vr; }

__device__ __forceinline__ void p8_prompt_unit(Frame& F, const Args& A, int b, int qb, int g) {
    unsigned char* ws = A.ws; const bf16* KVB = (const bf16*)(ws + WS_KVB); const bf16* QB = (const bf16*)(ws + WS_QB); const bf16* KCP = (const bf16*)(ws + WS_KCP);
    const float* GT = (const float*)(ws + WS_GT); bf16* O = (bf16*)(ws + WS_O);
    LAS unsigned char* L = F.lds + RING_OFF; LAS float* IMP = (LAS float*)(L + P8_IMP); LAS unsigned* SELB = (LAS unsigned*)(L + P8_SELB);
    const int lane = F.lane, w = F.wave, tid = F.tid, l15 = lane & 15, lq = lane >> 4;
    const size_t rowbase = (size_t)b * TP + (size_t)qb * 64;
    bf16x8 qf[2][2];
#pragma unroll
    for (int c = 0; c < 2; ++c)
#pragma unroll
        for (int ks = 0; ks < 2; ++ks) qf[c][ks] = *(const GAS bf16x8*)(QB + (rowbase + 8 * w + 4 * c + (l15 >> 2)) * DM + g * 256 + (l15 & 3) * 64 + ks * 32 + lq * 8);
    int tl[2]; tl[0] = 8 * w + (l15 >> 2); tl[1] = tl[0] + 4;
    for (int i = lane; i < 8 * 132; i += 64) IMP[w * 8 * 132 + i] = 0.f;
    LAS float* OT = (LAS float*)(L + P8_OT) + w * 2048 + lane;
    AttState st; v4u kr, vr; const float zb[2] = {0.f, 0.f}; const bool on[2] = {true, true};
    auto combine = [&](int br) {
#pragma unroll
        for (int c = 0; c < 2; ++c) { float linv[4]; if (br == 0) {
#pragma unroll
                for (int r = 0; r < 4; ++r) linv[r] = 1.f; } else att_finish(st, c, lane, linv);
#pragma unroll
            for (int r = 0; r < 4; ++r) { const float gt = GT[(rowbase + 8 * w + 4 * c + lq) * 48 + g * 12 + r * 3 + br] * linv[r];
#pragma unroll
                for (int d = 0; d < 4; ++d) { LAS float* p = OT + ((c * 4 + d) * 4 + r) * 64; const float v = gt * st.o[c][d][r]; *p = br == 0 ? v : *p + v; } } }
    };
    const int ncv = 4 * qb + 3, ncb = (ncv + 63) >> 6;
    const bf16* kc0 = KCP + (size_t)b * 512 * 512 + g * 64;
    int clo[2] = {0, 0}, chi[2];
    att_init(st);
    for (int pass = 0; pass < 2; ++pass) {
        if (pass == 1) {
#pragma unroll
            for (int c = 0; c < 2; ++c) { float l = st.l[c]; l += __shfl_xor(l, 16); l += __shfl_xor(l, 32); st.l[c] = 1.0f / fmaxf(l, 1e-30f); } }
        __syncthreads();
        p8_load(kc0, kc0 + 256, 512, tid, kr, vr); p8_store(L + P8_KT, L + P8_VT, tid, kr, vr);
        __syncthreads();
        for (int blk = 0; blk < ncb; ++blk) {
            const int buf = blk & 1;
            if (blk + 1 < ncb) p8_load(kc0 + (size_t)(blk + 1) * 64 * 512, kc0 + (size_t)(blk + 1) * 64 * 512 + 256, 512, tid, kr, vr);
#pragma unroll
            for (int c = 0; c < 2; ++c) chi[c] = ((qb * 64 + tl[c] - 31) >> 4) - 64 * blk;
            if (pass == 0) wave_block<4, 1>(L + P8_KT + buf * 64 * KT_STRIDE, L + P8_VT + buf * 64 * VT_STRIDE, qf, st, zb, on, true, clo, chi, lane, nullptr, 0, 0);
            else           wave_block<4, 2>(L + P8_KT + buf * 64 * KT_STRIDE, L + P8_VT + buf * 64 * VT_STRIDE, qf, st, zb, on, true, clo, chi, lane, IMP + w * 8 * 132, blk * 16, 132);
            if (blk + 1 < ncb) p8_store(L + P8_KT + (buf ^ 1) * 64 * KT_STRIDE, L + P8_VT + (buf ^ 1) * 64 * VT_STRIDE, tid, kr, vr);
            __syncthreads();
        }
    }
    combine(0);
    LDS_WAIT();
    for (int t8 = 0; t8 < 8; ++t8) { const LAS float* ir = IMP + (w * 8 + t8) * 132; unsigned long long s0, s1;
        select_blocks(ir[lane], ir[lane + 64], qb, lane, s0, s1);
        if (lane == 0) { LAS unsigned* sb = SELB + (w * 8 + t8) * 4; sb[0] = (unsigned)s0; sb[1] = (unsigned)(s0 >> 32); sb[2] = (unsigned)s1; sb[3] = (unsigned)(s1 >> 32); } }
    LDS_WAIT();
    unsigned mysel[2][4], usel[2][4];
#pragma unroll
    for (int c = 0; c < 2; ++c)
#pragma unroll
        for (int i = 0; i < 4; ++i) { mysel[c][i] = SELB[tl[c] * 4 + i];
            usel[c][i] = __builtin_amdgcn_readfirstlane(SELB[(8 * w + 4 * c + 0) * 4 + i] | SELB[(8 * w + 4 * c + 1) * 4 + i] | SELB[(8 * w + 4 * c + 2) * 4 + i] | SELB[(8 * w + 4 * c + 3) * 4 + i]); }
    {
        att_init(st);
        const bf16* k0 = KVB + (size_t)b * TP * NKV + 512 + g * 64; int lo2[2] = {0, 0}, hi2[2] = {tl[0], tl[1]};
        __syncthreads();
        p8_load(k0, k0 + 256, NKV, tid, kr, vr); p8_store(L + P8_KT, L + P8_VT, tid, kr, vr);
        __syncthreads();
        for (int jb = 0; jb <= qb; ++jb) {
            const int buf = jb & 1;
            if (jb < qb) p8_load(k0 + (size_t)(jb + 1) * 64 * NKV, k0 + (size_t)(jb + 1) * 64 * NKV + 256, NKV, tid, kr, vr);
            float bias[2]; bool act[2];
#pragma unroll
            for (int c = 0; c < 2; ++c) { bias[c] = ((pick4(mysel[c], jb >> 5) >> (jb & 31)) & 1u) ? 0.f : S_NEG; act[c] = ((pick4(usel[c], jb >> 5) >> (jb & 31)) & 1u) != 0u; }
            wave_block<4, 0>(L + P8_KT + buf * 64 * KT_STRIDE, L + P8_VT + buf * 64 * VT_STRIDE, qf, st, bias, act, jb == qb, lo2, hi2, lane, nullptr, 0, 0);
            if (jb < qb) p8_store(L + P8_KT + (buf ^ 1) * 64 * KT_STRIDE, L + P8_VT + (buf ^ 1) * 64 * VT_STRIDE, tid, kr, vr);
            __syncthreads();
        }
        combine(1);
    }
    {
        att_init(st);
        const int jb0 = qb >= 8 ? qb - 8 : 0;
        const bf16* k0 = KVB + (size_t)b * TP * NKV + 1024 + g * 64;
        __syncthreads();
        p8_load(k0 + (size_t)jb0 * 64 * NKV, k0 + (size_t)jb0 * 64 * NKV + 256, NKV, tid, kr, vr); p8_store(L + P8_KT, L + P8_VT, tid, kr, vr);
        __syncthreads();
        for (int jb = jb0; jb <= qb; ++jb) {
            const int buf = (jb - jb0) & 1;
            if (jb < qb) p8_load(k0 + (size_t)(jb + 1) * 64 * NKV, k0 + (size_t)(jb + 1) * 64 * NKV + 256, NKV, tid, kr, vr);
            int lo2[2], hi2[2]; const bool low = (qb >= 8 && jb == qb - 8), top = (jb == qb);
#pragma unroll
            for (int c = 0; c < 2; ++c) { lo2[c] = low ? tl[c] : 0; hi2[c] = top ? tl[c] : 63; }
            wave_block<4, 0>(L + P8_KT + buf * 64 * KT_STRIDE, L + P8_VT + buf * 64 * VT_STRIDE, qf, st, zb, on, low || top, lo2, hi2, lane, nullptr, 0, 0);
            if (jb < qb) p8_store(L + P8_KT + (buf ^ 1) * 64 * KT_STRIDE, L + P8_VT + (buf ^ 1) * 64 * VT_STRIDE, tid, kr, vr);
            __syncthreads();
        }
        combine(2);
    }
#pragma unroll
    for (int c = 0; c < 2; ++c)
#pragma unroll
        for (int r = 0; r < 4; ++r)
#pragma unroll
            for (int d = 0; d < 4; ++d) O[(rowbase + 8 * w + 4 * c + lq) * DM + g * 256 + r * 64 + d * 16 + l15] = (bf16)f2bf(OT[((c * 4 + d) * 4 + r) * 64]);
}

constexpr int P8S_WAVE = 11008, P8S_KT = 0, P8S_VT = 32 * KT_STRIDE, P8S_IMP = P8S_VT + 32 * VT_STRIDE, P8S_OL = 8 * P8S_WAVE, P8S_ML = P8S_OL + 8 * 8192, P8S_END = P8S_ML + 8 * 256;
static_assert(P8S_IMP + 8 * 40 * 4 <= P8S_WAVE && P8S_END <= RING_BYTES, "sample attention LDS");
struct P8sRegs { f32x4 k[8], v[8]; };
__device__ __forceinline__ void p8s_load_f32(P8sRegs& R, const float* kp, const float* vp, int lane) {
    asm volatile("" : "+v"(lane)); const int r0 = lane >> 4, ch = lane & 15;
#pragma unroll
    for (int i = 0; i < 8; ++i) { R.k[i] = *(const GAS f32x4*)(kp + (size_t)(4 * i + r0) * 512 + ch * 4); R.v[i] = *(const GAS f32x4*)(vp + (size_t)(4 * i + r0) * 512 + ch * 4); }
}
__device__ __forceinline__ void p8s_store_f32(const P8sRegs& R, LAS unsigned char* kt, LAS unsigned char* vt, int lane) {
    asm volatile("" : "+v"(lane)); const int r0 = lane >> 4, ch = lane & 15;
#pragma unroll
    for (int i = 0; i < 8; ++i) { v2u a, b; a.x = pg8::cvt_pk_bf16(R.k[i][0], R.k[i][1]); a.y = pg8::cvt_pk_bf16(R.k[i][2], R.k[i][3]); b.x = pg8::cvt_pk_bf16(R.v[i][0], R.v[i][1]); b.y = pg8::cvt_pk_bf16(R.v[i][2], R.v[i][3]);
        *(LAS v2u*)(kt + (4 * i + r0) * KT_STRIDE + ch * 8) = a; *(LAS v2u*)(vt + (4 * i + r0) * VT_STRIDE + ch * 8) = b; }
}
__device__ __forceinline__ void p8s_stage_bf16(const bf16* kp, const bf16* vp, size_t stride, int nrows, LAS unsigned char* kt, LAS unsigned char* vt, int lane) {
    asm volatile("" : "+v"(lane));
    v4u rk[4], rv[4]; const int r0 = lane >> 3, ch = lane & 7;
#pragma unroll
    for (int i = 0; i < 4; ++i) { const int row = 8 * i + r0; rk[i] = (v4u){0u, 0u, 0u, 0u}; rv[i] = rk[i];
        if (row < nrows) { rk[i] = *(const GAS v4u*)(kp + (size_t)row * stride + ch * 8); rv[i] = *(const GAS v4u*)(vp + (size_t)row * stride + ch * 8); } }
#pragma unroll
    for (int i = 0; i < 4; ++i) { const int row = 8 * i + r0; *(LAS v4u*)(kt + row * KT_STRIDE + ch * 16) = rk[i]; *(LAS v4u*)(vt + row * VT_STRIDE + ch * 16) = rv[i]; }
}
__device__ __forceinline__ void p8_sample_pair(Frame& F, const Args& A, int u, bool valid) {
    unsigned char* ws = A.ws; const bf16* KVB = (const bf16*)(ws + WS_KVB); const bf16* QB = (const bf16*)(ws + WS_QB); const bf16* KCS = (const bf16*)(ws + WS_KCS);
    const float* GT = (const float*)(ws + WS_GT); bf16* O = (bf16*)(ws + WS_O); const int* ptab = (const int*)A.in[I_PT];
    const int n = u >> 2, g = u & 3, sp = F.wave & 3, q0 = F.wave & 4;
    LAS unsigned char* L = F.lds + RING_OFF + F.wave * P8S_WAVE; LAS unsigned char* kt = L + P8S_KT; LAS unsigned char* vt = L + P8S_VT; LAS float* IMP = (LAS float*)(L + P8S_IMP);
    LAS float* OL = (LAS float*)(F.lds + RING_OFF + P8S_OL); LAS float* ML = (LAS float*)(F.lds + RING_OFF + P8S_ML);
    const int lane = F.lane, l15 = lane & 15, lq = lane >> 4;
    const size_t rowbase = (size_t)MP + (size_t)n * TS;
    bf16x8 qf[2][2];
#pragma unroll
    for (int c = 0; c < 2; ++c)
#pragma unroll
        for (int ks = 0; ks < 2; ++ks) qf[c][ks] = *(const GAS bf16x8*)(QB + (rowbase + 4 * c + (l15 >> 2)) * DM + g * 256 + (l15 & 3) * 64 + ks * 32 + lq * 8);
    int tl[2]; tl[0] = l15 >> 2; tl[1] = tl[0] + 4;
    for (int i = lane; i < 8 * 40; i += 64) IMP[i] = 0.f;
    AttState st; const float zb[2] = {0.f, 0.f}; const bool on[2] = {true, true};
    f32x4 fin[2];
    auto publish = [&]() {
#pragma unroll
        for (int c = 0; c < 2; ++c) { float l = st.l[c]; l += __shfl_xor(l, 16); l += __shfl_xor(l, 32);
            if (lq == 0) { ML[((F.wave * 2 + c) * 16 + l15) * 2] = st.m[c]; ML[((F.wave * 2 + c) * 16 + l15) * 2 + 1] = l; }
#pragma unroll
            for (int d = 0; d < 4; ++d)
#pragma unroll
                for (int r = 0; r < 4; ++r) OL[(F.wave * 32 + (c * 4 + d) * 4 + r) * 64 + lane] = st.o[c][d][r]; }
    };
    auto merge = [&](int br) {
#pragma unroll
        for (int k = 0; k < 2; ++k) { const int p = 2 * sp + k, c = p >> 2, d = p & 3;
#pragma unroll
            for (int r = 0; r < 4; ++r) { const int qrow = 4 * lq + r; float mi[4], li[4], M = -3.0e38f;
#pragma unroll
                for (int i = 0; i < 4; ++i) { mi[i] = ML[(((q0 + i) * 2 + c) * 16 + qrow) * 2]; li[i] = ML[(((q0 + i) * 2 + c) * 16 + qrow) * 2 + 1]; M = fmaxf(M, mi[i]); }
                float Ls = 0.f, Os = 0.f;
#pragma unroll
                for (int i = 0; i < 4; ++i) { const float wgt = __builtin_amdgcn_exp2f(mi[i] - M); Ls += wgt * li[i]; Os += wgt * OL[((q0 + i) * 32 + (c * 4 + d) * 4 + r) * 64 + lane]; }
                const float gt = GT[(rowbase + 4 * c + lq) * 48 + g * 12 + r * 3 + br];
                fin[k][r] += gt * Os / fmaxf(Ls, 1e-30f); } }
    };
#define WSYNC() do { LDS_WAIT(); asm volatile("" ::: "memory"); } while (0)
    if (valid) {
    const bf16* kc0 = KCS + (size_t)n * 128 * 512 + g * 64;
    int clo[2] = {0, 0}, chi[2];
    att_init(st);
    for (int pass = 0; pass < 2; ++pass) {
        if (pass == 1) {
#pragma unroll
            for (int c = 0; c < 2; ++c) { float l = st.l[c]; l += __shfl_xor(l, 16); l += __shfl_xor(l, 32); st.l[c] = 1.0f / fmaxf(l, 1e-30f); } }
        for (int hb = 0; hb < 4; ++hb) {
            WSYNC(); p8s_stage_bf16(kc0 + (size_t)hb * 32 * 512, kc0 + (size_t)hb * 32 * 512 + 256, 512, 32, kt, vt, lane); WSYNC();
            chi[0] = 126 - 32 * hb; chi[1] = chi[0];
            if (pass == 0) wave_block<2, 1>(kt, vt, qf, st, zb, on, hb == 3, clo, chi, lane, nullptr, 0, 0);
            else           wave_block<2, 2>(kt, vt, qf, st, zb, on, hb == 3, clo, chi, lane, IMP, hb * 8, 40);
        }
    }
#pragma unroll
    for (int c = 0; c < 2; ++c)
#pragma unroll
        for (int d = 0; d < 4; ++d)
#pragma unroll
            for (int r = 0; r < 4; ++r) OL[(F.wave * 32 + (c * 4 + d) * 4 + r) * 64 + lane] = st.o[c][d][r];
    WSYNC();
#pragma unroll
    for (int k = 0; k < 2; ++k) { const int p = 2 * sp + k, c = p >> 2, d = p & 3;
#pragma unroll
        for (int r = 0; r < 4; ++r) fin[k][r] = GT[(rowbase + 4 * c + lq) * 48 + g * 12 + r * 3 + 0] * OL[(F.wave * 32 + (c * 4 + d) * 4 + r) * 64 + lane]; }
    }
    unsigned mysel[2][2] = {{0u, 0u}, {0u, 0u}};
    if (valid) {
    WSYNC();
    unsigned selw[8][2];
#pragma unroll
    for (int t8 = 0; t8 < 8; ++t8) { unsigned long long s0, s1; const float v0 = lane < 33 ? IMP[t8 * 40 + lane] : 0.f; select_blocks(v0, 0.f, 32, lane, s0, s1); selw[t8][0] = (unsigned)s0; selw[t8][1] = (unsigned)(s0 >> 32); }
#pragma unroll
    for (int c = 0; c < 2; ++c)
#pragma unroll
        for (int i = 0; i < 2; ++i) { const int tt = l15 >> 2; const unsigned a0 = selw[4 * c + 0][i], a1 = selw[4 * c + 1][i], a2 = selw[4 * c + 2][i], a3 = selw[4 * c + 3][i];
            mysel[c][i] = tt == 0 ? a0 : tt == 1 ? a1 : tt == 2 ? a2 : a3; }
    }
    __syncthreads();
    if (valid) {
        att_init(st);
        const float* cache = A.in[I_CSLC]; int lo2[2] = {0, 0}, hi2[2] = {tl[0], tl[1]};
        P8sRegs R;
        { const int pg = ptab[n * NPAGE + (sp >> 2)]; const float* kp = cache + ((size_t)pg * PAGE + (sp & 3) * 32) * 512 + g * 64; p8s_load_f32(R, kp, kp + 256, lane); }
        for (int hb = sp; hb < 64; hb += 4) {
            WSYNC(); p8s_store_f32(R, kt, vt, lane);
            if (hb + 4 < 64) { const int h2 = hb + 4, pg = ptab[n * NPAGE + (h2 >> 2)]; const float* kp = cache + ((size_t)pg * PAGE + (h2 & 3) * 32) * 512 + g * 64; p8s_load_f32(R, kp, kp + 256, lane); }
            WSYNC();
            const int jb = hb >> 1; float bias[2];
#pragma unroll
            for (int c = 0; c < 2; ++c) bias[c] = (((jb < 32 ? mysel[c][0] : mysel[c][1]) >> (jb & 31)) & 1u) ? 0.f : S_NEG;
            wave_block<2, 0>(kt, vt, qf, st, bias, on, false, lo2, hi2, lane, nullptr, 0, 0);
        }
        if (sp == 0) {
            WSYNC(); { const bf16* kp = KVB + rowbase * NKV + 512 + g * 64; p8s_stage_bf16(kp, kp + 256, NKV, 8, kt, vt, lane); } WSYNC();
            wave_block<2, 0>(kt, vt, qf, st, zb, on, true, lo2, hi2, lane, nullptr, 0, 0);
        }
        publish();
    }
    __syncthreads();
    if (valid) merge(1);
    __syncthreads();
    if (valid) {
        att_init(st);
        const float* sw = A.in[I_SWIN] + (size_t)n * 512 * 512 + g * 64;
        P8sRegs R;
        p8s_load_f32(R, sw + (size_t)sp * 32 * 512, sw + (size_t)sp * 32 * 512 + 256, lane);
        for (int hb = sp; hb < 16; hb += 4) {
            WSYNC(); p8s_store_f32(R, kt, vt, lane);
            if (hb + 4 < 16) p8s_load_f32(R, sw + (size_t)(hb + 4) * 32 * 512, sw + (size_t)(hb + 4) * 32 * 512 + 256, lane);
            WSYNC();
            int lo2[2], hi2[2];
#pragma unroll
            for (int c = 0; c < 2; ++c) { lo2[c] = tl[c] - 32 * hb; hi2[c] = 512 + tl[c] - 32 * hb; }
            wave_block<2, 0>(kt, vt, qf, st, zb, on, hb == 0, lo2, hi2, lane, nullptr, 0, 0);
        }
        if (sp == 0) {
            WSYNC(); { const bf16* kp = KVB + rowbase * NKV + 1024 + g * 64; p8s_stage_bf16(kp, kp + 256, NKV, 8, kt, vt, lane); } WSYNC();
            int lo2[2], hi2[2];
#pragma unroll
            for (int c = 0; c < 2; ++c) { lo2[c] = tl[c] - 512; hi2[c] = tl[c]; }
            wave_block<2, 0>(kt, vt, qf, st, zb, on, true, lo2, hi2, lane, nullptr, 0, 0);
        }
        publish();
    }
    __syncthreads();
    if (valid) { merge(2);
#pragma unroll
        for (int k = 0; k < 2; ++k) { const int p = 2 * sp + k, c = p >> 2, d = p & 3;
#pragma unroll
            for (int r = 0; r < 4; ++r) O[(rowbase + 4 * c + lq) * DM + g * 256 + r * 64 + d * 16 + l15] = (bf16)f2bf(fin[k][r]); } }
    __syncthreads();
#undef WSYNC
}
__device__ __forceinline__ void p8_attention(Frame& F, const Args& A) {
    for (int ub = 2 * F.vcu; ub < NBS * 4; ub += 2 * F.G) { const int u = ub + (F.wave >> 2); p8_sample_pair(F, A, u < NBS * 4 ? u : 0, u < NBS * 4); }
    __syncthreads();
    for (int u = F.vcu; u < NBP * 128 * 4; u += F.G) { const int qb = 127 - (u >> 3), b = (u >> 2) & 1, g = u & 3; p8_prompt_unit(F, A, b, qb, g); }
}
#define P8_BODY p8_attention(F, args);
constexpr int N_PHASES = 14;
__global__ void __launch_bounds__(NWAVES * 64, 2) yoco_fwd(Args args) {
    extern __shared__ __attribute__((aligned(16))) unsigned char lds[];
    Frame F;
    F.lds = (LAS unsigned char*)lds; F.MISC = (volatile LAS unsigned*)(F.lds + MISC_OFF);
    F.tid = threadIdx.x; F.lane = F.tid & 63; F.wave = __builtin_amdgcn_readfirstlane(F.tid >> 6);
    F.G = gridDim.x; { const int bx = blockIdx.x; F.vcu = (F.G % 8 == 0) ? (bx % 8) * (F.G / 8) + bx / 8 : bx; }
    unsigned char* ws = args.ws;
    F.ctl = (gu32*)(ws + WS_CTL);
    for (int u = F.tid; u < (LDS_BYTES - LDSCTL_OFF) / 4; u += NWAVES * 64) ((LAS unsigned*)(F.lds + LDSCTL_OFF))[u] = 0u;
    __syncthreads();
    const int lo = args.ph_lo, hi = args.ph_hi;
    const bool multi = (hi - lo) > 1;
    XcdBarrier bar; bar.bar = (unsigned*)(F.ctl + CW_BAR); bar.x = 0; bar.st = nullptr;
    if (multi) bar = xcd_barrier_post((unsigned*)(F.ctl + CW_BAR), F.MISC + 8);
#define IN(k) (lo <= (k) && (k) < hi)
#define SEAM(k) do { if (IN(k) && IN((k) + 1)) xcd_barrier(bar); } while (0)
    bf16* const XB = (bf16*)(ws + WS_XB); bf16* const BBp = (bf16*)(ws + WS_BB); bf16* const VBp = (bf16*)(ws + WS_VB); bf16* const Zp = (bf16*)(ws + WS_Z);
    float* const Hp = (float*)(ws + WS_H); bf16* const HBp = (bf16*)(ws + WS_HB); bf16* const ACTp = (bf16*)(ws + WS_ACT); bf16* const KVBp = (bf16*)(ws + WS_KVB);
    bf16* const QBp = (bf16*)(ws + WS_QB); bf16* const Op = (bf16*)(ws + WS_O); float* const GTp = (float*)(ws + WS_GT);
    float* const SSQ = (float*)(ws + WS_SSQ); constexpr size_t SSQ_STRIDE = (size_t)MT * 16;
    const int c = (int)blockIdx.x;

    if (IN(0)) { p0_prologue(F, args); }
    SEAM(0);
    if (IN(1)) { pg8::Gemm g{XB, (const bf16*)(ws + WS_WAIN), MT, NAIN, DM}; pg8::StaticOrder S; S.init(MT, NAIN, F.G, c);
        pg8::EpiAin E{VBp, BBp, (const float*)(ws + WS_RSTD0)};
        pg8::gemm_phase<pg8::EpiAin, pg8::StaticOrder, PG8_ALIGN, PG8_SP2>(F.lds + RING_OFF, g, S, E); }
    SEAM(1);
    if (IN(2)) { p2_conv(F, args); }
    SEAM(2);
    if (IN(3)) { pg8::Gemm g{Zp, (const bf16*)(ws + WS_WAOUT), MT, DM, DM}; pg8::StaticOrder S; S.init(MT, DM, F.G, c);
        pg8::EpiRes E{args.in[I_XP], args.in[I_XS], Hp, HBp, SSQ + 0 * SSQ_STRIDE};
        pg8::gemm_phase<pg8::EpiRes, pg8::StaticOrder, PG8_ALIGN, PG8_SP2>(F.lds + RING_OFF, g, S, E); }
    SEAM(3);
    if (IN(4)) { pg8::Gemm g{HBp, (const bf16*)(ws + WS_WFIN0), MT, NFF, DM}; pg8::StaticOrder S; S.init(MT, NFF, F.G, c);
        pg8::EpiFfn E{ACTp, SSQ + 0 * SSQ_STRIDE};
        pg8::gemm_phase<pg8::EpiFfn, pg8::StaticOrder, PG8_ALIGN, PG8_SP2>(F.lds + RING_OFF, g, S, E); }
    SEAM(4);
    if (IN(5)) { pg8::Gemm g{ACTp, (const bf16*)(ws + WS_WFOUT0), MT, DM, DFF}; pg8::StaticOrder S; S.init(MT, DM, F.G, c);
        pg8::EpiRes E{Hp, Hp + (size_t)MP * DM, Hp, HBp, SSQ + 1 * SSQ_STRIDE};
        pg8::gemm_phase<pg8::EpiRes, pg8::StaticOrder, PG8_ALIGN, PG8_SP2>(F.lds + RING_OFF, g, S, E); }
    SEAM(5);
    if (IN(6)) { pg8::Gemm g{HBp, (const bf16*)(ws + WS_WKVQ), MT, NKVQ, DM}; pg8::StaticOrder S; S.init(MT, NKVQ, F.G, c);
        pg8::EpiKvq E{KVBp, QBp, GTp, SSQ + 1 * SSQ_STRIDE, args.out + O_CMPP, args.out + O_CMPS, args.out + O_SLCP, args.out + O_SLCS, args.out + O_WINP, args.out + O_WINS};
        pg8::gemm_phase<pg8::EpiKvq, pg8::StaticOrder, PG8_ALIGN, PG8_SP2>(F.lds + RING_OFF, g, S, E); }
    SEAM(6);
    if (IN(7)) { P7_BODY }
    SEAM(7);
    if (IN(8)) { P8_BODY }
    SEAM(8);
    if (IN(9)) { pg8::Gemm g{Op, (const bf16*)(ws + WS_WBOUT), MT, DM, DM}; pg8::StaticOrder S; S.init(MT, DM, F.G, c);
        pg8::EpiRes E{Hp, Hp + (size_t)MP * DM, Hp, HBp, SSQ + 2 * SSQ_STRIDE};
        pg8::gemm_phase<pg8::EpiRes, pg8::StaticOrder, PG8_ALIGN, PG8_SP2>(F.lds + RING_OFF, g, S, E); }
    SEAM(9);
    if (IN(10)) { pg8::Gemm g{HBp, (const bf16*)(ws + WS_WFIN1), MT, NFF, DM}; pg8::StaticOrder S; S.init(MT, NFF, F.G, c);
        pg8::EpiFfn E{ACTp, SSQ + 2 * SSQ_STRIDE};
        pg8::gemm_phase<pg8::EpiFfn, pg8::StaticOrder, PG8_ALIGN, PG8_SP2>(F.lds + RING_OFF, g, S, E); }
    SEAM(10);
    if (IN(11)) { pg8::Gemm g{ACTp, (const bf16*)(ws + WS_WFOUT1), MT, DM, DFF}; pg8::StaticOrder S; S.init(MT, DM, F.G, c);
        pg8::EpiRes E{Hp, Hp + (size_t)MP * DM, Hp, nullptr, nullptr};
        pg8::gemm_phase<pg8::EpiRes, pg8::StaticOrder, PG8_ALIGN, PG8_SP2>(F.lds + RING_OFF, g, S, E); }
    SEAM(11);
    if (IN(12)) { p_final(F, args); }
#undef IN
#undef SEAM
}

#ifndef MK_PER_PHASE
#define MK_PER_PHASE 0
#endif
extern "C" void kernel_launch(void* const* d_in, const int* in_sizes, int n_in, void* d_out, int out_size, void* d_ws, size_t ws_size, hipStream_t stream) {
    static int grid = 0;
    if (grid == 0) {
        if (n_in != 21 || out_size != (int)O_END || ws_size < WS_END) { fprintf(stderr, "kernel_launch: unexpected shapes (n_in %d out %d ws %zu)\n", n_in, out_size, ws_size); grid = -1; return; }
        int dev = 0, cus = 0, per_cu = 0;
        if (hipGetDevice(&dev) != hipSuccess || hipDeviceGetAttribute(&cus, hipDeviceAttributeMultiprocessorCount, dev) != hipSuccess) { grid = -1; return; }
        if (hipFuncSetAttribute((const void*)yoco_fwd, hipFuncAttributeMaxDynamicSharedMemorySize, LDS_BYTES) != hipSuccess) { fprintf(stderr, "kernel_launch: hipFuncSetAttribute failed\n"); grid = -1; return; }
        if (hipOccupancyMaxActiveBlocksPerMultiprocessor(&per_cu, (const void*)yoco_fwd, NWAVES * 64, LDS_BYTES) != hipSuccess || per_cu < 1) { fprintf(stderr, "kernel_launch: occupancy query says %d\n", per_cu); }
        (void)hipGetLastError();
        grid = cus;
    }
    if (grid < 0) return;
    if (hipMemsetAsync((char*)d_ws + WS_CTL, 0, CTL_ZERO_BYTES, stream) != hipSuccess) return;
    Args a{};
    for (int i = 0; i < 21; ++i) a.in[i] = (const float*)d_in[i];
    a.out = (float*)d_out; a.ws = (unsigned char*)d_ws;
#if MK_PER_PHASE
    for (int p = 0; p < N_PHASES - 1; ++p) { a.ph_lo = p; a.ph_hi = p + 1; hipLaunchKernelGGL(yoco_fwd, dim3(grid), dim3(NWAVES * 64), LDS_BYTES, stream, a); }
#else
    a.ph_lo = 0; a.ph_hi = N_PHASES; hipLaunchKernelGGL(yoco_fwd, dim3(grid), dim3(NWAVES * 64), LDS_BYTES, stream, a);
#endif
}
```

```cpp
#include <hip/hip_runtime.h>
#include <cstdio>
#include <cstdint>
namespace pg8 {
#define PG8_LAS __attribute__((address_space(3)))
typedef unsigned short bf16_t;
typedef short bf16x8 __attribute__((ext_vector_type(8)));
typedef float f32x4 __attribute__((ext_vector_type(4)));
typedef unsigned u32x4 __attribute__((ext_vector_type(4)));
constexpr int BM = 256, BK = 64, HALF = 128, HTB = HALF * BK * 2  , STAGE_BYTES = 8 * HTB, NXCD = 8, WGM = 8;

__host__ __device__ __forceinline__ int lds_byte(int r, int c) { const int st = (r >> 4) * 2 + (c >> 5), rr = r & 15, cc = c & 31, ob = rr * 64 + cc * 2; return st * 1024 + (ob ^ (((ob >> 9) & 1) << 5)); }
__host__ __device__ __forceinline__ void stage_rc(int b, int& R, int& C) { const int st = b / 1024, sb = b % 1024, swz = sb ^ (((sb >> 9) & 1) << 5); R = (st >> 1) * 16 + swz / 64; C = (st & 1) * 32 + (swz % 64) / 2; }
__host__ __device__ __forceinline__ int perm32(int rho) { const int n = rho >> 4, i = rho & 15; return 8 * (i >> 2) + 4 * n + (i & 3); }

struct Unit { int pm, pn; };
struct Gemm { const bf16_t* A; const bf16_t* Bt; int M, N, K; };

struct StaticOrder {
    int nM, nN, nwg, G, c;
    __host__ __device__ void init(int M, int N, int G_, int c_) { nM = M / BM; nN = N / BM; nwg = nM * nN; G = G_; c = c_; }
    __host__ __device__ bool next(int i, Unit& u) const {
        const long L = (long)i * G + c; if (L >= nwg) return false;
        int wgid = (int)L; { const int q = nwg / NXCD, r = nwg % NXCD, xcd = wgid % NXCD, off = wgid / NXCD; wgid = (xcd < r ? xcd * (q + 1) : r * (q + 1) + (xcd - r) * q) + off; }
        const int nig = WGM * nN, gid = wgid / nig, fm = gid * WGM, gsz = (nM - fm) < WGM ? (nM - fm) : WGM;
        u.pm = fm + ((wgid % nig) % gsz); u.pn = (wgid % nig) / gsz; return true;
    }
    __device__ __forceinline__ void a_ready(const Unit&) const {}
    __device__ __forceinline__ void done(const Unit&) const {}
};

__device__ __forceinline__ unsigned cvt_pk_bf16(float lo, float hi) { unsigned r; asm volatile("v_cvt_pk_bf16_f32 %0, %1, %2" : "=v"(r) : "v"(lo), "v"(hi)); return r; }
constexpr int E_MP = 16384;
constexpr float E_EPS = 1e-6f;
__device__ __forceinline__ float row_rstd16(const float* ssqp, int row, int fq) {
    const f32x4 p = *(const f32x4*)(ssqp + (size_t)row * 16 + fq * 4);
    float s = (p[0] + p[1]) + (p[2] + p[3]); s += __shfl_xor(s, 16); s += __shfl_xor(s, 32);
    return __builtin_amdgcn_rsqf(s * (1.0f / 1024.0f) + E_EPS);
}
__device__ __forceinline__ u32x4 pack8(const f32x4 a, const f32x4 b) { u32x4 w; w.x = cvt_pk_bf16(a[0], a[1]); w.y = cvt_pk_bf16(a[2], a[3]); w.z = cvt_pk_bf16(b[0], b[1]); w.w = cvt_pk_bf16(b[2], b[3]); return w; }

struct EpiAin {
    static constexpr bool PERM = true, AFTER_DRAIN = false;
    bf16_t* VB; bf16_t* BB; const float* rstd;
    __device__ __forceinline__ void operator()(const f32x4 (&acc)[2][2][4][2], const Unit& u, int wr, int wc, int fr, int fq) const {
        const int row0 = u.pm * BM + wr * 64 + fr;
        if (u.pn < 8) {
            const int ch = u.pn * 128 + wc * 32 + 8 * fq;
#pragma unroll
            for (int ai = 0; ai < 2; ++ai)
#pragma unroll
                for (int m = 0; m < 4; ++m) { const int row = row0 + ai * HALF + m * 16; const float r = rstd[row], r2 = r * r;
                    const f32x4 v0 = acc[ai][0][m][0] * acc[ai][1][m][0] * r2, v1 = acc[ai][0][m][1] * acc[ai][1][m][1] * r2;
                    *(u32x4*)(VB + (size_t)row * 1024 + ch) = pack8(v0, v1); }
        } else {
            const int ch = (u.pn - 8) * 256 + wc * 32 + 8 * fq;
#pragma unroll
            for (int ai = 0; ai < 2; ++ai)
#pragma unroll
                for (int m = 0; m < 4; ++m) { const int row = row0 + ai * HALF + m * 16; const float r = rstd[row];
#pragma unroll
                    for (int bj = 0; bj < 2; ++bj) *(u32x4*)(BB + (size_t)row * 1024 + ch + bj * HALF) = pack8(acc[ai][bj][m][0] * r, acc[ai][bj][m][1] * r); }
        }
    }
};
struct EpiRes {
    static constexpr bool PERM = true, AFTER_DRAIN = false;
    const bf16_t* base; bf16_t* HB; float* ssqp;
    __device__ __forceinline__ void operator()(const f32x4 (&acc)[2][2][4][2], const Unit& u, int wr, int wc, int fr, int fq) const {
        const int row0 = u.pm * BM + wr * 64 + fr, col0 = u.pn * BM + wc * 32 + 8 * fq;
#pragma unroll
        for (int ai = 0; ai < 2; ++ai)
#pragma unroll
            for (int m = 0; m < 4; ++m) { const int row = row0 + ai * HALF + m * 16; const size_t off = (size_t)row * 1024 + col0; float ss = 0.f;
#pragma unroll
                for (int bj = 0; bj < 2; ++bj) { const u32x4 bw = *(const u32x4*)(base + off + bj * HALF);
                    f32x4 h0, h1;
                    h0[0] = __builtin_bit_cast(float, bw.x << 16) + acc[ai][bj][m][0][0]; h0[1] = __builtin_bit_cast(float, bw.x & 0xffff0000u) + acc[ai][bj][m][0][1];
                    h0[2] = __builtin_bit_cast(float, bw.y << 16) + acc[ai][bj][m][0][2]; h0[3] = __builtin_bit_cast(float, bw.y & 0xffff0000u) + acc[ai][bj][m][0][3];
                    h1[0] = __builtin_bit_cast(float, bw.z << 16) + acc[ai][bj][m][1][0]; h1[1] = __builtin_bit_cast(float, bw.z & 0xffff0000u) + acc[ai][bj][m][1][1];
                    h1[2] = __builtin_bit_cast(float, bw.w << 16) + acc[ai][bj][m][1][2]; h1[3] = __builtin_bit_cast(float, bw.w & 0xffff0000u) + acc[ai][bj][m][1][3];
                    const u32x4 o = pack8(h0, h1); *(u32x4*)(HB + off + bj * HALF) = o;
                    if (ssqp) { const float r0 = __builtin_bit_cast(float, o.x << 16), r1 = __builtin_bit_cast(float, o.x & 0xffff0000u), r2 = __builtin_bit_cast(float, o.y << 16), r3 = __builtin_bit_cast(float, o.y & 0xffff0000u),
                                            r4 = __builtin_bit_cast(float, o.z << 16), r5 = __builtin_bit_cast(float, o.z & 0xffff0000u), r6 = __builtin_bit_cast(float, o.w << 16), r7 = __builtin_bit_cast(float, o.w & 0xffff0000u);
                        ss += (r0 * r0 + r1 * r1) + (r2 * r2 + r3 * r3) + (r4 * r4 + r5 * r5) + (r6 * r6 + r7 * r7); } }
                if (ssqp) { ss += __shfl_xor(ss, 16); ss += __shfl_xor(ss, 32); if (fq == 0) ssqp[(size_t)row * 16 + u.pn * 4 + wc] = ss; }
                if (m & 1) asm volatile("" ::: "memory"); }
    }
};
struct EpiFfn {
    static constexpr bool PERM = true, AFTER_DRAIN = false;
    bf16_t* ACT; const float* ssqp;
    __device__ __forceinline__ void operator()(const f32x4 (&acc)[2][2][4][2], const Unit& u, int wr, int wc, int fr, int fq) const {
        const int row0 = u.pm * BM + wr * 64 + fr, ch = u.pn * 128 + wc * 32 + 8 * fq;
#pragma unroll
        for (int ai = 0; ai < 2; ++ai)
#pragma unroll
            for (int m = 0; m < 4; ++m) { const int row = row0 + ai * HALF + m * 16; const float r = row_rstd16(ssqp, row, fq);
                f32x4 o[2];
#pragma unroll
                for (int n = 0; n < 2; ++n)
#pragma unroll
                    for (int e = 0; e < 4; ++e) { const float g = acc[ai][0][m][n][e] * r, up = acc[ai][1][m][n][e] * r;
                        o[n][e] = g * up * __builtin_amdgcn_rcpf(1.0f + __builtin_amdgcn_exp2f(g * -1.4426950408889634f)); }
                *(u32x4*)(ACT + (size_t)row * 2816 + ch) = pack8(o[0], o[1]); }
    }
};
struct EpiKvq {
    static constexpr bool PERM = true, AFTER_DRAIN = false;
    bf16_t* KVB; bf16_t* QB; float* GT; const float* ssqp;
    float *cmp_p, *cmp_s, *slc_p, *slc_s, *win_p, *win_s;
    __device__ __forceinline__ void operator()(const f32x4 (&acc)[2][2][4][2], const Unit& u, int wr, int wc, int fr, int fq) const {
        const int row0 = u.pm * BM + wr * 64 + fr, cw = wc * 32 + 8 * fq;
#pragma unroll
        for (int ai = 0; ai < 2; ++ai)
#pragma unroll
            for (int m = 0; m < 4; ++m) { const int row = row0 + ai * HALF + m * 16; const float r = row_rstd16(ssqp, row, fq);
                if (u.pn < 6) {
                    const int br = u.pn >> 1; float* orow = nullptr;
                    if (row < E_MP) { if (br == 0) orow = cmp_p + (size_t)row * 512; else if (br == 1) orow = slc_p + (size_t)row * 512;
                        else { const int t = row & 8191; if (t >= 7680) orow = win_p + ((size_t)(row >> 13) * 512 + (t - 7680)) * 512; } }
                    else { const int rs = row - E_MP; if (br == 0) orow = cmp_s + (size_t)rs * 512; else if (br == 1) orow = slc_s + (size_t)rs * 512;
                        else orow = win_s + ((size_t)(rs >> 3) * 512 + 504 + (rs & 7)) * 512; }
#pragma unroll
                    for (int bj = 0; bj < 2; ++bj) { const int col = u.pn * BM + bj * HALF + cw; const f32x4 a = acc[ai][bj][m][0] * r, b = acc[ai][bj][m][1] * r;
                        *(u32x4*)(KVB + (size_t)row * 1536 + col) = pack8(a, b);
                        if (orow) { *(f32x4*)(orow + (col & 511)) = a; *(f32x4*)(orow + (col & 511) + 4) = b; } }
                } else if (u.pn < 10) {
#pragma unroll
                    for (int bj = 0; bj < 2; ++bj) { const int col = (u.pn - 6) * BM + bj * HALF + cw;
                        *(u32x4*)(QB + (size_t)row * 1024 + col) = pack8(acc[ai][0 + bj][m][0] * r, acc[ai][0 + bj][m][1] * r); }
                } else {
                    if (cw < 48) {
                        f32x4 s0, s1;
#pragma unroll
                        for (int e = 0; e < 4; ++e) { s0[e] = __builtin_amdgcn_rcpf(1.0f + __builtin_amdgcn_exp2f(acc[ai][0][m][0][e] * r * -1.4426950408889634f));
                                                      s1[e] = __builtin_amdgcn_rcpf(1.0f + __builtin_amdgcn_exp2f(acc[ai][0][m][1][e] * r * -1.4426950408889634f)); }
                        *(f32x4*)(GT + (size_t)row * 48 + cw) = s0; *(f32x4*)(GT + (size_t)row * 48 + cw + 4) = s1; }
                }
            }
    }
};

struct SubOrder {
    int pm0, nM, nwg, Gs, cl;
    __host__ __device__ void init(int pm0_, int nM_, int nN_, int Gs_, int cl_) { pm0 = pm0_; nM = nM_; nwg = nM_ * nN_; Gs = Gs_; cl = cl_; }
    __host__ __device__ bool next(int i, Unit& u) const { if (cl < 0 || cl >= Gs) return false; const int L = i * Gs + cl; if (L >= nwg) return false; u.pm = pm0 + L % nM; u.pn = L / nM; return true; }
    __device__ __forceinline__ void a_ready(const Unit&) const {}
    __device__ __forceinline__ void done(const Unit&) const {}
};
template <class Epi, class Sched, bool ALIGN_EPI = false, bool SP2 = false>
__device__ __forceinline__ void gemm_phase(PG8_LAS unsigned char* lds, const Gemm g, const Sched& S, const Epi& E) {
    const int tid = threadIdx.x, wid = __builtin_amdgcn_readfirstlane(tid >> 6), lane = tid & 63, wr = wid >> 2, wc = wid & 3, fr = lane & 15, fq = lane >> 4;
    const int K = g.K, nt = K / BK;
    unsigned voffA[2], voffB[2];
#pragma unroll
    for (int i = 0; i < 2; ++i) { int R, C; stage_rc(tid * 16 + i * 8192, R, C); const int Rb = Epi::PERM ? ((R & ~31) + perm32(R & 31)) : R;
        voffA[i] = (unsigned)(R * K + C) * 2u; voffB[i] = (unsigned)(Rb * K + C) * 2u; }
    const size_t kstep = (size_t)(BK * 2);
    const size_t hstep = (size_t)HALF * K * 2;
    const size_t tstep = 2 * hstep;
    const unsigned ldsw = (unsigned)wid * 1024u;
    const int aoff = lds_byte(wr * 64 + fr, fq * 8), boff = lds_byte(wc * 32 + fr, fq * 8);
#define PG8_SA(b, h) (((b) * 2 + (h)) * HTB)
#define PG8_SB(b, h) ((4 + (b) * 2 + (h)) * HTB)
#define PG8_STAGE(bufoff, gbase, voff) do { _Pragma("unroll") for (int _i = 0; _i < 2; ++_i) \
        __builtin_amdgcn_global_load_lds((const unsigned*)((const char*)(gbase) + (voff)[_i]), (PG8_LAS unsigned*)(lds + (bufoff) + ldsw + _i * 8192), 16, 0, 0); } while (0)
#define PG8_LDA(dst, b, h) do { _Pragma("unroll") for (int m = 0; m < 4; ++m) _Pragma("unroll") for (int k = 0; k < 2; ++k) dst[m][k] = *(const PG8_LAS bf16x8*)(lds + PG8_SA(b, h) + aoff + m * 2048 + k * 1024); } while (0)
#define PG8_LDB(dst, b, h) do { _Pragma("unroll") for (int n = 0; n < 2; ++n) _Pragma("unroll") for (int k = 0; k < 2; ++k) dst[n][k] = *(const PG8_LAS bf16x8*)(lds + PG8_SB(b, h) + boff + n * 2048 + k * 1024); } while (0)
#define PG8_MMA(ai, bj, At, Bt) do { __builtin_amdgcn_s_setprio(1); _Pragma("unroll") for (int m = 0; m < 4; ++m) _Pragma("unroll") for (int n = 0; n < 2; ++n) _Pragma("unroll") for (int k = 0; k < 2; ++k) \
        acc[ai][bj][m][n] = __builtin_amdgcn_mfma_f32_16x16x32_bf16(Bt[n][k], At[m][k], acc[ai][bj][m][n], 0, 0, 0); __builtin_amdgcn_s_setprio(0); } while (0)
#define PG8_WAIT_V(n) asm volatile("s_waitcnt vmcnt(" #n ")" ::: "memory")
#define PG8_WAIT_L(n) asm volatile("s_waitcnt lgkmcnt(" #n ")" ::: "memory")
#define PG8_BAR __builtin_amdgcn_s_barrier()
#define PG8_SCHED __builtin_amdgcn_sched_barrier(0)
    Unit cur, nxt; int ui = 0;
    if (!S.next(0, cur)) return;
    f32x4 acc[2][2][4][2];
#pragma unroll
    for (int a = 0; a < 2; ++a)
#pragma unroll
        for (int b = 0; b < 2; ++b)
#pragma unroll
            for (int m = 0; m < 4; ++m)
#pragma unroll
                for (int n = 0; n < 2; ++n) acc[a][b][m][n] = (f32x4){0.f, 0.f, 0.f, 0.f};
    bf16x8 At[4][2], B0[2][2], B1[2][2];
    const char* cA = (const char*)g.A + (size_t)cur.pm * tstep; const char* cB = (const char*)g.Bt + (size_t)cur.pn * tstep;
    S.a_ready(cur);
    if constexpr (SP2) {
        PG8_STAGE(PG8_SB(0, 0), cB, voffB); PG8_STAGE(PG8_SB(0, 1), cB + hstep, voffB); PG8_STAGE(PG8_SA(0, 0), cA, voffA); PG8_STAGE(PG8_SA(0, 1), cA + hstep, voffA);
        if (wr == 1) PG8_BAR;
        PG8_WAIT_V(2); PG8_BAR;
        PG8_STAGE(PG8_SB(1, 0), cB + kstep, voffB); PG8_STAGE(PG8_SA(1, 0), cA + kstep, voffA); PG8_STAGE(PG8_SB(1, 1), cB + hstep + kstep, voffB);
        PG8_WAIT_V(6); PG8_BAR;
    } else {
        PG8_STAGE(PG8_SB(0, 0), cB, voffB); PG8_STAGE(PG8_SA(0, 0), cA, voffA); PG8_STAGE(PG8_SB(0, 1), cB + hstep, voffB); PG8_STAGE(PG8_SA(0, 1), cA + hstep, voffA);
        if (wr == 1) PG8_BAR;
        PG8_WAIT_V(4); PG8_BAR;
        PG8_STAGE(PG8_SB(1, 0), cB + kstep, voffB); PG8_STAGE(PG8_SA(1, 0), cA + kstep, voffA); PG8_STAGE(PG8_SB(1, 1), cB + hstep + kstep, voffB);
        PG8_WAIT_V(6); PG8_BAR;
    }
    for (;;) {
        const bool has_next = S.next(ui + 1, nxt);
        const char* nA = has_next ? (const char*)g.A + (size_t)nxt.pm * tstep : cA; const char* nB = has_next ? (const char*)g.Bt + (size_t)nxt.pn * tstep : cB;
        for (int t = 0; t < nt; t += 2) {
            const bool last = (t == nt - 2);
            const char* a1 = cA + (size_t)(t + 1) * kstep;
            const char* a2 = last ? nA : cA + (size_t)(t + 2) * kstep; const char* b2 = last ? nB : cB + (size_t)(t + 2) * kstep;
            const char* a3 = a2 + kstep; const char* b3 = b2 + kstep;
            if (last && has_next) S.a_ready(nxt);
            if constexpr (SP2) {
            PG8_LDB(B0, 0, 0); PG8_LDB(B1, 0, 1); PG8_SCHED; PG8_LDA(At, 0, 0); PG8_STAGE(PG8_SA(1, 1), a1 + hstep, voffA);
            PG8_WAIT_V(8); PG8_WAIT_L(0); PG8_BAR; PG8_MMA(0, 0, At, B0); PG8_MMA(0, 1, At, B1); PG8_BAR; PG8_SCHED;
            PG8_LDA(At, 0, 1); PG8_STAGE(PG8_SB(0, 0), b2, voffB); PG8_STAGE(PG8_SB(0, 1), b2 + hstep, voffB); PG8_STAGE(PG8_SA(0, 0), a2, voffA);
            PG8_WAIT_V(8); PG8_WAIT_L(0); PG8_BAR; PG8_MMA(1, 0, At, B0); PG8_MMA(1, 1, At, B1); PG8_BAR; PG8_SCHED;
            PG8_LDB(B0, 1, 0); PG8_LDB(B1, 1, 1); PG8_SCHED; PG8_LDA(At, 1, 0); PG8_STAGE(PG8_SA(0, 1), a2 + hstep, voffA);
            PG8_WAIT_V(8); PG8_WAIT_L(0); PG8_BAR; PG8_MMA(0, 0, At, B0); PG8_MMA(0, 1, At, B1); PG8_BAR; PG8_SCHED;
            PG8_LDA(At, 1, 1); PG8_STAGE(PG8_SB(1, 0), b3, voffB); PG8_STAGE(PG8_SB(1, 1), b3 + hstep, voffB); PG8_STAGE(PG8_SA(1, 0), a3, voffA);
            PG8_WAIT_V(8); PG8_WAIT_L(0); PG8_BAR; PG8_MMA(1, 0, At, B0); PG8_MMA(1, 1, At, B1); PG8_BAR; PG8_SCHED;
            } else {
            PG8_LDB(B0, 0, 0); PG8_SCHED; PG8_LDA(At, 0, 0); PG8_STAGE(PG8_SA(1, 1), a1 + hstep, voffA);
            PG8_WAIT_L(8); PG8_BAR; PG8_WAIT_L(0); PG8_MMA(0, 0, At, B0); PG8_BAR; PG8_SCHED;
            PG8_LDB(B1, 0, 1); PG8_STAGE(PG8_SB(0, 0), b2, voffB);
            PG8_BAR; PG8_WAIT_L(0); PG8_MMA(0, 1, At, B1); PG8_BAR;
            PG8_LDA(At, 0, 1); PG8_STAGE(PG8_SA(0, 0), a2, voffA);
            PG8_BAR; PG8_WAIT_L(0); PG8_MMA(1, 0, At, B0); PG8_BAR; PG8_SCHED;
            PG8_STAGE(PG8_SB(0, 1), b2 + hstep, voffB);
            PG8_WAIT_V(6); PG8_BAR; PG8_MMA(1, 1, At, B1); PG8_BAR;
            PG8_LDB(B0, 1, 0); PG8_SCHED; PG8_LDA(At, 1, 0); PG8_STAGE(PG8_SA(0, 1), a2 + hstep, voffA);
            PG8_WAIT_L(8); PG8_BAR; PG8_WAIT_L(0); PG8_MMA(0, 0, At, B0); PG8_BAR; PG8_SCHED;
            PG8_LDB(B1, 1, 1); PG8_STAGE(PG8_SB(1, 0), b3, voffB);
            PG8_BAR; PG8_WAIT_L(0); PG8_MMA(0, 1, At, B1); PG8_BAR;
            PG8_LDA(At, 1, 1); PG8_STAGE(PG8_SA(1, 0), a3, voffA);
            PG8_BAR; PG8_WAIT_L(0); PG8_MMA(1, 0, At, B0); PG8_BAR; PG8_SCHED;
            PG8_STAGE(PG8_SB(1, 1), b3 + hstep, voffB);
            PG8_WAIT_V(6); PG8_BAR; PG8_MMA(1, 1, At, B1); PG8_BAR;
            }
        }
        if constexpr (ALIGN_EPI) { if (wr == 0) PG8_BAR; }
        if constexpr (!Epi::AFTER_DRAIN) { E(acc, cur, wr, wc, fr, fq); S.done(cur); }
        if (!has_next) break;
#pragma unroll
        for (int a = 0; a < 2; ++a)
#pragma unroll
            for (int b = 0; b < 2; ++b)
#pragma unroll
                for (int m = 0; m < 4; ++m)
#pragma unroll
                    for (int n = 0; n < 2; ++n) acc[a][b][m][n] = (f32x4){0.f, 0.f, 0.f, 0.f};
        cur = nxt; cA = nA; cB = nB; ++ui;
        if constexpr (ALIGN_EPI) { if (wr == 1) PG8_BAR; }
    }
    PG8_WAIT_V(0);
    if constexpr (!ALIGN_EPI) { if (wr == 0) PG8_BAR; }
    PG8_BAR;
    if constexpr (Epi::AFTER_DRAIN) { E.fused(acc, cur, wr, wc, fr, fq, lds, wid, lane); S.done(cur); }
#undef PG8_SA
#undef PG8_SB
#undef PG8_STAGE
#undef PG8_LDA
#undef PG8_LDB
#undef PG8_MMA
#undef PG8_WAIT_V
#undef PG8_WAIT_L
#undef PG8_BAR
#undef PG8_SCHED
}
}
#ifndef PG8_SP2
#define PG8_SP2 true
#endif
#ifndef PG8_ALIGN
#define PG8_ALIGN true
#endif
constexpr int NWAVES = 8;
constexpr int DM = 1024, TP = 8192, NBP = 2, MP = NBP * TP, NBS = 128, TS = 8, MS = NBS * TS, MT = MP + MS;
constexpr int DFF = 2816, NFF = 2 * DFF, NAIN = 3 * DM, NKVQ = 2816, NKV = 1536, PAST = 2048, NPAGE = 16, PAGE = 128;
constexpr int NCP = 511, NCS = 127;
constexpr float RMS_EPS = 1e-6f;
constexpr float QSCALE = 0.125f * 1.4426950408889634f;
constexpr size_t O_YP = 0, O_YS = O_YP + (size_t)MP * DM, O_CONVP = O_YS + (size_t)MS * DM, O_CONVS = O_CONVP + 2 * 2 * DM, O_CMPP = O_CONVS + (size_t)NBS * 2 * DM,
                 O_CMPS = O_CMPP + (size_t)MP * 512, O_SLCP = O_CMPS + (size_t)MS * 512, O_SLCS = O_SLCP + (size_t)MP * 512, O_WINP = O_SLCS + (size_t)MS * 512,
                 O_WINS = O_WINP + (size_t)NBP * 512 * 512, O_END = O_WINS + (size_t)NBS * 512 * 512;
static_assert(O_END == 69996544, "output size");
constexpr size_t MiB = 1u << 20;
constexpr size_t WS_CTL = 0, CTL_ZERO_BYTES = 1 * MiB;
constexpr size_t WS_WAIN = 2 * MiB, WS_WAOUT = 8 * MiB, WS_WFIN0 = 10 * MiB, WS_WFIN1 = 21 * MiB, WS_WFOUT0 = 32 * MiB, WS_WFOUT1 = 38 * MiB, WS_WKVQ = 44 * MiB, WS_WBOUT = 50 * MiB,
                 WS_W1T = 52 * MiB, WS_W2T = 53 * MiB, WS_PEB = 53 * MiB + 65536, WS_RSTD0 = 54 * MiB, WS_SSQ = 55 * MiB  , WS_GT = 60 * MiB  ,
                 WS_KCP = 64 * MiB  , WS_KCS = 65 * MiB  , WS_SELS = 82 * MiB,
                 WS_XB = 96 * MiB, WS_BB = 132 * MiB, WS_VB = 168 * MiB, WS_Z = 204 * MiB, WS_H = 240 * MiB, WS_HB = 312 * MiB, WS_ACT = 348 * MiB, WS_KVB = 444 * MiB, WS_QB = 496 * MiB, WS_O = 532 * MiB, WS_OTG = 568 * MiB  , WS_END = 600 * MiB;
static_assert(WS_XB + (size_t)MT * DM * 2 <= WS_BB && WS_H + (size_t)MT * DM * 4 <= WS_HB && WS_ACT + (size_t)MT * DFF * 2 <= WS_KVB && WS_KVB + (size_t)MT * NKV * 2 <= WS_QB && WS_O + (size_t)MT * DM * 2 <= WS_OTG, "ws map");
static_assert(WS_SSQ + 4 * (size_t)MT * 16 * 4 <= WS_GT && WS_GT + (size_t)MT * 48 * 4 <= WS_KCP && WS_KCS + (size_t)NBS * 128 * 512 * 2 <= WS_SELS, "ws map 2");
constexpr int CW_TMO = 0, CW_CODE = 1, CW_Q8 = 64, CW_BAR = 4096;
constexpr int RING_OFF = 0, RING_BYTES = 155648, LDSCTL_OFF = RING_BYTES, MISC_OFF = LDSCTL_OFF + 320, LDS_BYTES = 159744;

#define GAS __attribute__((address_space(1)))
#define LAS __attribute__((address_space(3)))
typedef unsigned short bf16;
typedef unsigned v4u __attribute__((ext_vector_type(4)));
typedef unsigned v2u __attribute__((ext_vector_type(2)));
typedef float f32x4 __attribute__((ext_vector_type(4)));
typedef short bf16x8 __attribute__((ext_vector_type(8)));
typedef GAS unsigned gu32;
#define RLX_AGENT __ATOMIC_RELAXED, __HIP_MEMORY_SCOPE_AGENT
#define LDS_WAIT() asm volatile("s_waitcnt lgkmcnt(0)" ::: "memory")
#define VM_WAIT() asm volatile("s_waitcnt vmcnt(0)" ::: "memory")
__device__ __forceinline__ unsigned f2bf(float f) { unsigned u = __builtin_bit_cast(unsigned, f); return (u + 0x7fffu + ((u >> 16) & 1u)) >> 16; }
__device__ __forceinline__ unsigned pk2(float lo, float hi) { return f2bf(lo) | (f2bf(hi) << 16); }
__device__ __forceinline__ float bf2f(unsigned h) { return __builtin_bit_cast(float, h << 16); }
#define XB_TMO      128
#define XB_XCNT(j)  (256  + 64 * (j))
#define XB_XSUB(j)  (1280 + 64 * (j))
#define XB_XGEN(j)  (2304 + 64 * (j))
#define XB_TOP      3328
#define XB_TOPGEN   3392
#define XCD_BAR_WORDS 3456
#define XB_SPIN_CAP (1u << 18)

__device__ __forceinline__ unsigned xb_ld(unsigned* p)              { return __hip_atomic_load(p, __ATOMIC_RELAXED, __HIP_MEMORY_SCOPE_AGENT); }
__device__ __forceinline__ unsigned xb_add(unsigned* p, unsigned v) { return __hip_atomic_fetch_add(p, v, __ATOMIC_RELAXED, __HIP_MEMORY_SCOPE_AGENT); }
__device__ __forceinline__ unsigned xb_xcc_id() { return (unsigned)__builtin_amdgcn_s_getreg((3 << 11) | 20) & 0xFu; }
#define XB_SPIN(cond, bar) do { unsigned _sp = 0; while (cond) { __builtin_amdgcn_s_sleep(1); \
    if ((++_sp & 255u) == 0u) { if (xb_ld(&(bar)[XB_TMO])) break; if (_sp > XB_SPIN_CAP) { atomicAdd(&(bar)[XB_TMO], 1u); break; } } } } while (0)

struct XcdBarrier {
    unsigned* bar; unsigned x;
    volatile LAS unsigned* st;
};

__device__ __forceinline__ XcdBarrier xcd_barrier_post(unsigned* bar, volatile LAS unsigned* st) {
    XcdBarrier b; b.bar = bar; b.x = xb_xcc_id(); b.st = st;
    if (threadIdx.x == 0) (void)xb_add(&bar[XB_XCNT(b.x)], 1u);
    return b;
}
__device__ __forceinline__ void xcd_barrier_complete(unsigned* bar, unsigned x, unsigned& nloc, unsigned& nx) {
    const unsigned G = gridDim.x * gridDim.y * gridDim.z;
    unsigned sum, cnt, mine, sp = 0u;
    for (;;) {
        sum = 0u; cnt = 0u; mine = 0u;
#pragma unroll
        for (unsigned j = 0; j < 16; ++j) { const unsigned c = xb_ld(&bar[XB_XCNT(j)]); sum += c; cnt += (c > 0u) ? 1u : 0u; mine = (j == x) ? c : mine; }
        if (sum == G) break;
        __builtin_amdgcn_s_sleep(1);
        if ((++sp & 255u) == 0u) { if (xb_ld(&bar[XB_TMO])) break; if (sp > XB_SPIN_CAP) { atomicAdd(&bar[XB_TMO], 1u); break; } }
    }
    nloc = mine > 0u ? mine : 1u; nx = cnt > 0u ? cnt : 1u;
}

__device__ __forceinline__ void xcd_barrier(const XcdBarrier& b) {
    asm volatile("s_waitcnt vmcnt(0)" ::: "memory");
    __syncthreads();
    if (threadIdx.x == 0) {
        unsigned* bar = b.bar;
        __builtin_amdgcn_s_waitcnt(0);
        unsigned nloc = b.st[0], nx = b.st[1];
        if (nloc == 0u) { xcd_barrier_complete(bar, b.x, nloc, nx); b.st[0] = nloc; b.st[1] = nx; }
        const unsigned old = xb_add(&bar[XB_XSUB(b.x)], 1u);
        const unsigned gen = old / nloc;
        if (old + 1u == (gen + 1u) * nloc) {
            __builtin_amdgcn_fence(__ATOMIC_RELEASE, "agent");
            asm volatile("s_waitcnt vmcnt(0)" ::: "memory");
            const unsigned og = xb_add(&bar[XB_TOP], 1u);
            const unsigned tg = og / nx;
            if (og + 1u == (tg + 1u) * nx) xb_add(&bar[XB_TOPGEN], 1u);
            else XB_SPIN(xb_ld(&bar[XB_TOPGEN]) == tg, bar);
            __builtin_amdgcn_fence(__ATOMIC_ACQUIRE, "agent");
            xb_add(&bar[XB_XGEN(b.x)], 1u);
            asm volatile("s_waitcnt vmcnt(0)" ::: "memory");
        } else {
            XB_SPIN(xb_ld(&bar[XB_XGEN(b.x)]) == gen, bar);
            __builtin_amdgcn_fence(__ATOMIC_ACQUIRE, "agent");
            asm volatile("s_waitcnt vmcnt(0)" ::: "memory");
        }
    }
    __syncthreads();
}

struct Args { const float* in[21]; float* out; unsigned char* ws; int ph_lo, ph_hi; };
struct Frame {
    LAS unsigned char* lds; volatile LAS unsigned* MISC; gu32* ctl;
    int tid, lane, wave, vcu, G;
};
__device__ __forceinline__ float wave_sum(float v) {
#pragma unroll
    for (int o = 1; o < 64; o <<= 1) v += __shfl_xor(v, o);
    return v;
}
__device__ __forceinline__ void tr_item(const float* src, int ldsrc, int scol, int nvalid, const float* kscale, float cscale, bf16* dst, int K, int n0, int k0, LAS float* scr, int lane) {
#pragma unroll 8
    for (int i = 0; i < 32; ++i) { const int kk = 2 * i + (lane >> 5), c = lane & 31;
        float v = 0.f; if (c < nvalid) { v = src[(size_t)(k0 + kk) * ldsrc + scol + c] * cscale; if (kscale) v *= kscale[k0 + kk]; }
        scr[kk * 33 + c] = v; }
    LDS_WAIT(); asm volatile("" ::: "memory");
    const int c = lane & 7;
#pragma unroll
    for (int j = 0; j < 4; ++j) { const int n = (lane >> 3) + 8 * j; const LAS float* s = scr + (8 * c) * 33 + n;
        v4u o; o.x = pk2(s[0 * 33], s[1 * 33]); o.y = pk2(s[2 * 33], s[3 * 33]); o.z = pk2(s[4 * 33], s[5 * 33]); o.w = pk2(s[6 * 33], s[7 * 33]);
        *(GAS v4u*)(dst + (size_t)(n0 + n) * K + k0 + 8 * c) = o; }
    LDS_WAIT(); asm volatile("" ::: "memory");
}
enum { I_XP = 0, I_XS, I_CCMP, I_CSLC, I_SWIN, I_SCONV, I_PT, I_NORMW, I_FNORMW, I_AIN, I_ACONV, I_AOUT, I_BIN, I_BOUT, I_KVNORM, I_KVW, I_PE, I_W1, I_W2, I_FIN, I_FOUT };

__device__ __forceinline__ void p0_prologue(Frame& F, const Args& A) {
    unsigned char* ws = A.ws;
    LAS float* scr = (LAS float*)(F.lds + RING_OFF + F.wave * 16384);
    const int gw = F.vcu * NWAVES + F.wave, NGW = F.G * NWAVES;
    const float* normw = A.in[I_NORMW];
    constexpr int IT_AIN = (NAIN / 32) * (DM / 64), IT_SQ = (DM / 32) * (DM / 64), IT_FIN = (NFF / 32) * (DM / 64), IT_FOUT = (DM / 32) * (DFF / 64), IT_KVQ = (NKVQ / 32) * (DM / 64),
                  IT_W1 = 2 * (64 / 32) * (2048 / 64), IT_W2 = 2 * 2;
    constexpr int NITEMS = IT_AIN + 2 * IT_SQ + 2 * IT_FIN + 2 * IT_FOUT + IT_KVQ + IT_W1 + IT_W2;
    for (int it = gw; it < NITEMS; it += NGW) {
        int r = it;
        if (r < IT_AIN) { const int ng = r / 16, kb = r % 16, n0 = ng * 32, pn = n0 >> 8, w = n0 & 255;
            const int scol = pn < 8 ? (w < 128 ? 1024 + pn * 128 + w : 2048 + pn * 128 + (w - 128)) : (pn - 8) * 256 + w;
            tr_item(A.in[I_AIN], NAIN, scol, 32, normw, 1.f, (bf16*)(ws + WS_WAIN), DM, n0, kb * 64, scr, F.lane); continue; } r -= IT_AIN;
        if (r < IT_SQ) { const int ng = r / 16, kb = r % 16; tr_item(A.in[I_AOUT], DM, ng * 32, 32, nullptr, 1.f, (bf16*)(ws + WS_WAOUT), DM, ng * 32, kb * 64, scr, F.lane); continue; } r -= IT_SQ;
        if (r < IT_SQ) { const int ng = r / 16, kb = r % 16; tr_item(A.in[I_BOUT], DM, ng * 32, 32, nullptr, 1.f, (bf16*)(ws + WS_WBOUT), DM, ng * 32, kb * 64, scr, F.lane); continue; } r -= IT_SQ;
        if (r < 2 * IT_FIN) { const int l = r / IT_FIN, q = r % IT_FIN, ng = q / 16, kb = q % 16, n0 = ng * 32, pn = n0 >> 8, w = n0 & 255;
            const int scol = w < 128 ? pn * 128 + w : DFF + pn * 128 + (w - 128);
            tr_item(A.in[I_FIN] + (size_t)l * DM * NFF, NFF, scol, 32, normw + (l * 2 + 1) * DM, 1.f, (bf16*)(ws + (l ? WS_WFIN1 : WS_WFIN0)), DM, n0, kb * 64, scr, F.lane); continue; } r -= 2 * IT_FIN;
        if (r < 2 * IT_FOUT) { const int l = r / IT_FOUT, q = r % IT_FOUT, ng = q / 44, kb = q % 44;
            tr_item(A.in[I_FOUT] + (size_t)l * DFF * DM, DM, ng * 32, 32, nullptr, 1.f, (bf16*)(ws + (l ? WS_WFOUT1 : WS_WFOUT0)), DFF, ng * 32, kb * 64, scr, F.lane); continue; } r -= 2 * IT_FOUT;
        if (r < IT_KVQ) { const int ng = r / 16, kb = r % 16, n0 = ng * 32; bf16* dst = (bf16*)(ws + WS_WKVQ);
            if (n0 < NKV) tr_item(A.in[I_KVW], NKV, n0, 32, A.in[I_KVNORM], 1.f, dst, DM, n0, kb * 64, scr, F.lane);
            else if (n0 < NKV + 1024) tr_item(A.in[I_BIN], 1072, n0 - NKV, 32, normw + 2 * DM, QSCALE, dst, DM, n0, kb * 64, scr, F.lane);
            else { const int g0 = n0 - (NKV + 1024); const int nv = g0 >= 48 ? 0 : (48 - g0 < 32 ? 48 - g0 : 32);
                tr_item(A.in[I_BIN], 1072, 1024 + (nv ? g0 : 0), nv, normw + 2 * DM, 1.f, dst, DM, n0, kb * 64, scr, F.lane); }
            continue; } r -= IT_KVQ;
        if (r < IT_W1) { const int k = r / 64, q = r % 64, ng = q / 32, kb = q % 32;
            tr_item(A.in[I_W1] + (size_t)k * 2048 * 64, 64, ng * 32, 32, nullptr, 1.f, (bf16*)(ws + WS_W1T) + (size_t)k * 64 * 2048, 2048, ng * 32, kb * 64, scr, F.lane); continue; } r -= IT_W1;
        { const int k = r / 2, ng = r % 2;
            tr_item(A.in[I_W2] + (size_t)k * 64 * 64, 64, ng * 32, 32, nullptr, 1.f, (bf16*)(ws + WS_W2T) + (size_t)k * 64 * 64, 64, ng * 32, 0, scr, F.lane); }
    }
    for (int o = gw; o < 128; o += NGW) { const int k = o >> 6, h = o & 63; const float* pe = A.in[I_PE] + (size_t)k * 2048; const float* w1 = A.in[I_W1] + (size_t)k * 2048 * 64 + h;
        float s = 0.f; for (int i = F.lane; i < 2048; i += 64) s += pe[i] * w1[(size_t)i * 64];
        s = wave_sum(s); if (F.lane == 0) ((float*)(ws + WS_PEB))[o] = s; }
    for (int m = gw; m < MT; m += NGW) {
        const float* xrow = m < MP ? A.in[I_XP] + (size_t)m * DM : A.in[I_XS] + (size_t)(m - MP) * DM;
        const GAS f32x4* xr = (const GAS f32x4*)xrow + F.lane; f32x4 v[4]; float s = 0.f;
#pragma unroll
        for (int j = 0; j < 4; ++j) { v[j] = xr[64 * j]; s += (v[j].x * v[j].x + v[j].y * v[j].y) + (v[j].z * v[j].z + v[j].w * v[j].w); }
        s = wave_sum(s);
        GAS v2u* o8 = (GAS v2u*)((bf16*)(ws + WS_XB) + (size_t)m * DM) + F.lane;
#pragma unroll
        for (int j = 0; j < 4; ++j) { v2u w; w.x = pk2(v[j].x, v[j].y); w.y = pk2(v[j].z, v[j].w); o8[64 * j] = w; }
        if (F.lane == 0) ((float*)(ws + WS_RSTD0))[m] = __builtin_amdgcn_rsqf(s * (1.0f / DM) + RMS_EPS);
    }
}
__device__ __forceinline__ void p_wincopy(Frame& F, const Args& A, int cu_lo, int cu_cnt) {
    const int cu = (int)blockIdx.x - cu_lo; if (cu < 0 || cu >= cu_cnt) return;
    const GAS f32x4* src = (const GAS f32x4*)A.in[I_SWIN]; GAS f32x4* dst = (GAS f32x4*)(A.out + O_WINS);
    const size_t per = (size_t)504 * 128, total = (size_t)NBS * per; const size_t gt = (size_t)cu * 512 + F.tid, GT_ = (size_t)cu_cnt * 512;
    for (size_t i = gt; i < total; i += 4 * GT_) { f32x4 v[4];
#pragma unroll
        for (int j = 0; j < 4; ++j) { const size_t ii = i + j * GT_; if (ii < total) { const size_t n = ii / per, rem = ii % per; v[j] = __builtin_nontemporal_load(src + n * (512 * 128) + 8 * 128 + rem); } }
#pragma unroll
        for (int j = 0; j < 4; ++j) { const size_t ii = i + j * GT_; if (ii < total) { const size_t n = ii / per, rem = ii % per; __builtin_nontemporal_store(v[j], dst + n * (512 * 128) + rem); } } }
}
__device__ __forceinline__ void p2_conv(Frame& F, const Args& A, int row_lo, int row_hi, int cu_lo, int cu_cnt) {
    unsigned char* ws = A.ws; const bf16* VB = (const bf16*)(ws + WS_VB); const bf16* BB = (const bf16*)(ws + WS_BB); bf16* Z = (bf16*)(ws + WS_Z);
    const float* cw = A.in[I_ACONV]; const float* sc = A.in[I_SCONV];
    const int cu = (int)blockIdx.x - cu_lo; if (cu < 0 || cu >= cu_cnt) return;
    const size_t gt = (size_t)cu * 512 + F.tid, GT_ = (size_t)cu_cnt * 512, total = (size_t)(row_hi - row_lo) * 128;
    for (size_t i = gt; i < total; i += GT_) {
        const int row = row_lo + (int)(i >> 7), c8 = (int)(i & 127) * 8; int t, tlen; const float* pre = nullptr;
        if (row < MP) { t = row & (TP - 1); tlen = TP; } else { const int rs = row - MP; t = rs & 7; tlen = TS; pre = sc + (size_t)(rs >> 3) * 2 * DM; }
        const v4u vb = *(const GAS v4u*)(BB + (size_t)row * DM + c8), v2 = *(const GAS v4u*)(VB + (size_t)row * DM + c8);
        float f1[8], f0[8];
        if (t >= 1) { const v4u q = *(const GAS v4u*)(VB + (size_t)(row - 1) * DM + c8);
#pragma unroll
            for (int e = 0; e < 4; ++e) { f1[2 * e] = bf2f(q[e] & 0xffffu); f1[2 * e + 1] = bf2f(q[e] >> 16); } }
        else {
#pragma unroll
            for (int e = 0; e < 8; ++e) f1[e] = pre ? pre[DM + c8 + e] : 0.f; }
        if (t >= 2) { const v4u q = *(const GAS v4u*)(VB + (size_t)(row - 2) * DM + c8);
#pragma unroll
            for (int e = 0; e < 4; ++e) { f0[2 * e] = bf2f(q[e] & 0xffffu); f0[2 * e + 1] = bf2f(q[e] >> 16); } }
        else {
#pragma unroll
            for (int e = 0; e < 8; ++e) f0[e] = pre ? pre[(size_t)t * DM + c8 + e] : 0.f; }
        float z[8], vv[8];
#pragma unroll
        for (int e = 0; e < 4; ++e) { vv[2 * e] = bf2f(v2[e] & 0xffffu); vv[2 * e + 1] = bf2f(v2[e] >> 16); }
#pragma unroll
        for (int e = 0; e < 8; ++e) { const float b = bf2f((vb[e >> 1] >> ((e & 1) * 16)) & 0xffffu);
            z[e] = b * (cw[c8 + e] * f0[e] + cw[DM + c8 + e] * f1[e] + cw[2 * DM + c8 + e] * vv[e]); }
        v4u o; o.x = pk2(z[0], z[1]); o.y = pk2(z[2], z[3]); o.z = pk2(z[4], z[5]); o.w = pk2(z[6], z[7]);
        *(GAS v4u*)(Z + (size_t)row * DM + c8) = o;
        if (t >= tlen - 2) { float* dst = row < MP ? A.out + O_CONVP + ((size_t)(row >> 13) * 2 + (t - (tlen - 2))) * DM + c8
                                                  : A.out + O_CONVS + ((size_t)((row - MP) >> 3) * 2 + (t - (tlen - 2))) * DM + c8;
#pragma unroll
            for (int e = 0; e < 8; ++e) dst[e] = vv[e]; }
    }
}
__device__ __forceinline__ void p_final(Frame& F, const Args& A, int row_lo, int row_hi, int cu_lo, int cu_cnt) {
    const bf16* HB = (const bf16*)(A.ws + WS_HB); const GAS f32x4* fw = (const GAS f32x4*)A.in[I_FNORMW];
    const int cu = (int)blockIdx.x - cu_lo; if (cu < 0 || cu >= cu_cnt) return;
    const int gw = cu * NWAVES + F.wave, NGW = cu_cnt * NWAVES;
    f32x4 w[4];
#pragma unroll
    for (int j = 0; j < 4; ++j) w[j] = fw[4 * F.lane + j];
    for (int m = row_lo + gw; m < row_hi; m += NGW) {
        const GAS v4u* xr = (const GAS v4u*)(HB + (size_t)m * DM) + 2 * F.lane; const v4u a = xr[0], b = xr[1]; f32x4 v[4]; float s = 0.f;
        v[0] = (f32x4){bf2f(a.x & 0xffffu), bf2f(a.x >> 16), bf2f(a.y & 0xffffu), bf2f(a.y >> 16)}; v[1] = (f32x4){bf2f(a.z & 0xffffu), bf2f(a.z >> 16), bf2f(a.w & 0xffffu), bf2f(a.w >> 16)};
        v[2] = (f32x4){bf2f(b.x & 0xffffu), bf2f(b.x >> 16), bf2f(b.y & 0xffffu), bf2f(b.y >> 16)}; v[3] = (f32x4){bf2f(b.z & 0xffffu), bf2f(b.z >> 16), bf2f(b.w & 0xffffu), bf2f(b.w >> 16)};
#pragma unroll
        for (int j = 0; j < 4; ++j) s += (v[j].x * v[j].x + v[j].y * v[j].y) + (v[j].z * v[j].z + v[j].w * v[j].w);
        const float r = __builtin_amdgcn_rsqf(wave_sum(s) * (1.0f / DM) + RMS_EPS);
        GAS f32x4* o = (GAS f32x4*)(A.out + (m < MP ? O_YP + (size_t)m * DM : O_YS + (size_t)(m - MP) * DM)) + 4 * F.lane;
#pragma unroll
        for (int j = 0; j < 4; ++j) o[j] = v[j] * r * w[j];
    }
}
__device__ __forceinline__ void p_zero16(Frame& F, void* p, size_t bytes) {
    GAS v4u* d = (GAS v4u*)p; const size_t n = bytes / 16, gt = (size_t)F.vcu * 512 + F.tid, GT_ = (size_t)F.G * 512;
    for (size_t i = gt; i < n; i += GT_) d[i] = (v4u){0u, 0u, 0u, 0u};
}
constexpr int P7_IMG_BYTES = 144 * 512, P7_HID = 2 * P7_IMG_BYTES, P7_HID_STRIDE = 144;
static_assert(P7_HID + 32 * P7_HID_STRIDE <= RING_BYTES, "compress LDS");
__device__ __forceinline__ int p7_swz(int pos_l, int g, int dchunk) { return pos_l * 512 + g * 128 + ((dchunk ^ ((pos_l >> 4) & 3) ^ ((g >> 1) << 2)) << 4); }
struct P7Unit { int isp, seq, seg; };
__device__ __forceinline__ bool p7_unit(int i, int cu2, int ncu2, P7Unit& U) {
    if (i == 0) { if (cu2 >= NBP * 64) return false; U.isp = 1; U.seq = cu2 >> 6; U.seg = cu2 & 63; return true; }
    const int v = (i - 1) * ncu2 + cu2; if (v >= NBS * NPAGE) return false; U.isp = 0; U.seq = v >> 4; U.seg = v & 15; return true;
}
struct P7Batch { f32x4 a[3], b[3]; };
template <int C0, int NCH> __device__ __forceinline__ void p7_load(P7Batch& R, const P7Unit& U, int k, const Args& A, int tid) {
    asm volatile("" : "+v"(tid));
    const int pos0 = U.seg * 128;
    if (U.isp) { const bf16* KVB = (const bf16*)(A.ws + WS_KVB);
#pragma unroll
        for (int i = 0; i < NCH; ++i) { const int c = tid + (C0 + i) * 512, pos_l = c >> 5, g = (c >> 3) & 3, dc = c & 7, pos = pos0 + pos_l; v4u r = (v4u){0u, 0u, 0u, 0u};
            if (pos < TP) r = *(const GAS v4u*)(KVB + ((size_t)U.seq * TP + pos) * NKV + k * 256 + g * 64 + dc * 8);
            R.a[i] = __builtin_bit_cast(f32x4, r); }
    } else { const int* ptab = (const int*)A.in[I_PT]; const float* cache = A.in[I_CCMP];
        const int pgA = ptab[U.seq * NPAGE + U.seg], pgB = U.seg < 15 ? ptab[U.seq * NPAGE + U.seg + 1] : 0;
#pragma unroll
        for (int i = 0; i < NCH; ++i) { const int c = tid + (C0 + i) * 512, pos_l = c >> 5, g = (c >> 3) & 3, dc = c & 7, pos = pos0 + pos_l;
            R.a[i] = (f32x4){0.f, 0.f, 0.f, 0.f}; R.b[i] = R.a[i];
            if (pos < PAST) { const float* s = cache + ((size_t)(pos_l < 128 ? pgA : pgB) * PAGE + (pos_l & 127)) * 512 + k * 256 + g * 64 + dc * 8; R.a[i] = *(const GAS f32x4*)s; R.b[i] = *(const GAS f32x4*)(s + 4); } }
    }
}
template <int C0, int NCH> __device__ __forceinline__ void p7_store(const P7Batch& R, const P7Unit& U, LAS unsigned char* img, int tid) {
    asm volatile("" : "+v"(tid));
#pragma unroll
    for (int i = 0; i < NCH; ++i) { const int c = tid + (C0 + i) * 512, pos_l = c >> 5, g = (c >> 3) & 3, dc = c & 7; v4u o;
        if (U.isp) o = __builtin_bit_cast(v4u, R.a[i]);
        else { o.x = pg8::cvt_pk_bf16(R.a[i][0], R.a[i][1]); o.y = pg8::cvt_pk_bf16(R.a[i][2], R.a[i][3]); o.z = pg8::cvt_pk_bf16(R.b[i][0], R.b[i][1]); o.w = pg8::cvt_pk_bf16(R.b[i][2], R.b[i][3]); }
        *(LAS v4u*)(img + p7_swz(pos_l, g, dc)) = o; }
}
__device__ __forceinline__ void p7_compress(Frame& F, const Args& A, int mode) {
    unsigned char* ws = A.ws; LAS unsigned char* L = F.lds + RING_OFF; LAS unsigned char* hidp = L + P7_HID;
    const bf16* W1T = (const bf16*)(ws + WS_W1T); const bf16* W2T = (const bf16*)(ws + WS_W2T); const float* PEB = (const float*)(ws + WS_PEB);
    const int lane = F.lane, w = F.wave, tid = F.tid, l15 = lane & 15, lq = lane >> 4;
    const int k = F.vcu & 1, cu2 = F.vcu >> 1, ncu2 = (F.G + 1 - k) >> 1;
    bf16x8 bw[8][4];
#pragma unroll
    for (int kl = 0; kl < 8; ++kl)
#pragma unroll
        for (int nt = 0; nt < 4; ++nt) bw[kl][nt] = *(const GAS bf16x8*)(W1T + ((size_t)(k * 64 + nt * 16 + l15)) * 2048 + (8 * w + kl) * 32 + lq * 8);
    P7Unit U, Un; P7Batch R;
    int ui = mode; bool have = p7_unit(ui, cu2, ncu2, U);
    if (have) { p7_load<0, 3>(R, U, k, A, tid); p7_store<0, 3>(R, U, L, tid); p7_load<3, 3>(R, U, k, A, tid); p7_store<3, 3>(R, U, L, tid); p7_load<6, 3>(R, U, k, A, tid); p7_store<6, 3>(R, U, L, tid); }
    __syncthreads();
    int buf = 0;
    while (have) {
        LAS unsigned char* img = L + buf * P7_IMG_BYTES; LAS unsigned char* nimg = L + (buf ^ 1) * P7_IMG_BYTES; LAS float* red = (LAS float*)img;
        const bool hn = mode == 1 && p7_unit(ui + 1, cu2, ncu2, Un);
        const int ntok = (U.isp ? U.seg == 63 : U.seg == 15) ? 7 : 8;
        f32x4 acc[2][4];
#pragma unroll
        for (int a = 0; a < 2; ++a)
#pragma unroll
            for (int b = 0; b < 4; ++b) acc[a][b] = (f32x4){0.f, 0.f, 0.f, 0.f};
        if (hn) p7_load<0, 3>(R, Un, k, A, tid);
#pragma unroll
        for (int kl = 0; kl < 8; ++kl) { const int ks = 8 * w + kl, j = ks >> 1, dh = ks & 1; bf16x8 afr[2];
            if (kl == 3 && hn) { p7_store<0, 3>(R, Un, nimg, tid); p7_load<3, 3>(R, Un, k, A, tid); }
            if (kl == 6 && hn) { p7_store<3, 3>(R, Un, nimg, tid); p7_load<6, 3>(R, Un, k, A, tid); }
#pragma unroll
            for (int mt = 0; mt < 2; ++mt) { const int tok = mt * 4 + (l15 >> 2), g = l15 & 3, pos_l = 16 * tok + j; afr[mt] = *(const LAS bf16x8*)(img + p7_swz(pos_l, g, dh * 4 + lq)); }
#pragma unroll
            for (int mt = 0; mt < 2; ++mt)
#pragma unroll
                for (int nt = 0; nt < 4; ++nt) acc[mt][nt] = __builtin_amdgcn_mfma_f32_16x16x32_bf16(afr[mt], bw[kl][nt], acc[mt][nt], 0, 0, 0);
        }
        if (hn) p7_store<6, 3>(R, Un, nimg, tid);
        __syncthreads();
#pragma unroll
        for (int mt = 0; mt < 2; ++mt)
#pragma unroll
            for (int nt = 0; nt < 4; ++nt)
#pragma unroll
                for (int rg = 0; rg < 4; ++rg) red[(w * 32 + mt * 16 + 4 * lq + rg) * 64 + nt * 16 + l15] = acc[mt][nt][rg];
        __syncthreads();
        { const int row = tid >> 4, col = (tid & 15) * 4; f32x4 s = *(const LAS f32x4*)(red + row * 64 + col);
#pragma unroll
            for (int ww = 1; ww < 8; ++ww) s += *(const LAS f32x4*)(red + (ww * 32 + row) * 64 + col);
            const f32x4 pb = *(const GAS f32x4*)(PEB + k * 64 + col); float h[4];
#pragma unroll
            for (int e = 0; e < 4; ++e) { const float x = s[e] + pb[e]; h[e] = x * __builtin_amdgcn_rcpf(1.0f + __builtin_amdgcn_exp2f(x * -1.4426950408889634f)); }
            v2u o; o.x = pg8::cvt_pk_bf16(h[0], h[1]); o.y = pg8::cvt_pk_bf16(h[2], h[3]); *(LAS v2u*)(hidp + row * P7_HID_STRIDE + col * 2) = o; }
        __syncthreads();
        { const int mt = w >> 2, nt = w & 3; f32x4 a2 = (f32x4){0.f, 0.f, 0.f, 0.f};
#pragma unroll
            for (int k2 = 0; k2 < 2; ++k2) { const bf16x8 af = *(const LAS bf16x8*)(hidp + (mt * 16 + l15) * P7_HID_STRIDE + k2 * 64 + lq * 16);
                const bf16x8 bf = *(const GAS bf16x8*)(W2T + ((size_t)(k * 64 + nt * 16 + l15)) * 64 + k2 * 32 + lq * 8);
                a2 = __builtin_amdgcn_mfma_f32_16x16x32_bf16(af, bf, a2, 0, 0, 0); }
            const int tok = mt * 4 + lq; bf16* kc = U.isp ? (bf16*)(ws + WS_KCP) + (((size_t)U.seq * 512 + U.seg * 8 + tok) * 2 + k) * 256 : (bf16*)(ws + WS_KCS) + (((size_t)U.seq * 128 + U.seg * 8 + tok) * 2 + k) * 256;
#pragma unroll
            for (int rg = 0; rg < 4; ++rg) kc[rg * 64 + nt * 16 + l15] = (bf16)(tok < ntok ? f2bf(a2[rg]) : 0u); }
        U = Un; have = hn; ++ui; buf ^= 1;
    }
    __syncthreads();
}

constexpr int KT_STRIDE = 144, VT_STRIDE = 160;
constexpr float S_NEG = -1.0e30f, M_INIT = -1000.0f, RESC_THR = 8.0f;
typedef short s16x4 __attribute__((ext_vector_type(4)));
struct AttState { float m[2], l[2]; f32x4 o[2][4]; };
__device__ __forceinline__ void att_init(AttState& st) {
#pragma unroll
    for (int c = 0; c < 2; ++c) { st.m[c] = M_INIT; st.l[c] = 0.f;
#pragma unroll
        for (int d = 0; d < 4; ++d) st.o[c][d] = (f32x4){0.f, 0.f, 0.f, 0.f}; }
}
__device__ __forceinline__ s16x4 tr_read(const LAS unsigned char* p) { return __builtin_bit_cast(s16x4, __builtin_amdgcn_ds_read_tr16_b64_v4i16((LAS s16x4*)p)); }
template <int NKT, int MODE>
__device__ __forceinline__ void wave_block(const LAS unsigned char* kt, const LAS unsigned char* vt, const bf16x8 (&qf)[2][2], AttState& st, const float (&bias)[2], const bool (&act)[2],
                                           bool boundary, const int (&lo)[2], const int (&hi)[2], int lane, LAS float* imp_row0, int imp_blk0, int imp_stride) {
    const int l15 = lane & 15, lq = lane >> 4;
    if (!act[0] && !act[1]) return;
    bf16x8 kf[NKT][2];
#pragma unroll
    for (int t = 0; t < NKT; ++t)
#pragma unroll
        for (int ks = 0; ks < 2; ++ks) kf[t][ks] = *(const LAS bf16x8*)(kt + (t * 16 + l15) * KT_STRIDE + ks * 64 + lq * 16);
    bf16x8 pfr[2][NKT / 2];
#pragma unroll
    for (int c = 0; c < 2; ++c) {
        if (!act[c]) continue;
        const float c0 = bias[c] - st.m[c];
        f32x4 s[NKT];
#pragma unroll
        for (int t = 0; t < NKT; ++t) { s[t] = (f32x4){c0, c0, c0, c0};
            s[t] = __builtin_amdgcn_mfma_f32_16x16x32_bf16(kf[t][0], qf[c][0], s[t], 0, 0, 0);
            s[t] = __builtin_amdgcn_mfma_f32_16x16x32_bf16(kf[t][1], qf[c][1], s[t], 0, 0, 0); }
        if (boundary) { const int l2 = lo[c] - 4 * lq, h2 = hi[c] - 4 * lq;
#pragma unroll
            for (int t = 0; t < NKT; ++t)
#pragma unroll
                for (int r = 0; r < 4; ++r) { const int kk = t * 16 + r; if (kk < l2 || kk > h2) s[t][r] = S_NEG; } }
        float mx = s[0][0];
#pragma unroll
        for (int t = 0; t < NKT; ++t)
#pragma unroll
            for (int r = 0; r < 4; ++r) mx = fmaxf(mx, s[t][r]);
        mx = fmaxf(mx, __shfl_xor(mx, 16)); mx = fmaxf(mx, __shfl_xor(mx, 32));
        if (MODE == 1) {
            const float dl = fmaxf(mx, 0.f), f = __builtin_amdgcn_exp2f(-dl); st.m[c] += dl; float a = 0.f;
#pragma unroll
            for (int t = 0; t < NKT; ++t)
#pragma unroll
                for (int r = 0; r < 4; ++r) a += __builtin_amdgcn_exp2f(s[t][r] - dl);
            st.l[c] = st.l[c] * f + a;
            continue;
        }
        if (MODE == 0) {
            if (__any(mx > RESC_THR)) {
                const float dl = fmaxf(mx, 0.f), f = __builtin_amdgcn_exp2f(-dl); st.m[c] += dl; st.l[c] *= f;
#pragma unroll
                for (int t = 0; t < NKT; ++t) s[t] = s[t] - dl;
#pragma unroll
                for (int r = 0; r < 4; ++r) { const float fr = __shfl(f, 4 * lq + r);
#pragma unroll
                    for (int dt = 0; dt < 4; ++dt) st.o[c][dt][r] *= fr; }
            }
        }
        float a = 0.f;
#pragma unroll
        for (int t = 0; t < NKT; ++t)
#pragma unroll
            for (int r = 0; r < 4; ++r) { s[t][r] = __builtin_amdgcn_exp2f(s[t][r]); a += s[t][r]; }
        if (MODE == 0) st.l[c] += a;
        if (MODE == 2) {
            const float li = st.l[c];
#pragma unroll
            for (int t = 0; t < NKT; ++t) { s[t] = s[t] * li;
                float ia = 2.f * (s[t][0] + s[t][1] + s[t][2]) + s[t][3], ib = s[t][3];
                ia += __shfl_xor(ia, 1); ia += __shfl_xor(ia, 2); ib += __shfl_xor(ib, 1); ib += __shfl_xor(ib, 2);
                if ((l15 & 3) == 0) { LAS float* ir = imp_row0 + (c * 4 + (l15 >> 2)) * imp_stride + imp_blk0 + 4 * t + lq; atomicAdd((float*)ir, ia); atomicAdd((float*)(ir + 1), ib); } }
        }
#pragma unroll
        for (int G = 0; G < NKT / 2; ++G) {
            v4u pw; pw.x = pg8::cvt_pk_bf16(s[2 * G][0], s[2 * G][1]); pw.y = pg8::cvt_pk_bf16(s[2 * G][2], s[2 * G][3]); pw.z = pg8::cvt_pk_bf16(s[2 * G + 1][0], s[2 * G + 1][1]); pw.w = pg8::cvt_pk_bf16(s[2 * G + 1][2], s[2 * G + 1][3]);
            pfr[c][G] = __builtin_bit_cast(bf16x8, pw); }
    }
    if (MODE == 1) return;
    asm volatile("" ::: "memory");
    const LAS unsigned char* vb = vt + (4 * lq + (l15 >> 2)) * VT_STRIDE + (l15 & 3) * 8;
#pragma unroll
    for (int G = 0; G < NKT / 2; ++G) {
        bf16x8 vf[4];
#pragma unroll
        for (int dt = 0; dt < 4; ++dt) { const s16x4 a = tr_read(vb + (32 * G) * VT_STRIDE + dt * 32), b = tr_read(vb + (32 * G + 16) * VT_STRIDE + dt * 32);
            vf[dt] = (bf16x8){a[0], a[1], a[2], a[3], b[0], b[1], b[2], b[3]}; }
#pragma unroll
        for (int c = 0; c < 2; ++c) { if (!act[c]) continue;
#pragma unroll
            for (int dt = 0; dt < 4; ++dt) st.o[c][dt] = __builtin_amdgcn_mfma_f32_16x16x32_bf16(pfr[c][G], vf[dt], st.o[c][dt], 0, 0, 0); }
        asm volatile("" ::: "memory");
    }
}
__device__ __forceinline__ void att_finish(const AttState& st, int c, int lane, float (&linv)[4]) {
    float l = st.l[c]; l += __shfl_xor(l, 16); l += __shfl_xor(l, 32);
    const float li = 1.0f / fmaxf(l, 1e-30f);
#pragma unroll
    for (int r = 0; r < 4; ++r) linv[r] = __shfl(li, 4 * (lane >> 4) + r);
}
__device__ __forceinline__ void select_blocks(float v0, float v1, int cur, int lane, unsigned long long& sel0, unsigned long long& sel1) {
    const unsigned k0 = __float_as_uint(v0), k1 = __float_as_uint(v1);
    const bool e0 = lane >= 1 && lane <= cur - 2, e1 = (lane + 64) <= cur - 2;
    const int nforced = cur >= 2 ? 3 : cur + 1, need = 16 - nforced, nelig = cur - 2 > 0 ? cur - 2 : 0;
    unsigned long long s0 = 1ull, s1 = 0ull;
    if (cur < 64) s0 |= 1ull << cur; else s1 |= 1ull << (cur - 64);
    if (cur >= 1) { if (cur - 1 < 64) s0 |= 1ull << (cur - 1); else s1 |= 1ull << (cur - 65); }
    if (nelig <= need) { s0 |= __ballot(e0); s1 |= __ballot(e1); }
    else {
        unsigned T = 0u;
        for (int bit = 30; bit >= 0; --bit) { const unsigned cand = T | (1u << bit);
            const int cnt = __popcll(__ballot(e0 && k0 >= cand)) + __popcll(__ballot(e1 && k1 >= cand));
            if (cnt >= need) T = cand; }
        const unsigned long long g0 = __ballot(e0 && k0 > T), g1 = __ballot(e1 && k1 > T);
        unsigned long long q0 = __ballot(e0 && k0 == T), q1 = __ballot(e1 && k1 == T);
        int rem = need - (__popcll(g0) + __popcll(g1));
        s0 |= g0; s1 |= g1;
        while (rem > 0 && (q0 | q1)) { if (q0) { const unsigned long long b = q0 & (~q0 + 1ull); s0 |= b; q0 ^= b; } else { const unsigned long long b = q1 & (~q1 + 1ull); s1 |= b; q1 ^= b; } --rem; }
    }
    sel0 = s0; sel1 = s1;
}

__device__ __forceinline__ unsigned pick4(const unsigned (&a)[4], int i) { return i == 0 ? a[0] : i == 1 ? a[1] : i == 2 ? a[2] : a[3]; }
constexpr int P8_GB = 65536, P8_SELB = 2 * P8_GB, P8_IMP = P8_GB  , P8_END = P8_SELB + 64 * 16;
static_assert(P8_END <= RING_BYTES && 64 * 132 * 4 <= P8_GB, "attention LDS");
__device__ __forceinline__ float rowmax4(float x) {
    auto r = __builtin_amdgcn_permlane16_swap(__float_as_uint(x), __float_as_uint(x), false, false); x = fmaxf(__uint_as_float(r[0]), __uint_as_float(r[1]));
    auto q = __builtin_amdgcn_permlane32_swap(__float_as_uint(x), __float_as_uint(x), false, false); return fmaxf(__uint_as_float(q[0]), __uint_as_float(q[1]));
}
__device__ __forceinline__ float rowsum4(float x) {
    auto r = __builtin_amdgcn_permlane16_swap(__float_as_uint(x), __float_as_uint(x), false, false); x = __uint_as_float(r[0]) + __uint_as_float(r[1]);
    auto q = __builtin_amdgcn_permlane32_swap(__float_as_uint(x), __float_as_uint(x), false, false); return __uint_as_float(q[0]) + __uint_as_float(q[1]);
}
struct TileAddr { int kofs[2]; int vofs[4]; };
__device__ __forceinline__ void tile_addr(TileAddr& T, int lane) {
    const int l15 = lane & 15, lq = lane >> 4, qp = l15 >> 2, p = l15 & 3, r7 = ((lq & 1) << 2) | qp;
#pragma unroll
    for (int ks = 0; ks < 2; ++ks) T.kofs[ks] = l15 * 128 + (((ks * 4 + lq) ^ (l15 & 7)) << 4);
#pragma unroll
    for (int dt = 0; dt < 4; ++dt) T.vofs[dt] = (4 * lq + qp) * 128 + (((dt * 2 + (p >> 1)) ^ r7) << 4) + (p & 1) * 8;
}
template <int MODE>
__device__ __forceinline__ void wave_block2(const LAS unsigned char* kt, const LAS unsigned char* vt, const TileAddr& T, const bf16x8 (&qf)[2][2], AttState& st, const float (&bias)[2], const bool (&act)[2],
                                            bool boundary, const int (&lo)[2], const int (&hi)[2], int lane, LAS float* imp_row0, int imp_blk0, int imp_stride) {
    const int l15 = lane & 15, lq = lane >> 4;
    if (!act[0] && !act[1]) return;
    bf16x8 kf[4][2];
#pragma unroll
    for (int t = 0; t < 4; ++t)
#pragma unroll
        for (int ks = 0; ks < 2; ++ks) kf[t][ks] = *(const LAS bf16x8*)(kt + t * 2048 + T.kofs[ks]);
    f32x4 s[2][4];
#pragma unroll
    for (int c = 0; c < 2; ++c) { if (!act[c]) continue;
        const float c0 = bias[c] - st.m[c];
#pragma unroll
        for (int t = 0; t < 4; ++t) { s[c][t] = (f32x4){c0, c0, c0, c0};
            s[c][t] = __builtin_amdgcn_mfma_f32_16x16x32_bf16(kf[t][0], qf[c][0], s[c][t], 0, 0, 0);
            s[c][t] = __builtin_amdgcn_mfma_f32_16x16x32_bf16(kf[t][1], qf[c][1], s[c][t], 0, 0, 0); } }
    bf16x8 vf[2][4];
    if (MODE != 1) {
#pragma unroll
        for (int G = 0; G < 2; ++G)
#pragma unroll
            for (int dt = 0; dt < 4; ++dt) { const s16x4 a = tr_read(vt + G * 4096 + T.vofs[dt]), b = tr_read(vt + G * 4096 + 2048 + T.vofs[dt]);
                vf[G][dt] = (bf16x8){a[0], a[1], a[2], a[3], b[0], b[1], b[2], b[3]}; }
    }
    bf16x8 pfr[2][2];
#pragma unroll
    for (int c = 0; c < 2; ++c) {
        if (!act[c]) continue;
        if (boundary) { const int l2 = lo[c] - 4 * lq, h2 = hi[c] - 4 * lq;
#pragma unroll
            for (int t = 0; t < 4; ++t)
#pragma unroll
                for (int r = 0; r < 4; ++r) { const int kk = t * 16 + r; if (kk < l2 || kk > h2) s[c][t][r] = S_NEG; } }
        float mx = fmaxf(fmaxf(s[c][0][0], s[c][0][1]), fmaxf(s[c][0][2], s[c][0][3]));
#pragma unroll
        for (int t = 1; t < 4; ++t) mx = fmaxf(mx, fmaxf(fmaxf(s[c][t][0], s[c][t][1]), fmaxf(s[c][t][2], s[c][t][3])));
        mx = rowmax4(mx);
        if (MODE == 1) {
            const float dl = fmaxf(mx, 0.f), f = __builtin_amdgcn_exp2f(-dl); st.m[c] += dl; float a = 0.f;
#pragma unroll
            for (int t = 0; t < 4; ++t)
#pragma unroll
                for (int r = 0; r < 4; ++r) a += __builtin_amdgcn_exp2f(s[c][t][r] - dl);
            st.l[c] = st.l[c] * f + a;
            continue;
        }
        if (MODE == 0) {
            if (__any(mx > RESC_THR)) {
                const float dl = fmaxf(mx, 0.f), f = __builtin_amdgcn_exp2f(-dl); st.m[c] += dl; st.l[c] *= f;
#pragma unroll
                for (int t = 0; t < 4; ++t) s[c][t] = s[c][t] - dl;
#pragma unroll
                for (int r = 0; r < 4; ++r) { const float fr = __shfl(f, 4 * lq + r);
#pragma unroll
                    for (int dt = 0; dt < 4; ++dt) st.o[c][dt][r] *= fr; }
            }
        }
        float a = 0.f;
#pragma unroll
        for (int t = 0; t < 4; ++t)
#pragma unroll
            for (int r = 0; r < 4; ++r) { s[c][t][r] = __builtin_amdgcn_exp2f(s[c][t][r]); a += s[c][t][r]; }
        if (MODE == 0) st.l[c] += a;
        if (MODE == 2) {
            const float li = st.l[c];
#pragma unroll
            for (int t = 0; t < 4; ++t) { s[c][t] = s[c][t] * li;
                float ia = 2.f * (s[c][t][0] + s[c][t][1] + s[c][t][2]) + s[c][t][3], ib = s[c][t][3];
                ia += __shfl_xor(ia, 1); ia += __shfl_xor(ia, 2); ib += __shfl_xor(ib, 1); ib += __shfl_xor(ib, 2);
                if ((l15 & 3) == 0) { LAS float* ir = imp_row0 + (c * 4 + (l15 >> 2)) * imp_stride + imp_blk0 + 4 * t + lq; atomicAdd((float*)ir, ia); atomicAdd((float*)(ir + 1), ib); } }
        }
#pragma unroll
        for (int G = 0; G < 2; ++G) {
            v4u pw; pw.x = pg8::cvt_pk_bf16(s[c][2 * G][0], s[c][2 * G][1]); pw.y = pg8::cvt_pk_bf16(s[c][2 * G][2], s[c][2 * G][3]); pw.z = pg8::cvt_pk_bf16(s[c][2 * G + 1][0], s[c][2 * G + 1][1]); pw.w = pg8::cvt_pk_bf16(s[c][2 * G + 1][2], s[c][2 * G + 1][3]);
            pfr[c][G] = __builtin_bit_cast(bf16x8, pw); }
    }
    if (MODE == 1) return;
#pragma unroll
    for (int G = 0; G < 2; ++G)
#pragma unroll
        for (int c = 0; c < 2; ++c) { if (!act[c]) continue;
#pragma unroll
            for (int dt = 0; dt < 4; ++dt) st.o[c][dt] = __builtin_amdgcn_mfma_f32_16x16x32_bf16(pfr[c][G], vf[G][dt], st.o[c][dt], 0, 0, 0); }
}
__device__ __forceinline__ void p8_dma_group(const bf16* kbase, const bf16* vbase, size_t row_stride, int blk0, int nblk, LAS unsigned char* gb, int w, int lane) {
    asm volatile("" : "+v"(lane));
    const size_t loff = (size_t)(8 * w + (lane >> 3)) * row_stride + (((lane & 7) ^ (lane >> 3)) << 3);
#pragma unroll
    for (int i = 0; i < 4; ++i) { const int blk = blk0 + (i < nblk ? i : nblk - 1); const size_t boff = (size_t)blk * 64 * row_stride + loff;
        __builtin_amdgcn_global_load_lds((const unsigned*)(kbase + boff), (LAS unsigned*)(gb + i * 16384 + w * 1024), 16, 0, 0);
        __builtin_amdgcn_global_load_lds((const unsigned*)(vbase + boff), (LAS unsigned*)(gb + i * 16384 + 8192 + w * 1024), 16, 0, 0); }
}
#define P8_WAITV(n) asm volatile("s_waitcnt vmcnt(" #n ")" ::: "memory")
#define P8_BARRIER() do { asm volatile("s_waitcnt lgkmcnt(0)" ::: "memory"); __builtin_amdgcn_s_barrier(); asm volatile("" ::: "memory"); } while (0)

__device__ __forceinline__ void p8_prompt_unit(Frame& F, const Args& A, int b, int qb, int g) {
    unsigned char* ws = A.ws; const bf16* KVB = (const bf16*)(ws + WS_KVB); const bf16* QB = (const bf16*)(ws + WS_QB); const bf16* KCP = (const bf16*)(ws + WS_KCP);
    const float* GT = (const float*)(ws + WS_GT); bf16* O = (bf16*)(ws + WS_O);
    LAS unsigned char* L = F.lds + RING_OFF; LAS float* IMP = (LAS float*)(L + P8_IMP); LAS unsigned* SELB = (LAS unsigned*)(L + P8_SELB);
    const int lane = F.lane, w = F.wave, l15 = lane & 15, lq = lane >> 4;
    const size_t rowbase = (size_t)b * TP + (size_t)qb * 64;
    float* OTG = (float*)(ws + WS_OTG) + ((size_t)F.vcu * NWAVES + w) * 2048 + lane;
    TileAddr T; tile_addr(T, lane);
    bf16x8 qf[2][2];
#pragma unroll
    for (int c = 0; c < 2; ++c)
#pragma unroll
        for (int ks = 0; ks < 2; ++ks) qf[c][ks] = *(const GAS bf16x8*)(QB + (rowbase + 8 * w + 4 * c + (l15 >> 2)) * DM + g * 256 + (l15 & 3) * 64 + ks * 32 + lq * 8);
    int tl[2]; tl[0] = 8 * w + (l15 >> 2); tl[1] = tl[0] + 4;
    for (int i = lane; i < 8 * 132; i += 64) IMP[w * 8 * 132 + i] = 0.f;
    AttState st; const float zb[2] = {0.f, 0.f}; const bool on[2] = {true, true};
    auto combine = [&](int br) {
#pragma unroll
        for (int c = 0; c < 2; ++c) { float linv[4];
            if (br == 0) {
#pragma unroll
                for (int r = 0; r < 4; ++r) linv[r] = 1.f; }
            else { const float li = 1.0f / fmaxf(rowsum4(st.l[c]), 1e-30f);
#pragma unroll
                for (int r = 0; r < 4; ++r) linv[r] = __shfl(li, 4 * lq + r); }
#pragma unroll
            for (int r = 0; r < 4; ++r) { const float gt = GT[(rowbase + 8 * w + 4 * c + lq) * 48 + g * 12 + r * 3 + br] * linv[r];
#pragma unroll
                for (int d = 0; d < 4; ++d) { float* p = OTG + ((c * 4 + d) * 4 + r) * 64; const float v = gt * st.o[c][d][r];
                    if (br == 0) *p = v; else if (br == 1) *p += v;
                    else O[(rowbase + 8 * w + 4 * c + lq) * DM + g * 256 + r * 64 + d * 16 + l15] = (bf16)f2bf(*p + v); } } }
    };
    const int ncv = 4 * qb + 3, ncb = (ncv + 63) >> 6, ncg = (ncb + 3) >> 2;
    const bf16* kc0 = KCP + (size_t)b * 512 * 512 + g * 64;
    int clo[2] = {0, 0}, chi[2];
    att_init(st);
    for (int pass = 0; pass < 2; ++pass) {
        if (pass == 1) {
#pragma unroll
            for (int c = 0; c < 2; ++c) st.l[c] = 1.0f / fmaxf(rowsum4(st.l[c]), 1e-30f); }
        for (int gi = 0; gi < ncg; ++gi) {
            const int nb = ncb - 4 * gi < 4 ? ncb - 4 * gi : 4;
            p8_dma_group(kc0, kc0 + 256, 512, 4 * gi, nb, L, w, lane);
            P8_WAITV(0); P8_BARRIER();
            for (int i = 0; i < nb; ++i) { const int blk = 4 * gi + i;
#pragma unroll
                for (int c = 0; c < 2; ++c) chi[c] = ((qb * 64 + tl[c] - 31) >> 4) - 64 * blk;
                if (pass == 0) wave_block2<1>(L + i * 16384, L + i * 16384 + 8192, T, qf, st, zb, on, true, clo, chi, lane, nullptr, 0, 0);
                else           wave_block2<2>(L + i * 16384, L + i * 16384 + 8192, T, qf, st, zb, on, true, clo, chi, lane, IMP + w * 8 * 132, blk * 16, 132); }
            P8_BARRIER();
        }
    }
    combine(0);
    LDS_WAIT();
    for (int t8 = 0; t8 < 8; ++t8) { const LAS float* ir = IMP + (w * 8 + t8) * 132; unsigned long long s0, s1;
        select_blocks(ir[lane], ir[lane + 64], qb, lane, s0, s1);
        if (lane == 0) { LAS unsigned* sb = SELB + (w * 8 + t8) * 4; sb[0] = (unsigned)s0; sb[1] = (unsigned)(s0 >> 32); sb[2] = (unsigned)s1; sb[3] = (unsigned)(s1 >> 32); } }
    LDS_WAIT();
    unsigned mysel[2][4], usel[2][4];
#pragma unroll
    for (int c = 0; c < 2; ++c)
#pragma unroll
        for (int i = 0; i < 4; ++i) { mysel[c][i] = SELB[tl[c] * 4 + i];
            usel[c][i] = __builtin_amdgcn_readfirstlane(SELB[(8 * w + 4 * c + 0) * 4 + i] | SELB[(8 * w + 4 * c + 1) * 4 + i] | SELB[(8 * w + 4 * c + 2) * 4 + i] | SELB[(8 * w + 4 * c + 3) * 4 + i]); }
    P8_BARRIER();
    {
        att_init(st);
        const bf16* k0 = KVB + (size_t)b * TP * NKV + 512 + g * 64; int lo2[2] = {0, 0}, hi2[2] = {tl[0], tl[1]};
        const int nblk = qb + 1, ng = (nblk + 3) >> 2;
        p8_dma_group(k0, k0 + 256, NKV, 0, nblk < 4 ? nblk : 4, L, w, lane);
        for (int gi = 0; gi < ng; ++gi) {
            LAS unsigned char* gb = L + (gi & 1) * P8_GB;
            if (gi + 1 < ng) { const int n2 = nblk - 4 * (gi + 1); p8_dma_group(k0, k0 + 256, NKV, 4 * (gi + 1), n2 < 4 ? n2 : 4, L + ((gi + 1) & 1) * P8_GB, w, lane); P8_WAITV(8); }
            else P8_WAITV(0);
            P8_BARRIER();
            const int nb = nblk - 4 * gi < 4 ? nblk - 4 * gi : 4;
            for (int i = 0; i < nb; ++i) { const int jb = 4 * gi + i; float bias[2]; bool act[2];
#pragma unroll
                for (int c = 0; c < 2; ++c) { bias[c] = ((pick4(mysel[c], jb >> 5) >> (jb & 31)) & 1u) ? 0.f : S_NEG; act[c] = ((pick4(usel[c], jb >> 5) >> (jb & 31)) & 1u) != 0u; }
                wave_block2<0>(gb + i * 16384, gb + i * 16384 + 8192, T, qf, st, bias, act, jb == qb, lo2, hi2, lane, nullptr, 0, 0); }
            P8_BARRIER();
        }
        combine(1);
    }
    {
        att_init(st);
        const int jb0 = qb >= 8 ? qb - 8 : 0, nblk = qb - jb0 + 1, ng = (nblk + 3) >> 2;
        const bf16* k0 = KVB + ((size_t)b * TP + (size_t)jb0 * 64) * NKV + 1024 + g * 64;
        p8_dma_group(k0, k0 + 256, NKV, 0, nblk < 4 ? nblk : 4, L, w, lane);
        for (int gi = 0; gi < ng; ++gi) {
            LAS unsigned char* gb = L + (gi & 1) * P8_GB;
            if (gi + 1 < ng) { const int n2 = nblk - 4 * (gi + 1); p8_dma_group(k0, k0 + 256, NKV, 4 * (gi + 1), n2 < 4 ? n2 : 4, L + ((gi + 1) & 1) * P8_GB, w, lane); P8_WAITV(8); }
            else P8_WAITV(0);
            P8_BARRIER();
            const int nb = nblk - 4 * gi < 4 ? nblk - 4 * gi : 4;
            for (int i = 0; i < nb; ++i) { const int jb = jb0 + 4 * gi + i; int lo2[2], hi2[2]; const bool low = (qb >= 8 && jb == qb - 8), top = (jb == qb);
#pragma unroll
                for (int c = 0; c < 2; ++c) { lo2[c] = low ? tl[c] : 0; hi2[c] = top ? tl[c] : 63; }
                wave_block2<0>(gb + i * 16384, gb + i * 16384 + 8192, T, qf, st, zb, on, low || top, lo2, hi2, lane, nullptr, 0, 0); }
            P8_BARRIER();
        }
        combine(2);
    }
}
constexpr int P8S_WAVE = 11008, P8S_KT = 0, P8S_VT = 32 * KT_STRIDE, P8S_IMP = P8S_VT + 32 * VT_STRIDE, P8S_OL = 8 * P8S_WAVE, P8S_ML = P8S_OL + 8 * 8192, P8S_END = P8S_ML + 8 * 256;
static_assert(P8S_IMP + 8 * 40 * 4 <= P8S_WAVE && P8S_END <= RING_BYTES, "sample attention LDS");
struct P8sRegs { f32x4 k[8], v[8]; };
__device__ __forceinline__ void p8s_load_f32(P8sRegs& R, const float* kp, const float* vp, int lane) {
    asm volatile("" : "+v"(lane)); const int r0 = lane >> 4, ch = lane & 15;
#pragma unroll
    for (int i = 0; i < 8; ++i) { R.k[i] = *(const GAS f32x4*)(kp + (size_t)(4 * i + r0) * 512 + ch * 4); R.v[i] = *(const GAS f32x4*)(vp + (size_t)(4 * i + r0) * 512 + ch * 4); }
}
__device__ __forceinline__ void p8s_store_f32(const P8sRegs& R, LAS unsigned char* kt, LAS unsigned char* vt, int lane) {
    asm volatile("" : "+v"(lane)); const int r0 = lane >> 4, ch = lane & 15;
#pragma unroll
    for (int i = 0; i < 8; ++i) { v2u a, b; a.x = pg8::cvt_pk_bf16(R.k[i][0], R.k[i][1]); a.y = pg8::cvt_pk_bf16(R.k[i][2], R.k[i][3]); b.x = pg8::cvt_pk_bf16(R.v[i][0], R.v[i][1]); b.y = pg8::cvt_pk_bf16(R.v[i][2], R.v[i][3]);
        *(LAS v2u*)(kt + (4 * i + r0) * KT_STRIDE + ch * 8) = a; *(LAS v2u*)(vt + (4 * i + r0) * VT_STRIDE + ch * 8) = b; }
}
__device__ __forceinline__ void p8s_stage_bf16(const bf16* kp, const bf16* vp, size_t stride, int nrows, LAS unsigned char* kt, LAS unsigned char* vt, int lane) {
    asm volatile("" : "+v"(lane));
    v4u rk[4], rv[4]; const int r0 = lane >> 3, ch = lane & 7;
#pragma unroll
    for (int i = 0; i < 4; ++i) { const int row = 8 * i + r0; rk[i] = (v4u){0u, 0u, 0u, 0u}; rv[i] = rk[i];
        if (row < nrows) { rk[i] = *(const GAS v4u*)(kp + (size_t)row * stride + ch * 8); rv[i] = *(const GAS v4u*)(vp + (size_t)row * stride + ch * 8); } }
#pragma unroll
    for (int i = 0; i < 4; ++i) { const int row = 8 * i + r0; *(LAS v4u*)(kt + row * KT_STRIDE + ch * 16) = rk[i]; *(LAS v4u*)(vt + row * VT_STRIDE + ch * 16) = rv[i]; }
}
__device__ __forceinline__ void p8_sample_pair(Frame& F, const Args& A, int u, bool valid) {
    unsigned char* ws = A.ws; const bf16* KVB = (const bf16*)(ws + WS_KVB); const bf16* QB = (const bf16*)(ws + WS_QB); const bf16* KCS = (const bf16*)(ws + WS_KCS);
    const float* GT = (const float*)(ws + WS_GT); bf16* O = (bf16*)(ws + WS_O); const int* ptab = (const int*)A.in[I_PT];
    const int n = u >> 2, g = u & 3, sp = F.wave & 3, q0 = F.wave & 4;
    LAS unsigned char* L = F.lds + RING_OFF + F.wave * P8S_WAVE; LAS unsigned char* kt = L + P8S_KT; LAS unsigned char* vt = L + P8S_VT; LAS float* IMP = (LAS float*)(L + P8S_IMP);
    LAS float* OL = (LAS float*)(F.lds + RING_OFF + P8S_OL); LAS float* ML = (LAS float*)(F.lds + RING_OFF + P8S_ML);
    const int lane = F.lane, l15 = lane & 15, lq = lane >> 4;
    const size_t rowbase = (size_t)MP + (size_t)n * TS;
    bf16x8 qf[2][2];
#pragma unroll
    for (int c = 0; c < 2; ++c)
#pragma unroll
        for (int ks = 0; ks < 2; ++ks) qf[c][ks] = *(const GAS bf16x8*)(QB + (rowbase + 4 * c + (l15 >> 2)) * DM + g * 256 + (l15 & 3) * 64 + ks * 32 + lq * 8);
    int tl[2]; tl[0] = l15 >> 2; tl[1] = tl[0] + 4;
    for (int i = lane; i < 8 * 40; i += 64) IMP[i] = 0.f;
    AttState st; const float zb[2] = {0.f, 0.f}; const bool on[2] = {true, true};
    f32x4 fin[2];
    auto publish = [&]() {
#pragma unroll
        for (int c = 0; c < 2; ++c) { float l = st.l[c]; l += __shfl_xor(l, 16); l += __shfl_xor(l, 32);
            if (lq == 0) { ML[((F.wave * 2 + c) * 16 + l15) * 2] = st.m[c]; ML[((F.wave * 2 + c) * 16 + l15) * 2 + 1] = l; }
#pragma unroll
            for (int d = 0; d < 4; ++d)
#pragma unroll
                for (int r = 0; r < 4; ++r) OL[(F.wave * 32 + (c * 4 + d) * 4 + r) * 64 + lane] = st.o[c][d][r]; }
    };
    auto merge = [&](int br) {
#pragma unroll
        for (int k = 0; k < 2; ++k) { const int p = 2 * sp + k, c = p >> 2, d = p & 3;
#pragma unroll
            for (int r = 0; r < 4; ++r) { const int qrow = 4 * lq + r; float mi[4], li[4], M = -3.0e38f;
#pragma unroll
                for (int i = 0; i < 4; ++i) { mi[i] = ML[(((q0 + i) * 2 + c) * 16 + qrow) * 2]; li[i] = ML[(((q0 + i) * 2 + c) * 16 + qrow) * 2 + 1]; M = fmaxf(M, mi[i]); }
                float Ls = 0.f, Os = 0.f;
#pragma unroll
                for (int i = 0; i < 4; ++i) { const float wgt = __builtin_amdgcn_exp2f(mi[i] - M); Ls += wgt * li[i]; Os += wgt * OL[((q0 + i) * 32 + (c * 4 + d) * 4 + r) * 64 + lane]; }
                const float gt = GT[(rowbase + 4 * c + lq) * 48 + g * 12 + r * 3 + br];
                fin[k][r] += gt * Os / fmaxf(Ls, 1e-30f); } }
    };
#define WSYNC() do { LDS_WAIT(); asm volatile("" ::: "memory"); } while (0)
    if (valid) {
    const bf16* kc0 = KCS + (size_t)n * 128 * 512 + g * 64;
    int clo[2] = {0, 0}, chi[2];
    att_init(st);
    for (int pass = 0; pass < 2; ++pass) {
        if (pass == 1) {
#pragma unroll
            for (int c = 0; c < 2; ++c) { float l = st.l[c]; l += __shfl_xor(l, 16); l += __shfl_xor(l, 32); st.l[c] = 1.0f / fmaxf(l, 1e-30f); } }
        for (int hb = 0; hb < 4; ++hb) {
            WSYNC(); p8s_stage_bf16(kc0 + (size_t)hb * 32 * 512, kc0 + (size_t)hb * 32 * 512 + 256, 512, 32, kt, vt, lane); WSYNC();
            chi[0] = 126 - 32 * hb; chi[1] = chi[0];
            if (pass == 0) wave_block<2, 1>(kt, vt, qf, st, zb, on, hb == 3, clo, chi, lane, nullptr, 0, 0);
            else           wave_block<2, 2>(kt, vt, qf, st, zb, on, hb == 3, clo, chi, lane, IMP, hb * 8, 40);
        }
    }
#pragma unroll
    for (int c = 0; c < 2; ++c)
#pragma unroll
        for (int d = 0; d < 4; ++d)
#pragma unroll
            for (int r = 0; r < 4; ++r) OL[(F.wave * 32 + (c * 4 + d) * 4 + r) * 64 + lane] = st.o[c][d][r];
    WSYNC();
#pragma unroll
    for (int k = 0; k < 2; ++k) { const int p = 2 * sp + k, c = p >> 2, d = p & 3;
#pragma unroll
        for (int r = 0; r < 4; ++r) fin[k][r] = GT[(rowbase + 4 * c + lq) * 48 + g * 12 + r * 3 + 0] * OL[(F.wave * 32 + (c * 4 + d) * 4 + r) * 64 + lane]; }
    }
    unsigned mysel[2][2] = {{0u, 0u}, {0u, 0u}};
    if (valid) {
    WSYNC();
    unsigned selw[8][2];
#pragma unroll
    for (int t8 = 0; t8 < 8; ++t8) { unsigned long long s0, s1; const float v0 = lane < 33 ? IMP[t8 * 40 + lane] : 0.f; select_blocks(v0, 0.f, 32, lane, s0, s1); selw[t8][0] = (unsigned)s0; selw[t8][1] = (unsigned)(s0 >> 32); }
#pragma unroll
    for (int c = 0; c < 2; ++c)
#pragma unroll
        for (int i = 0; i < 2; ++i) { const int tt = l15 >> 2; const unsigned a0 = selw[4 * c + 0][i], a1 = selw[4 * c + 1][i], a2 = selw[4 * c + 2][i], a3 = selw[4 * c + 3][i];
            mysel[c][i] = tt == 0 ? a0 : tt == 1 ? a1 : tt == 2 ? a2 : a3; }
    }
    __syncthreads();
    if (valid) {
        att_init(st);
        const float* cache = A.in[I_CSLC]; int lo2[2] = {0, 0}, hi2[2] = {tl[0], tl[1]};
        P8sRegs R;
        { const int pg = ptab[n * NPAGE + (sp >> 2)]; const float* kp = cache + ((size_t)pg * PAGE + (sp & 3) * 32) * 512 + g * 64; p8s_load_f32(R, kp, kp + 256, lane); }
        for (int hb = sp; hb < 64; hb += 4) {
            WSYNC(); p8s_store_f32(R, kt, vt, lane);
            if (hb + 4 < 64) { const int h2 = hb + 4, pg = ptab[n * NPAGE + (h2 >> 2)]; const float* kp = cache + ((size_t)pg * PAGE + (h2 & 3) * 32) * 512 + g * 64; p8s_load_f32(R, kp, kp + 256, lane); }
            WSYNC();
            const int jb = hb >> 1; float bias[2];
#pragma unroll
            for (int c = 0; c < 2; ++c) bias[c] = (((jb < 32 ? mysel[c][0] : mysel[c][1]) >> (jb & 31)) & 1u) ? 0.f : S_NEG;
            wave_block<2, 0>(kt, vt, qf, st, bias, on, false, lo2, hi2, lane, nullptr, 0, 0);
        }
        if (sp == 0) {
            WSYNC(); { const bf16* kp = KVB + rowbase * NKV + 512 + g * 64; p8s_stage_bf16(kp, kp + 256, NKV, 8, kt, vt, lane); } WSYNC();
            wave_block<2, 0>(kt, vt, qf, st, zb, on, true, lo2, hi2, lane, nullptr, 0, 0);
        }
        publish();
    }
    __syncthreads();
    if (valid) merge(1);
    __syncthreads();
    if (valid) {
        att_init(st);
        const float* sw = A.in[I_SWIN] + (size_t)n * 512 * 512 + g * 64;
        P8sRegs R;
        p8s_load_f32(R, sw + (size_t)sp * 32 * 512, sw + (size_t)sp * 32 * 512 + 256, lane);
        for (int hb = sp; hb < 16; hb += 4) {
            WSYNC(); p8s_store_f32(R, kt, vt, lane);
            if (hb + 4 < 16) p8s_load_f32(R, sw + (size_t)(hb + 4) * 32 * 512, sw + (size_t)(hb + 4) * 32 * 512 + 256, lane);
            WSYNC();
            int lo2[2], hi2[2];
#pragma unroll
            for (int c = 0; c < 2; ++c) { lo2[c] = tl[c] - 32 * hb; hi2[c] = 512 + tl[c] - 32 * hb; }
            wave_block<2, 0>(kt, vt, qf, st, zb, on, hb == 0, lo2, hi2, lane, nullptr, 0, 0);
        }
        if (sp == 0) {
            WSYNC(); { const bf16* kp = KVB + rowbase * NKV + 1024 + g * 64; p8s_stage_bf16(kp, kp + 256, NKV, 8, kt, vt, lane); } WSYNC();
            int lo2[2], hi2[2];
#pragma unroll
            for (int c = 0; c < 2; ++c) { lo2[c] = tl[c] - 512; hi2[c] = tl[c]; }
            wave_block<2, 0>(kt, vt, qf, st, zb, on, true, lo2, hi2, lane, nullptr, 0, 0);
        }
        publish();
    }
    __syncthreads();
    if (valid) { merge(2);
#pragma unroll
        for (int k = 0; k < 2; ++k) { const int p = 2 * sp + k, c = p >> 2, d = p & 3;
#pragma unroll
            for (int r = 0; r < 4; ++r) O[(rowbase + 4 * c + lq) * DM + g * 256 + r * 64 + d * 16 + l15] = (bf16)f2bf(fin[k][r]); } }
    __syncthreads();
#undef WSYNC
}
__device__ __forceinline__ void p8_attention(Frame& F, const Args& A) {
    for (int ub = 2 * F.vcu; ub < NBS * 4; ub += 2 * F.G) { const int u = ub + (F.wave >> 2); p8_sample_pair(F, A, u < NBS * 4 ? u : 0, u < NBS * 4); }
    __syncthreads();
    for (;;) {
        if (F.tid == 0) F.MISC[16] = __hip_atomic_fetch_add((unsigned*)(F.ctl + CW_Q8), 1u, __ATOMIC_RELAXED, __HIP_MEMORY_SCOPE_AGENT);
        __syncthreads();
        const int u = (int)F.MISC[16];
        __syncthreads();
        if (u >= NBP * 128 * 4) break;
        const int qb = 127 - (u >> 3), b = (u >> 2) & 1, g = u & 3; p8_prompt_unit(F, A, b, qb, g);
    }
}
constexpr int N_PHASES = 15;
__global__ void __launch_bounds__(NWAVES * 64, 2) yoco_fwd(Args args) {
    extern __shared__ __attribute__((aligned(16))) unsigned char lds[];
    Frame F;
    F.lds = (LAS unsigned char*)lds; F.MISC = (volatile LAS unsigned*)(F.lds + MISC_OFF);
    F.tid = threadIdx.x; F.lane = F.tid & 63; F.wave = __builtin_amdgcn_readfirstlane(F.tid >> 6);
    F.G = gridDim.x; { const int bx = blockIdx.x; F.vcu = (F.G % 8 == 0) ? (bx % 8) * (F.G / 8) + bx / 8 : bx; }
    unsigned char* ws = args.ws;
    F.ctl = (gu32*)(ws + WS_CTL);
    for (int u = F.tid; u < (LDS_BYTES - LDSCTL_OFF) / 4; u += NWAVES * 64) ((LAS unsigned*)(F.lds + LDSCTL_OFF))[u] = 0u;
    __syncthreads();
    const int lo = args.ph_lo, hi = args.ph_hi;
    const bool multi = (hi - lo) > 1;
    XcdBarrier bar; bar.bar = (unsigned*)(F.ctl + CW_BAR); bar.x = 0; bar.st = nullptr;
    if (multi) bar = xcd_barrier_post((unsigned*)(F.ctl + CW_BAR), F.MISC + 8);
#define IN(k) (lo <= (k) && (k) < hi)
#define SEAM(k) do { if (IN(k) && IN((k) + 1)) xcd_barrier(bar); } while (0)
    bf16* const XB = (bf16*)(ws + WS_XB); bf16* const BBp = (bf16*)(ws + WS_BB); bf16* const VBp = (bf16*)(ws + WS_VB); bf16* const Zp = (bf16*)(ws + WS_Z);
    float* const Hp = (float*)(ws + WS_H); bf16* const HBp = (bf16*)(ws + WS_HB); bf16* const ACTp = (bf16*)(ws + WS_ACT); bf16* const KVBp = (bf16*)(ws + WS_KVB);
    bf16* const QBp = (bf16*)(ws + WS_QB); bf16* const Op = (bf16*)(ws + WS_O); float* const GTp = (float*)(ws + WS_GT);
    float* const SSQ = (float*)(ws + WS_SSQ); constexpr size_t SSQ_STRIDE = (size_t)MT * 16;
    const int c = (int)blockIdx.x;

    const bf16* const WAIN = (const bf16*)(ws + WS_WAIN); const bf16* const WAOUT = (const bf16*)(ws + WS_WAOUT); const bf16* const WKVQ = (const bf16*)(ws + WS_WKVQ); const bf16* const WBOUT = (const bf16*)(ws + WS_WBOUT);
    float* const SSQ0 = SSQ, * const SSQ1 = SSQ + SSQ_STRIDE, * const SSQ2 = SSQ + 2 * SSQ_STRIDE;
#define GEMM(EPI, E, SCH, S, Ap, Wp, N_, K_) pg8::gemm_phase<pg8::EPI, pg8::SCH, PG8_ALIGN, PG8_SP2>(F.lds + RING_OFF, pg8::Gemm{Ap, Wp, MT, N_, K_}, S, E)
    if (IN(0)) { p0_prologue(F, args); }
    SEAM(0);
    if (IN(1)) { pg8::StaticOrder S; S.init(MP, NAIN, F.G, c); pg8::EpiAin E{VBp, BBp, (const float*)(ws + WS_RSTD0)}; GEMM(EpiAin, E, StaticOrder, S, XB, WAIN, NAIN, DM); }
    SEAM(1);
    if (IN(2)) { if (c < 48) { pg8::SubOrder S; S.init(64, 4, 12, 48, c); pg8::EpiAin E{VBp, BBp, (const float*)(ws + WS_RSTD0)}; GEMM(EpiAin, E, SubOrder, S, XB, WAIN, NAIN, DM); }
                 else p2_conv(F, args, 0, MP, 48, F.G - 48); }
    SEAM(2);
    if (IN(3)) { { pg8::StaticOrder S; S.init(MP, DM, F.G, c); pg8::EpiRes E{XB, HBp, SSQ0}; GEMM(EpiRes, E, StaticOrder, S, Zp, WAOUT, DM, DM); }
                 p2_conv(F, args, MP, MT, 0, F.G); }
    SEAM(3);
    if (IN(4)) { if (c >= 240) { pg8::SubOrder S; S.init(64, 4, 4, 16, c - 240); pg8::EpiRes E{XB, HBp, SSQ0}; GEMM(EpiRes, E, SubOrder, S, Zp, WAOUT, DM, DM); }
                 { pg8::StaticOrder S; S.init(MP, NFF, F.G, c); pg8::EpiFfn E{ACTp, SSQ0}; GEMM(EpiFfn, E, StaticOrder, S, HBp, (const bf16*)(ws + WS_WFIN0), NFF, DM); } }
    SEAM(4);
    if (IN(5)) { { pg8::StaticOrder S; S.init(MP, DM, F.G, c); pg8::EpiRes E{HBp, HBp, SSQ1}; GEMM(EpiRes, E, StaticOrder, S, ACTp, (const bf16*)(ws + WS_WFOUT0), DM, DFF); }
                 if (c < 88) { pg8::SubOrder S; S.init(64, 4, 22, 88, c); pg8::EpiFfn E{ACTp, SSQ0}; GEMM(EpiFfn, E, SubOrder, S, HBp, (const bf16*)(ws + WS_WFIN0), NFF, DM); } }
    SEAM(5);
    if (IN(6)) { pg8::EpiKvq EK{KVBp, QBp, GTp, SSQ1, args.out + O_CMPP, args.out + O_CMPS, args.out + O_SLCP, args.out + O_SLCS, args.out + O_WINP, args.out + O_WINS};
                 if (c >= 240) { pg8::SubOrder S; S.init(64, 4, 4, 16, c - 240); pg8::EpiRes E{HBp, HBp, SSQ1}; GEMM(EpiRes, E, SubOrder, S, ACTp, (const bf16*)(ws + WS_WFOUT0), DM, DFF); }
                 else { pg8::StaticOrder S; S.init(MP, NKVQ, 240, c); GEMM(EpiKvq, EK, StaticOrder, S, HBp, WKVQ, NKVQ, DM); } }
    SEAM(6);
    if (IN(7)) { if (c < 44) { pg8::SubOrder S; S.init(64, 4, 11, 44, c); pg8::EpiKvq EK{KVBp, QBp, GTp, SSQ1, args.out + O_CMPP, args.out + O_CMPS, args.out + O_SLCP, args.out + O_SLCS, args.out + O_WINP, args.out + O_WINS};
                     GEMM(EpiKvq, EK, SubOrder, S, HBp, WKVQ, NKVQ, DM); }
                 p7_compress(F, args, 0); }
    SEAM(7);
    if (IN(8)) { p7_compress(F, args, 1); }
    SEAM(8);
    if (IN(9)) { p8_attention(F, args); }
    SEAM(9);
    if (IN(10)) { pg8::StaticOrder S; S.init(MP, DM, F.G, c); pg8::EpiRes E{HBp, HBp, SSQ2}; GEMM(EpiRes, E, StaticOrder, S, Op, WBOUT, DM, DM); }
    SEAM(10);
    if (IN(11)) { if (c >= 240) { pg8::SubOrder S; S.init(64, 4, 4, 16, c - 240); pg8::EpiRes E{HBp, HBp, SSQ2}; GEMM(EpiRes, E, SubOrder, S, Op, WBOUT, DM, DM); }
                  { pg8::StaticOrder S; S.init(MP, NFF, F.G, c); pg8::EpiFfn E{ACTp, SSQ2}; GEMM(EpiFfn, E, StaticOrder, S, HBp, (const bf16*)(ws + WS_WFIN1), NFF, DM); } }
    SEAM(11);
    if (IN(12)) { { pg8::StaticOrder S; S.init(MP, DM, F.G, c); pg8::EpiRes E{HBp, HBp, nullptr}; GEMM(EpiRes, E, StaticOrder, S, ACTp, (const bf16*)(ws + WS_WFOUT1), DM, DFF); }
                  if (c < 88) { pg8::SubOrder S; S.init(64, 4, 22, 88, c); pg8::EpiFfn E{ACTp, SSQ2}; GEMM(EpiFfn, E, SubOrder, S, HBp, (const bf16*)(ws + WS_WFIN1), NFF, DM); } }
    SEAM(12);
    if (IN(13)) { if (c >= 240) { pg8::SubOrder S; S.init(64, 4, 4, 16, c - 240); pg8::EpiRes E{HBp, HBp, nullptr}; GEMM(EpiRes, E, SubOrder, S, ACTp, (const bf16*)(ws + WS_WFOUT1), DM, DFF); }
                  else { p_final(F, args, 0, MP, 0, 240); p_wincopy(F, args, 0, 240); } }
    SEAM(13);
    if (IN(14)) { p_final(F, args, MP, MT, 0, F.G); }
#undef GEMM
#undef IN
#undef SEAM
}

#ifndef MK_PER_PHASE
#define MK_PER_PHASE 0
#endif
extern "C" void kernel_launch(void* const* d_in, const int* in_sizes, int n_in, void* d_out, int out_size, void* d_ws, size_t ws_size, hipStream_t stream) {
    static int grid = 0;
    if (grid == 0) {
        if (n_in != 21 || out_size != (int)O_END || ws_size < WS_END) { fprintf(stderr, "kernel_launch: unexpected shapes (n_in %d out %d ws %zu)\n", n_in, out_size, ws_size); grid = -1; return; }
        int dev = 0, cus = 0, per_cu = 0;
        if (hipGetDevice(&dev) != hipSuccess || hipDeviceGetAttribute(&cus, hipDeviceAttributeMultiprocessorCount, dev) != hipSuccess) { grid = -1; return; }
        if (hipFuncSetAttribute((const void*)yoco_fwd, hipFuncAttributeMaxDynamicSharedMemorySize, LDS_BYTES) != hipSuccess) { fprintf(stderr, "kernel_launch: hipFuncSetAttribute failed\n"); grid = -1; return; }
        if (hipOccupancyMaxActiveBlocksPerMultiprocessor(&per_cu, (const void*)yoco_fwd, NWAVES * 64, LDS_BYTES) != hipSuccess || per_cu < 1) { fprintf(stderr, "kernel_launch: occupancy query says %d\n", per_cu); }
        (void)hipGetLastError();
        grid = cus;
    }
    if (grid < 0) return;
    if (hipMemsetAsync((char*)d_ws + WS_CTL, 0, CTL_ZERO_BYTES, stream) != hipSuccess) return;
    Args a{};
    for (int i = 0; i < 21; ++i) a.in[i] = (const float*)d_in[i];
    a.out = (float*)d_out; a.ws = (unsigned char*)d_ws;
#if MK_PER_PHASE
    for (int p = 0; p < N_PHASES; ++p) { a.ph_lo = p; a.ph_hi = p + 1; hipLaunchKernelGGL(yoco_fwd, dim3(grid), dim3(NWAVES * 64), LDS_BYTES, stream, a); }
#else
    a.ph_lo = 0; a.ph_hi = N_PHASES; hipLaunchKernelGGL(yoco_fwd, dim3(grid), dim3(NWAVES * 64), LDS_BYTES, stream, a);
#endif
}
```

```cpp
#include <hip/hip_runtime.h>
#include <cstdio>
#include <cstdint>
namespace pg8 {
#define PG8_LAS __attribute__((address_space(3)))
typedef unsigned short bf16_t;
typedef short bf16x8 __attribute__((ext_vector_type(8)));
typedef float f32x4 __attribute__((ext_vector_type(4)));
typedef unsigned u32x4 __attribute__((ext_vector_type(4)));
constexpr int BM = 256, BK = 64, HALF = 128, HTB = HALF * BK * 2  , STAGE_BYTES = 8 * HTB, NXCD = 8, WGM = 8;

__host__ __device__ __forceinline__ int lds_byte(int r, int c) { const int st = (r >> 4) * 2 + (c >> 5), rr = r & 15, cc = c & 31, ob = rr * 64 + cc * 2; return st * 1024 + (ob ^ (((ob >> 9) & 1) << 5)); }
__host__ __device__ __forceinline__ void stage_rc(int b, int& R, int& C) { const int st = b / 1024, sb = b % 1024, swz = sb ^ (((sb >> 9) & 1) << 5); R = (st >> 1) * 16 + swz / 64; C = (st & 1) * 32 + (swz % 64) / 2; }
__host__ __device__ __forceinline__ int perm32(int rho) { const int n = rho >> 4, i = rho & 15; return 8 * (i >> 2) + 4 * n + (i & 3); }

struct Unit { int pm, pn; };
struct Gemm { const bf16_t* A; const bf16_t* Bt; int M, N, K; };

struct StaticOrder {
    int nM, nN, nwg, G, c;
    __host__ __device__ void init(int M, int N, int G_, int c_) { nM = M / BM; nN = N / BM; nwg = nM * nN; G = G_; c = c_; }
    __host__ __device__ bool next(int i, Unit& u) const {
        const long L = (long)i * G + c; if (L >= nwg) return false;
        int wgid = (int)L; { const int q = nwg / NXCD, r = nwg % NXCD, xcd = wgid % NXCD, off = wgid / NXCD; wgid = (xcd < r ? xcd * (q + 1) : r * (q + 1) + (xcd - r) * q) + off; }
        const int nig = WGM * nN, gid = wgid / nig, fm = gid * WGM, gsz = (nM - fm) < WGM ? (nM - fm) : WGM;
        u.pm = fm + ((wgid % nig) % gsz); u.pn = (wgid % nig) / gsz; return true;
    }
    __device__ __forceinline__ void a_ready(const Unit&) const {}
    __device__ __forceinline__ void done(const Unit&) const {}
};

__device__ __forceinline__ unsigned cvt_pk_bf16(float lo, float hi) { unsigned r; asm volatile("v_cvt_pk_bf16_f32 %0, %1, %2" : "=v"(r) : "v"(lo), "v"(hi)); return r; }
constexpr int E_MP = 16384;
constexpr float E_EPS = 1e-6f;
__device__ __forceinline__ float row_rstd16(const float* ssqp, int row, int fq) {
    const f32x4 p = *(const f32x4*)(ssqp + (size_t)row * 16 + fq * 4);
    float s = (p[0] + p[1]) + (p[2] + p[3]); s += __shfl_xor(s, 16); s += __shfl_xor(s, 32);
    return __builtin_amdgcn_rsqf(s * (1.0f / 1024.0f) + E_EPS);
}
__device__ __forceinline__ u32x4 pack8(const f32x4 a, const f32x4 b) { u32x4 w; w.x = cvt_pk_bf16(a[0], a[1]); w.y = cvt_pk_bf16(a[2], a[3]); w.z = cvt_pk_bf16(b[0], b[1]); w.w = cvt_pk_bf16(b[2], b[3]); return w; }

struct EpiAin {
    static constexpr bool PERM = true, AFTER_DRAIN = false;
    bf16_t* VB; bf16_t* BB; const float* rstd;
    __device__ __forceinline__ void operator()(const f32x4 (&acc)[2][2][4][2], const Unit& u, int wr, int wc, int fr, int fq) const {
        const int row0 = u.pm * BM + wr * 64 + fr;
        if (u.pn < 8) {
            const int ch = u.pn * 128 + wc * 32 + 8 * fq;
#pragma unroll
            for (int ai = 0; ai < 2; ++ai)
#pragma unroll
                for (int m = 0; m < 4; ++m) { const int row = row0 + ai * HALF + m * 16; const float r = rstd[row], r2 = r * r;
                    const f32x4 v0 = acc[ai][0][m][0] * acc[ai][1][m][0] * r2, v1 = acc[ai][0][m][1] * acc[ai][1][m][1] * r2;
                    *(u32x4*)(VB + (size_t)row * 1024 + ch) = pack8(v0, v1); }
        } else {
            const int ch = (u.pn - 8) * 256 + wc * 32 + 8 * fq;
#pragma unroll
            for (int ai = 0; ai < 2; ++ai)
#pragma unroll
                for (int m = 0; m < 4; ++m) { const int row = row0 + ai * HALF + m * 16; const float r = rstd[row];
#pragma unroll
                    for (int bj = 0; bj < 2; ++bj) *(u32x4*)(BB + (size_t)row * 1024 + ch + bj * HALF) = pack8(acc[ai][bj][m][0] * r, acc[ai][bj][m][1] * r); }
        }
    }
};
struct EpiRes {
    static constexpr bool PERM = true, AFTER_DRAIN = false;
    const bf16_t* base; bf16_t* HB; float* ssqp;
    __device__ __forceinline__ void operator()(const f32x4 (&acc)[2][2][4][2], const Unit& u, int wr, int wc, int fr, int fq) const {
        const int row0 = u.pm * BM + wr * 64 + fr, col0 = u.pn * BM + wc * 32 + 8 * fq;
#pragma unroll
        for (int ai = 0; ai < 2; ++ai)
#pragma unroll
            for (int m = 0; m < 4; ++m) { const int row = row0 + ai * HALF + m * 16; const size_t off = (size_t)row * 1024 + col0; float ss = 0.f;
#pragma unroll
                for (int bj = 0; bj < 2; ++bj) { const u32x4 bw = *(const u32x4*)(base + off + bj * HALF);
                    f32x4 h0, h1;
                    h0[0] = __builtin_bit_cast(float, bw.x << 16) + acc[ai][bj][m][0][0]; h0[1] = __builtin_bit_cast(float, bw.x & 0xffff0000u) + acc[ai][bj][m][0][1];
                    h0[2] = __builtin_bit_cast(float, bw.y << 16) + acc[ai][bj][m][0][2]; h0[3] = __builtin_bit_cast(float, bw.y & 0xffff0000u) + acc[ai][bj][m][0][3];
                    h1[0] = __builtin_bit_cast(float, bw.z << 16) + acc[ai][bj][m][1][0]; h1[1] = __builtin_bit_cast(float, bw.z & 0xffff0000u) + acc[ai][bj][m][1][1];
                    h1[2] = __builtin_bit_cast(float, bw.w << 16) + acc[ai][bj][m][1][2]; h1[3] = __builtin_bit_cast(float, bw.w & 0xffff0000u) + acc[ai][bj][m][1][3];
                    const u32x4 o = pack8(h0, h1); *(u32x4*)(HB + off + bj * HALF) = o;
                    if (ssqp) { const float r0 = __builtin_bit_cast(float, o.x << 16), r1 = __builtin_bit_cast(float, o.x & 0xffff0000u), r2 = __builtin_bit_cast(float, o.y << 16), r3 = __builtin_bit_cast(float, o.y & 0xffff0000u),
                                            r4 = __builtin_bit_cast(float, o.z << 16), r5 = __builtin_bit_cast(float, o.z & 0xffff0000u), r6 = __builtin_bit_cast(float, o.w << 16), r7 = __builtin_bit_cast(float, o.w & 0xffff0000u);
                        ss += (r0 * r0 + r1 * r1) + (r2 * r2 + r3 * r3) + (r4 * r4 + r5 * r5) + (r6 * r6 + r7 * r7); } }
                if (ssqp) { ss += __shfl_xor(ss, 16); ss += __shfl_xor(ss, 32); if (fq == 0) ssqp[(size_t)row * 16 + u.pn * 4 + wc] = ss; }
                if (m & 1) asm volatile("" ::: "memory"); }
    }
};
struct EpiFfn {
    static constexpr bool PERM = true, AFTER_DRAIN = false;
    bf16_t* ACT; const float* ssqp;
    __device__ __forceinline__ void operator()(const f32x4 (&acc)[2][2][4][2], const Unit& u, int wr, int wc, int fr, int fq) const {
        const int row0 = u.pm * BM + wr * 64 + fr, ch = u.pn * 128 + wc * 32 + 8 * fq;
#pragma unroll
        for (int ai = 0; ai < 2; ++ai)
#pragma unroll
            for (int m = 0; m < 4; ++m) { const int row = row0 + ai * HALF + m * 16; const float r = row_rstd16(ssqp, row, fq);
                f32x4 o[2];
#pragma unroll
                for (int n = 0; n < 2; ++n)
#pragma unroll
                    for (int e = 0; e < 4; ++e) { const float g = acc[ai][0][m][n][e] * r, up = acc[ai][1][m][n][e] * r;
                        o[n][e] = g * up * __builtin_amdgcn_rcpf(1.0f + __builtin_amdgcn_exp2f(g * -1.4426950408889634f)); }
                *(u32x4*)(ACT + (size_t)row * 2816 + ch) = pack8(o[0], o[1]); }
    }
};
struct EpiKvq {
    static constexpr bool PERM = true, AFTER_DRAIN = false;
    bf16_t* KVB; bf16_t* QB; float* GT; const float* ssqp;
    float *cmp_p, *cmp_s, *slc_p, *slc_s, *win_p, *win_s;
    __device__ __forceinline__ void operator()(const f32x4 (&acc)[2][2][4][2], const Unit& u, int wr, int wc, int fr, int fq) const {
        const int row0 = u.pm * BM + wr * 64 + fr, cw = wc * 32 + 8 * fq;
#pragma unroll
        for (int ai = 0; ai < 2; ++ai)
#pragma unroll
            for (int m = 0; m < 4; ++m) { const int row = row0 + ai * HALF + m * 16; const float r = row_rstd16(ssqp, row, fq);
                if (u.pn < 6) {
                    const int br = u.pn >> 1; float* orow = nullptr;
                    if (row < E_MP) { if (br == 0) orow = cmp_p + (size_t)row * 512; else if (br == 1) orow = slc_p + (size_t)row * 512;
                        else { const int t = row & 8191; if (t >= 7680) orow = win_p + ((size_t)(row >> 13) * 512 + (t - 7680)) * 512; } }
                    else { const int rs = row - E_MP; if (br == 0) orow = cmp_s + (size_t)rs * 512; else if (br == 1) orow = slc_s + (size_t)rs * 512;
                        else orow = win_s + ((size_t)(rs >> 3) * 512 + 504 + (rs & 7)) * 512; }
#pragma unroll
                    for (int bj = 0; bj < 2; ++bj) { const int col = u.pn * BM + bj * HALF + cw; const f32x4 a = acc[ai][bj][m][0] * r, b = acc[ai][bj][m][1] * r;
                        *(u32x4*)(KVB + (size_t)row * 1536 + col) = pack8(a, b);
                        if (orow) { *(f32x4*)(orow + (col & 511)) = a; *(f32x4*)(orow + (col & 511) + 4) = b; } }
                } else if (u.pn < 10) {
#pragma unroll
                    for (int bj = 0; bj < 2; ++bj) { const int col = (u.pn - 6) * BM + bj * HALF + cw;
                        *(u32x4*)(QB + (size_t)row * 1024 + col) = pack8(acc[ai][0 + bj][m][0] * r, acc[ai][0 + bj][m][1] * r); }
                } else {
                    if (cw < 48) {
                        f32x4 s0, s1;
#pragma unroll
                        for (int e = 0; e < 4; ++e) { s0[e] = __builtin_amdgcn_rcpf(1.0f + __builtin_amdgcn_exp2f(acc[ai][0][m][0][e] * r * -1.4426950408889634f));
                                                      s1[e] = __builtin_amdgcn_rcpf(1.0f + __builtin_amdgcn_exp2f(acc[ai][0][m][1][e] * r * -1.4426950408889634f)); }
                        *(f32x4*)(GT + (size_t)row * 48 + cw) = s0; *(f32x4*)(GT + (size_t)row * 48 + cw + 4) = s1; }
                }
            }
    }
};

struct SubOrder {
    int pm0, nM, nwg, Gs, cl;
    __host__ __device__ void init(int pm0_, int nM_, int nN_, int Gs_, int cl_) { pm0 = pm0_; nM = nM_; nwg = nM_ * nN_; Gs = Gs_; cl = cl_; }
    __host__ __device__ bool next(int i, Unit& u) const { if (cl < 0 || cl >= Gs) return false; const int L = i * Gs + cl; if (L >= nwg) return false; u.pm = pm0 + L % nM; u.pn = L / nM; return true; }
    __device__ __forceinline__ void a_ready(const Unit&) const {}
    __device__ __forceinline__ void done(const Unit&) const {}
};
template <class Epi, class Sched, bool ALIGN_EPI = false, bool SP2 = false>
__device__ __forceinline__ void gemm_phase(PG8_LAS unsigned char* lds, const Gemm g, const Sched& S, const Epi& E) {
    const int tid = threadIdx.x, wid = __builtin_amdgcn_readfirstlane(tid >> 6), lane = tid & 63, wr = wid >> 2, wc = wid & 3, fr = lane & 15, fq = lane >> 4;
    const int K = g.K, nt = K / BK;
    unsigned voffA[2], voffB[2];
#pragma unroll
    for (int i = 0; i < 2; ++i) { int R, C; stage_rc(tid * 16 + i * 8192, R, C); const int Rb = Epi::PERM ? ((R & ~31) + perm32(R & 31)) : R;
        voffA[i] = (unsigned)(R * K + C) * 2u; voffB[i] = (unsigned)(Rb * K + C) * 2u; }
    const size_t kstep = (size_t)(BK * 2);
    const size_t hstep = (size_t)HALF * K * 2;
    const size_t tstep = 2 * hstep;
    const unsigned ldsw = (unsigned)wid * 1024u;
    const int aoff = lds_byte(wr * 64 + fr, fq * 8), boff = lds_byte(wc * 32 + fr, fq * 8);
#define PG8_SA(b, h) (((b) * 2 + (h)) * HTB)
#define PG8_SB(b, h) ((4 + (b) * 2 + (h)) * HTB)
#define PG8_STAGE(bufoff, gbase, voff) do { _Pragma("unroll") for (int _i = 0; _i < 2; ++_i) \
        __builtin_amdgcn_global_load_lds((const unsigned*)((const char*)(gbase) + (voff)[_i]), (PG8_LAS unsigned*)(lds + (bufoff) + ldsw + _i * 8192), 16, 0, 0); } while (0)
#define PG8_LDA(dst, b, h) do { _Pragma("unroll") for (int m = 0; m < 4; ++m) _Pragma("unroll") for (int k = 0; k < 2; ++k) dst[m][k] = *(const PG8_LAS bf16x8*)(lds + PG8_SA(b, h) + aoff + m * 2048 + k * 1024); } while (0)
#define PG8_LDB(dst, b, h) do { _Pragma("unroll") for (int n = 0; n < 2; ++n) _Pragma("unroll") for (int k = 0; k < 2; ++k) dst[n][k] = *(const PG8_LAS bf16x8*)(lds + PG8_SB(b, h) + boff + n * 2048 + k * 1024); } while (0)
#define PG8_MMA(ai, bj, At, Bt) do { __builtin_amdgcn_s_setprio(1); _Pragma("unroll") for (int m = 0; m < 4; ++m) _Pragma("unroll") for (int n = 0; n < 2; ++n) _Pragma("unroll") for (int k = 0; k < 2; ++k) \
        acc[ai][bj][m][n] = __builtin_amdgcn_mfma_f32_16x16x32_bf16(Bt[n][k], At[m][k], acc[ai][bj][m][n], 0, 0, 0); __builtin_amdgcn_s_setprio(0); } while (0)
#define PG8_WAIT_V(n) asm volatile("s_waitcnt vmcnt(" #n ")" ::: "memory")
#define PG8_WAIT_L(n) asm volatile("s_waitcnt lgkmcnt(" #n ")" ::: "memory")
#define PG8_BAR __builtin_amdgcn_s_barrier()
#define PG8_SCHED __builtin_amdgcn_sched_barrier(0)
    Unit cur, nxt; int ui = 0;
    if (!S.next(0, cur)) return;
    f32x4 acc[2][2][4][2];
#pragma unroll
    for (int a = 0; a < 2; ++a)
#pragma unroll
        for (int b = 0; b < 2; ++b)
#pragma unroll
            for (int m = 0; m < 4; ++m)
#pragma unroll
                for (int n = 0; n < 2; ++n) acc[a][b][m][n] = (f32x4){0.f, 0.f, 0.f, 0.f};
    bf16x8 At[4][2], B0[2][2], B1[2][2];
    const char* cA = (const char*)g.A + (size_t)cur.pm * tstep; const char* cB = (const char*)g.Bt + (size_t)cur.pn * tstep;
    S.a_ready(cur);
    if constexpr (SP2) {
        PG8_STAGE(PG8_SB(0, 0), cB, voffB); PG8_STAGE(PG8_SB(0, 1), cB + hstep, voffB); PG8_STAGE(PG8_SA(0, 0), cA, voffA); PG8_STAGE(PG8_SA(0, 1), cA + hstep, voffA);
        if (wr == 1) PG8_BAR;
        PG8_WAIT_V(2); PG8_BAR;
        PG8_STAGE(PG8_SB(1, 0), cB + kstep, voffB); PG8_STAGE(PG8_SA(1, 0), cA + kstep, voffA); PG8_STAGE(PG8_SB(1, 1), cB + hstep + kstep, voffB);
        PG8_WAIT_V(6); PG8_BAR;
    } else {
        PG8_STAGE(PG8_SB(0, 0), cB, voffB); PG8_STAGE(PG8_SA(0, 0), cA, voffA); PG8_STAGE(PG8_SB(0, 1), cB + hstep, voffB); PG8_STAGE(PG8_SA(0, 1), cA + hstep, voffA);
        if (wr == 1) PG8_BAR;
        PG8_WAIT_V(4); PG8_BAR;
        PG8_STAGE(PG8_SB(1, 0), cB + kstep, voffB); PG8_STAGE(PG8_SA(1, 0), cA + kstep, voffA); PG8_STAGE(PG8_SB(1, 1), cB + hstep + kstep, voffB);
        PG8_WAIT_V(6); PG8_BAR;
    }
    for (;;) {
        const bool has_next = S.next(ui + 1, nxt);
        const char* nA = has_next ? (const char*)g.A + (size_t)nxt.pm * tstep : cA; const char* nB = has_next ? (const char*)g.Bt + (size_t)nxt.pn * tstep : cB;
        for (int t = 0; t < nt; t += 2) {
            const bool last = (t == nt - 2);
            const char* a1 = cA + (size_t)(t + 1) * kstep;
            const char* a2 = last ? nA : cA + (size_t)(t + 2) * kstep; const char* b2 = last ? nB : cB + (size_t)(t + 2) * kstep;
            const char* a3 = a2 + kstep; const char* b3 = b2 + kstep;
            if (last && has_next) S.a_ready(nxt);
            if constexpr (SP2) {
            PG8_LDB(B0, 0, 0); PG8_LDB(B1, 0, 1); PG8_SCHED; PG8_LDA(At, 0, 0); PG8_STAGE(PG8_SA(1, 1), a1 + hstep, voffA);
            PG8_WAIT_V(8); PG8_WAIT_L(0); PG8_BAR; PG8_MMA(0, 0, At, B0); PG8_MMA(0, 1, At, B1); PG8_BAR; PG8_SCHED;
            PG8_LDA(At, 0, 1); PG8_STAGE(PG8_SB(0, 0), b2, voffB); PG8_STAGE(PG8_SB(0, 1), b2 + hstep, voffB); PG8_STAGE(PG8_SA(0, 0), a2, voffA);
            PG8_WAIT_V(8); PG8_WAIT_L(0); PG8_BAR; PG8_MMA(1, 0, At, B0); PG8_MMA(1, 1, At, B1); PG8_BAR; PG8_SCHED;
            PG8_LDB(B0, 1, 0); PG8_LDB(B1, 1, 1); PG8_SCHED; PG8_LDA(At, 1, 0); PG8_STAGE(PG8_SA(0, 1), a2 + hstep, voffA);
            PG8_WAIT_V(8); PG8_WAIT_L(0); PG8_BAR; PG8_MMA(0, 0, At, B0); PG8_MMA(0, 1, At, B1); PG8_BAR; PG8_SCHED;
            PG8_LDA(At, 1, 1); PG8_STAGE(PG8_SB(1, 0), b3, voffB); PG8_STAGE(PG8_SB(1, 1), b3 + hstep, voffB); PG8_STAGE(PG8_SA(1, 0), a3, voffA);
            PG8_WAIT_V(8); PG8_WAIT_L(0); PG8_BAR; PG8_MMA(1, 0, At, B0); PG8_MMA(1, 1, At, B1); PG8_BAR; PG8_SCHED;
            } else {
            PG8_LDB(B0, 0, 0); PG8_SCHED; PG8_LDA(At, 0, 0); PG8_STAGE(PG8_SA(1, 1), a1 + hstep, voffA);
            PG8_WAIT_L(8); PG8_BAR; PG8_WAIT_L(0); PG8_MMA(0, 0, At, B0); PG8_BAR; PG8_SCHED;
            PG8_LDB(B1, 0, 1); PG8_STAGE(PG8_SB(0, 0), b2, voffB);
            PG8_BAR; PG8_WAIT_L(0); PG8_MMA(0, 1, At, B1); PG8_BAR;
            PG8_LDA(At, 0, 1); PG8_STAGE(PG8_SA(0, 0), a2, voffA);
            PG8_BAR; PG8_WAIT_L(0); PG8_MMA(1, 0, At, B0); PG8_BAR; PG8_SCHED;
            PG8_STAGE(PG8_SB(0, 1), b2 + hstep, voffB);
            PG8_WAIT_V(6); PG8_BAR; PG8_MMA(1, 1, At, B1); PG8_BAR;
            PG8_LDB(B0, 1, 0); PG8_SCHED; PG8_LDA(At, 1, 0); PG8_STAGE(PG8_SA(0, 1), a2 + hstep, voffA);
            PG8_WAIT_L(8); PG8_BAR; PG8_WAIT_L(0); PG8_MMA(0, 0, At, B0); PG8_BAR; PG8_SCHED;
            PG8_LDB(B1, 1, 1); PG8_STAGE(PG8_SB(1, 0), b3, voffB);
            PG8_BAR; PG8_WAIT_L(0); PG8_MMA(0, 1, At, B1); PG8_BAR;
            PG8_LDA(At, 1, 1); PG8_STAGE(PG8_SA(1, 0), a3, voffA);
            PG8_BAR; PG8_WAIT_L(0); PG8_MMA(1, 0, At, B0); PG8_BAR; PG8_SCHED;
            PG8_STAGE(PG8_SB(1, 1), b3 + hstep, voffB);
            PG8_WAIT_V(6); PG8_BAR; PG8_MMA(1, 1, At, B1); PG8_BAR;
            }
        }
        if constexpr (ALIGN_EPI) { if (wr == 0) PG8_BAR; }
        if constexpr (!Epi::AFTER_DRAIN) { E(acc, cur, wr, wc, fr, fq); S.done(cur); }
        if (!has_next) break;
#pragma unroll
        for (int a = 0; a < 2; ++a)
#pragma unroll
            for (int b = 0; b < 2; ++b)
#pragma unroll
                for (int m = 0; m < 4; ++m)
#pragma unroll
                    for (int n = 0; n < 2; ++n) acc[a][b][m][n] = (f32x4){0.f, 0.f, 0.f, 0.f};
        cur = nxt; cA = nA; cB = nB; ++ui;
        if constexpr (ALIGN_EPI) { if (wr == 1) PG8_BAR; }
    }
    PG8_WAIT_V(0);
    if constexpr (!ALIGN_EPI) { if (wr == 0) PG8_BAR; }
    PG8_BAR;
    if constexpr (Epi::AFTER_DRAIN) { E.fused(acc, cur, wr, wc, fr, fq, lds, wid, lane); S.done(cur); }
#undef PG8_SA
#undef PG8_SB
#undef PG8_STAGE
#undef PG8_LDA
#undef PG8_LDB
#undef PG8_MMA
#undef PG8_WAIT_V
#undef PG8_WAIT_L
#undef PG8_BAR
#undef PG8_SCHED
}
}
#ifndef PG8_SP2
#define PG8_SP2 true
#endif
#ifndef PG8_ALIGN
#define PG8_ALIGN true
#endif
constexpr int NWAVES = 8;
constexpr int DM = 1024, TP = 8192, NBP = 2, MP = NBP * TP, NBS = 128, TS = 8, MS = NBS * TS, MT = MP + MS;
constexpr int DFF = 2816, NFF = 2 * DFF, NAIN = 3 * DM, NKVQ = 2816, NKV = 1536, PAST = 2048, NPAGE = 16, PAGE = 128;
constexpr int NCP = 511, NCS = 127;
constexpr float RMS_EPS = 1e-6f;
constexpr float QSCALE = 0.125f * 1.4426950408889634f;
constexpr size_t O_YP = 0, O_YS = O_YP + (size_t)MP * DM, O_CONVP = O_YS + (size_t)MS * DM, O_CONVS = O_CONVP + 2 * 2 * DM, O_CMPP = O_CONVS + (size_t)NBS * 2 * DM,
                 O_CMPS = O_CMPP + (size_t)MP * 512, O_SLCP = O_CMPS + (size_t)MS * 512, O_SLCS = O_SLCP + (size_t)MP * 512, O_WINP = O_SLCS + (size_t)MS * 512,
                 O_WINS = O_WINP + (size_t)NBP * 512 * 512, O_END = O_WINS + (size_t)NBS * 512 * 512;
static_assert(O_END == 69996544, "output size");
constexpr size_t MiB = 1u << 20;
constexpr size_t WS_CTL = 0, CTL_ZERO_BYTES = 1 * MiB;
constexpr size_t WS_WAIN = 2 * MiB, WS_WAOUT = 8 * MiB, WS_WFIN0 = 10 * MiB, WS_WFIN1 = 21 * MiB, WS_WFOUT0 = 32 * MiB, WS_WFOUT1 = 38 * MiB, WS_WKVQ = 44 * MiB, WS_WBOUT = 50 * MiB,
                 WS_W1T = 52 * MiB, WS_W2T = 53 * MiB, WS_PEB = 53 * MiB + 65536, WS_RSTD0 = 54 * MiB, WS_SSQ = 55 * MiB  , WS_GT = 60 * MiB  ,
                 WS_KCP = 64 * MiB  , WS_KCS = 65 * MiB  , WS_SELS = 82 * MiB,
                 WS_XB = 96 * MiB, WS_BB = 132 * MiB, WS_VB = 168 * MiB, WS_Z = 204 * MiB, WS_H = 240 * MiB, WS_HB = 312 * MiB, WS_ACT = 348 * MiB, WS_KVB = 444 * MiB, WS_QB = 496 * MiB, WS_O = 532 * MiB, WS_OTG = 568 * MiB  , WS_END = 600 * MiB;
static_assert(WS_XB + (size_t)MT * DM * 2 <= WS_BB && WS_H + (size_t)MT * DM * 4 <= WS_HB && WS_ACT + (size_t)MT * DFF * 2 <= WS_KVB && WS_KVB + (size_t)MT * NKV * 2 <= WS_QB && WS_O + (size_t)MT * DM * 2 <= WS_OTG, "ws map");
static_assert(WS_SSQ + 4 * (size_t)MT * 16 * 4 <= WS_GT && WS_GT + (size_t)MT * 48 * 4 <= WS_KCP && WS_KCS + (size_t)NBS * 128 * 512 * 2 <= WS_SELS, "ws map 2");
constexpr int CW_TMO = 0, CW_CODE = 1, CW_Q8 = 64, CW_Q7 = 256, CW_BAR = 4096;
constexpr int RING_OFF = 0, RING_BYTES = 155648, LDSCTL_OFF = RING_BYTES, MISC_OFF = LDSCTL_OFF + 320, LDS_BYTES = 159744;

#define GAS __attribute__((address_space(1)))
#define LAS __attribute__((address_space(3)))
typedef unsigned short bf16;
typedef unsigned v4u __attribute__((ext_vector_type(4)));
typedef unsigned v2u __attribute__((ext_vector_type(2)));
typedef float f32x4 __attribute__((ext_vector_type(4)));
typedef short bf16x8 __attribute__((ext_vector_type(8)));
typedef GAS unsigned gu32;
#define RLX_AGENT __ATOMIC_RELAXED, __HIP_MEMORY_SCOPE_AGENT
#define LDS_WAIT() asm volatile("s_waitcnt lgkmcnt(0)" ::: "memory")
#define VM_WAIT() asm volatile("s_waitcnt vmcnt(0)" ::: "memory")
__device__ __forceinline__ unsigned f2bf(float f) { unsigned u = __builtin_bit_cast(unsigned, f); return (u + 0x7fffu + ((u >> 16) & 1u)) >> 16; }
__device__ __forceinline__ unsigned pk2(float lo, float hi) { return f2bf(lo) | (f2bf(hi) << 16); }
__device__ __forceinline__ float bf2f(unsigned h) { return __builtin_bit_cast(float, h << 16); }
#define XB_TMO      128
#define XB_XCNT(j)  (256  + 64 * (j))
#define XB_XSUB(j)  (1280 + 64 * (j))
#define XB_XGEN(j)  (2304 + 64 * (j))
#define XB_TOP      3328
#define XB_TOPGEN   3392
#define XCD_BAR_WORDS 3456
#define XB_SPIN_CAP (1u << 18)

__device__ __forceinline__ unsigned xb_ld(unsigned* p)              { return __hip_atomic_load(p, __ATOMIC_RELAXED, __HIP_MEMORY_SCOPE_AGENT); }
__device__ __forceinline__ unsigned xb_add(unsigned* p, unsigned v) { return __hip_atomic_fetch_add(p, v, __ATOMIC_RELAXED, __HIP_MEMORY_SCOPE_AGENT); }
__device__ __forceinline__ unsigned xb_xcc_id() { return (unsigned)__builtin_amdgcn_s_getreg((3 << 11) | 20) & 0xFu; }
#define XB_SPIN(cond, bar) do { unsigned _sp = 0; while (cond) { __builtin_amdgcn_s_sleep(1); \
    if ((++_sp & 255u) == 0u) { if (xb_ld(&(bar)[XB_TMO])) break; if (_sp > XB_SPIN_CAP) { atomicAdd(&(bar)[XB_TMO], 1u); break; } } } } while (0)

struct XcdBarrier {
    unsigned* bar; unsigned x;
    volatile LAS unsigned* st;
};

__device__ __forceinline__ XcdBarrier xcd_barrier_post(unsigned* bar, volatile LAS unsigned* st) {
    XcdBarrier b; b.bar = bar; b.x = xb_xcc_id(); b.st = st;
    if (threadIdx.x == 0) (void)xb_add(&bar[XB_XCNT(b.x)], 1u);
    return b;
}
__device__ __forceinline__ void xcd_barrier_complete(unsigned* bar, unsigned x, unsigned& nloc, unsigned& nx) {
    const unsigned G = gridDim.x * gridDim.y * gridDim.z;
    unsigned sum, cnt, mine, sp = 0u;
    for (;;) {
        sum = 0u; cnt = 0u; mine = 0u;
#pragma unroll
        for (unsigned j = 0; j < 16; ++j) { const unsigned c = xb_ld(&bar[XB_XCNT(j)]); sum += c; cnt += (c > 0u) ? 1u : 0u; mine = (j == x) ? c : mine; }
        if (sum == G) break;
        __builtin_amdgcn_s_sleep(1);
        if ((++sp & 255u) == 0u) { if (xb_ld(&bar[XB_TMO])) break; if (sp > XB_SPIN_CAP) { atomicAdd(&bar[XB_TMO], 1u); break; } }
    }
    nloc = mine > 0u ? mine : 1u; nx = cnt > 0u ? cnt : 1u;
}

__device__ __forceinline__ void xcd_barrier(const XcdBarrier& b) {
    asm volatile("s_waitcnt vmcnt(0)" ::: "memory");
    __syncthreads();
    if (threadIdx.x == 0) {
        unsigned* bar = b.bar;
        __builtin_amdgcn_s_waitcnt(0);
        unsigned nloc = b.st[0], nx = b.st[1];
        if (nloc == 0u) { xcd_barrier_complete(bar, b.x, nloc, nx); b.st[0] = nloc; b.st[1] = nx; }
        const unsigned old = xb_add(&bar[XB_XSUB(b.x)], 1u);
        const unsigned gen = old / nloc;
        if (old + 1u == (gen + 1u) * nloc) {
            __builtin_amdgcn_fence(__ATOMIC_RELEASE, "agent");
            asm volatile("s_waitcnt vmcnt(0)" ::: "memory");
            const unsigned og = xb_add(&bar[XB_TOP], 1u);
            const unsigned tg = og / nx;
            if (og + 1u == (tg + 1u) * nx) xb_add(&bar[XB_TOPGEN], 1u);
            else XB_SPIN(xb_ld(&bar[XB_TOPGEN]) == tg, bar);
            __builtin_amdgcn_fence(__ATOMIC_ACQUIRE, "agent");
            xb_add(&bar[XB_XGEN(b.x)], 1u);
            asm volatile("s_waitcnt vmcnt(0)" ::: "memory");
        } else {
            XB_SPIN(xb_ld(&bar[XB_XGEN(b.x)]) == gen, bar);
            __builtin_amdgcn_fence(__ATOMIC_ACQUIRE, "agent");
            asm volatile("s_waitcnt vmcnt(0)" ::: "memory");
        }
    }
    __syncthreads();
}

struct Args { const float* in[21]; float* out; unsigned char* ws; int ph_lo, ph_hi; };
struct Frame {
    LAS unsigned char* lds; volatile LAS unsigned* MISC; gu32* ctl;
    int tid, lane, wave, vcu, G;
};
__device__ __forceinline__ float wave_sum(float v) {
#pragma unroll
    for (int o = 1; o < 64; o <<= 1) v += __shfl_xor(v, o);
    return v;
}
__device__ __forceinline__ void tr_item(const float* src, int ldsrc, int scol, int nvalid, const float* kscale, float cscale, bf16* dst, int K, int n0, int k0, LAS float* scr, int lane) {
    { const int c = lane & 31, kh = lane >> 5; float v[32], ks[32];
#pragma unroll
    for (int i = 0; i < 32; ++i) { v[i] = 0.f; ks[i] = 1.f; if (c < nvalid) { v[i] = src[(size_t)(k0 + 2 * i + kh) * ldsrc + scol + c]; if (kscale) ks[i] = kscale[k0 + 2 * i + kh]; } }
#pragma unroll
    for (int i = 0; i < 32; ++i) scr[(2 * i + kh) * 33 + c] = v[i] * cscale * ks[i]; }
    LDS_WAIT(); asm volatile("" ::: "memory");
    const int c = lane & 7;
#pragma unroll
    for (int j = 0; j < 4; ++j) { const int n = (lane >> 3) + 8 * j; const LAS float* s = scr + (8 * c) * 33 + n;
        v4u o; o.x = pk2(s[0 * 33], s[1 * 33]); o.y = pk2(s[2 * 33], s[3 * 33]); o.z = pk2(s[4 * 33], s[5 * 33]); o.w = pk2(s[6 * 33], s[7 * 33]);
        *(GAS v4u*)(dst + (size_t)(n0 + n) * K + k0 + 8 * c) = o; }
    LDS_WAIT(); asm volatile("" ::: "memory");
}
enum { I_XP = 0, I_XS, I_CCMP, I_CSLC, I_SWIN, I_SCONV, I_PT, I_NORMW, I_FNORMW, I_AIN, I_ACONV, I_AOUT, I_BIN, I_BOUT, I_KVNORM, I_KVW, I_PE, I_W1, I_W2, I_FIN, I_FOUT };

__device__ __forceinline__ void p0_prologue(Frame& F, const Args& A) {
    unsigned char* ws = A.ws;
    LAS float* scr = (LAS float*)(F.lds + RING_OFF + F.wave * 16384);
    const int gw = F.vcu * NWAVES + F.wave, NGW = F.G * NWAVES;
    const float* normw = A.in[I_NORMW];
    constexpr int IT_AIN = (NAIN / 32) * (DM / 64), IT_SQ = (DM / 32) * (DM / 64), IT_FIN = (NFF / 32) * (DM / 64), IT_FOUT = (DM / 32) * (DFF / 64), IT_KVQ = (NKVQ / 32) * (DM / 64),
                  IT_W1 = 2 * (64 / 32) * (2048 / 64), IT_W2 = 2 * 2;
    constexpr int NITEMS = IT_AIN + 2 * IT_SQ + 2 * IT_FIN + 2 * IT_FOUT + IT_KVQ + IT_W1 + IT_W2;
    for (int it = gw; it < NITEMS; it += NGW) {
        int r = it;
        if (r < IT_AIN) { const int ng = r / 16, kb = r % 16, n0 = ng * 32, pn = n0 >> 8, w = n0 & 255;
            const int scol = pn < 8 ? (w < 128 ? 1024 + pn * 128 + w : 2048 + pn * 128 + (w - 128)) : (pn - 8) * 256 + w;
            tr_item(A.in[I_AIN], NAIN, scol, 32, normw, 1.f, (bf16*)(ws + WS_WAIN), DM, n0, kb * 64, scr, F.lane); continue; } r -= IT_AIN;
        if (r < IT_SQ) { const int ng = r / 16, kb = r % 16; tr_item(A.in[I_AOUT], DM, ng * 32, 32, nullptr, 1.f, (bf16*)(ws + WS_WAOUT), DM, ng * 32, kb * 64, scr, F.lane); continue; } r -= IT_SQ;
        if (r < IT_SQ) { const int ng = r / 16, kb = r % 16; tr_item(A.in[I_BOUT], DM, ng * 32, 32, nullptr, 1.f, (bf16*)(ws + WS_WBOUT), DM, ng * 32, kb * 64, scr, F.lane); continue; } r -= IT_SQ;
        if (r < 2 * IT_FIN) { const int l = r / IT_FIN, q = r % IT_FIN, ng = q / 16, kb = q % 16, n0 = ng * 32, pn = n0 >> 8, w = n0 & 255;
            const int scol = w < 128 ? pn * 128 + w : DFF + pn * 128 + (w - 128);
            tr_item(A.in[I_FIN] + (size_t)l * DM * NFF, NFF, scol, 32, normw + (l * 2 + 1) * DM, 1.f, (bf16*)(ws + (l ? WS_WFIN1 : WS_WFIN0)), DM, n0, kb * 64, scr, F.lane); continue; } r -= 2 * IT_FIN;
        if (r < 2 * IT_FOUT) { const int l = r / IT_FOUT, q = r % IT_FOUT, ng = q / 44, kb = q % 44;
            tr_item(A.in[I_FOUT] + (size_t)l * DFF * DM, DM, ng * 32, 32, nullptr, 1.f, (bf16*)(ws + (l ? WS_WFOUT1 : WS_WFOUT0)), DFF, ng * 32, kb * 64, scr, F.lane); continue; } r -= 2 * IT_FOUT;
        if (r < IT_KVQ) { const int ng = r / 16, kb = r % 16, n0 = ng * 32; bf16* dst = (bf16*)(ws + WS_WKVQ);
            if (n0 < NKV) tr_item(A.in[I_KVW], NKV, n0, 32, A.in[I_KVNORM], 1.f, dst, DM, n0, kb * 64, scr, F.lane);
            else if (n0 < NKV + 1024) tr_item(A.in[I_BIN], 1072, n0 - NKV, 32, normw + 2 * DM, QSCALE, dst, DM, n0, kb * 64, scr, F.lane);
            else { const int g0 = n0 - (NKV + 1024); const int nv = g0 >= 48 ? 0 : (48 - g0 < 32 ? 48 - g0 : 32);
                tr_item(A.in[I_BIN], 1072, 1024 + (nv ? g0 : 0), nv, normw + 2 * DM, 1.f, dst, DM, n0, kb * 64, scr, F.lane); }
            continue; } r -= IT_KVQ;
        if (r < IT_W1) { const int k = r / 64, q = r % 64, ng = q / 32, kb = q % 32;
            tr_item(A.in[I_W1] + (size_t)k * 2048 * 64, 64, ng * 32, 32, nullptr, 1.f, (bf16*)(ws + WS_W1T) + (size_t)k * 64 * 2048, 2048, ng * 32, kb * 64, scr, F.lane); continue; } r -= IT_W1;
        { const int k = r / 2, ng = r % 2;
            tr_item(A.in[I_W2] + (size_t)k * 64 * 64, 64, ng * 32, 32, nullptr, 1.f, (bf16*)(ws + WS_W2T) + (size_t)k * 64 * 64, 64, ng * 32, 0, scr, F.lane); }
    }
    for (int o = gw; o < 128; o += NGW) { const int k = o >> 6, h = o & 63; const float* pe = A.in[I_PE] + (size_t)k * 2048; const float* w1 = A.in[I_W1] + (size_t)k * 2048 * 64 + h;
        float s = 0.f; for (int i = F.lane; i < 2048; i += 64) s += pe[i] * w1[(size_t)i * 64];
        s = wave_sum(s); if (F.lane == 0) ((float*)(ws + WS_PEB))[o] = s; }
    for (int m0 = 2 * gw; m0 < MT; m0 += 2 * NGW) {
        f32x4 v[2][4]; float s[2];
#pragma unroll
        for (int r = 0; r < 2; ++r) { const int m = m0 + r; const float* xrow = m < MP ? A.in[I_XP] + (size_t)m * DM : A.in[I_XS] + (size_t)(m - MP) * DM;
            const GAS f32x4* xr = (const GAS f32x4*)xrow + F.lane;
#pragma unroll
            for (int j = 0; j < 4; ++j) v[r][j] = xr[64 * j]; }
#pragma unroll
        for (int r = 0; r < 2; ++r) { const int m = m0 + r; s[r] = 0.f;
#pragma unroll
            for (int j = 0; j < 4; ++j) s[r] += (v[r][j].x * v[r][j].x + v[r][j].y * v[r][j].y) + (v[r][j].z * v[r][j].z + v[r][j].w * v[r][j].w);
            s[r] = wave_sum(s[r]);
            GAS v2u* o8 = (GAS v2u*)((bf16*)(ws + WS_XB) + (size_t)m * DM) + F.lane;
#pragma unroll
            for (int j = 0; j < 4; ++j) { v2u wv; wv.x = pk2(v[r][j].x, v[r][j].y); wv.y = pk2(v[r][j].z, v[r][j].w); o8[64 * j] = wv; }
            if (F.lane == 0) ((float*)(ws + WS_RSTD0))[m] = __builtin_amdgcn_rsqf(s[r] * (1.0f / DM) + RMS_EPS); }
    }
}
__device__ __forceinline__ void p_wincopy(Frame& F, const Args& A, int cu_lo, int cu_cnt) {
    const int cu = (int)blockIdx.x - cu_lo; if (cu < 0 || cu >= cu_cnt) return;
    const GAS f32x4* src = (const GAS f32x4*)A.in[I_SWIN]; GAS f32x4* dst = (GAS f32x4*)(A.out + O_WINS);
    const size_t per = (size_t)504 * 128, total = (size_t)NBS * per; const size_t gt = (size_t)cu * 512 + F.tid, GT_ = (size_t)cu_cnt * 512;
    for (size_t i = gt; i < total; i += 4 * GT_) { f32x4 v[4];
#pragma unroll
        for (int j = 0; j < 4; ++j) { const size_t ii = i + j * GT_; if (ii < total) { const size_t n = ii / per, rem = ii % per; v[j] = __builtin_nontemporal_load(src + n * (512 * 128) + 8 * 128 + rem); } }
#pragma unroll
        for (int j = 0; j < 4; ++j) { const size_t ii = i + j * GT_; if (ii < total) { const size_t n = ii / per, rem = ii % per; __builtin_nontemporal_store(v[j], dst + n * (512 * 128) + rem); } } }
}
__device__ __forceinline__ void p2_conv(Frame& F, const Args& A, int row_lo, int row_hi, int cu_lo, int cu_cnt) {
    unsigned char* ws = A.ws; const bf16* VB = (const bf16*)(ws + WS_VB); const bf16* BB = (const bf16*)(ws + WS_BB); bf16* Z = (bf16*)(ws + WS_Z);
    const float* cw = A.in[I_ACONV]; const float* sc = A.in[I_SCONV];
    const int cu = (int)blockIdx.x - cu_lo; if (cu < 0 || cu >= cu_cnt) return;
    const size_t gt = (size_t)cu * 512 + F.tid, GT_ = (size_t)cu_cnt * 512, total = (size_t)(row_hi - row_lo) * 128;
    const int c8 = (int)(gt & 127) * 8;
    float cw0[8], cw1[8], cw2[8];
#pragma unroll
    for (int e = 0; e < 8; ++e) { cw0[e] = cw[c8 + e]; cw1[e] = cw[DM + c8 + e]; cw2[e] = cw[2 * DM + c8 + e]; }
    for (size_t i = gt; i < total; i += GT_) {
        const int row = row_lo + (int)(i >> 7); int t, tlen; const float* pre = nullptr;
        if (row < MP) { t = row & (TP - 1); tlen = TP; } else { const int rs = row - MP; t = rs & 7; tlen = TS; pre = sc + (size_t)(rs >> 3) * 2 * DM; }
        const v4u vb = *(const GAS v4u*)(BB + (size_t)row * DM + c8), v2 = *(const GAS v4u*)(VB + (size_t)row * DM + c8);
        float f1[8], f0[8];
        if (t >= 1) { const v4u q = *(const GAS v4u*)(VB + (size_t)(row - 1) * DM + c8);
#pragma unroll
            for (int e = 0; e < 4; ++e) { f1[2 * e] = bf2f(q[e] & 0xffffu); f1[2 * e + 1] = bf2f(q[e] >> 16); } }
        else {
#pragma unroll
            for (int e = 0; e < 8; ++e) f1[e] = pre ? pre[DM + c8 + e] : 0.f; }
        if (t >= 2) { const v4u q = *(const GAS v4u*)(VB + (size_t)(row - 2) * DM + c8);
#pragma unroll
            for (int e = 0; e < 4; ++e) { f0[2 * e] = bf2f(q[e] & 0xffffu); f0[2 * e + 1] = bf2f(q[e] >> 16); } }
        else {
#pragma unroll
            for (int e = 0; e < 8; ++e) f0[e] = pre ? pre[(size_t)t * DM + c8 + e] : 0.f; }
        float z[8], vv[8];
#pragma unroll
        for (int e = 0; e < 4; ++e) { vv[2 * e] = bf2f(v2[e] & 0xffffu); vv[2 * e + 1] = bf2f(v2[e] >> 16); }
#pragma unroll
        for (int e = 0; e < 8; ++e) { const float b = bf2f((vb[e >> 1] >> ((e & 1) * 16)) & 0xffffu);
            z[e] = b * (cw0[e] * f0[e] + cw1[e] * f1[e] + cw2[e] * vv[e]); }
        v4u o; o.x = pk2(z[0], z[1]); o.y = pk2(z[2], z[3]); o.z = pk2(z[4], z[5]); o.w = pk2(z[6], z[7]);
        *(GAS v4u*)(Z + (size_t)row * DM + c8) = o;
        if (t >= tlen - 2) { float* dst = row < MP ? A.out + O_CONVP + ((size_t)(row >> 13) * 2 + (t - (tlen - 2))) * DM + c8
                                                  : A.out + O_CONVS + ((size_t)((row - MP) >> 3) * 2 + (t - (tlen - 2))) * DM + c8;
#pragma unroll
            for (int e = 0; e < 8; ++e) dst[e] = vv[e]; }
    }
}
__device__ __forceinline__ void p_final(Frame& F, const Args& A, int row_lo, int row_hi, int cu_lo, int cu_cnt) {
    const bf16* HB = (const bf16*)(A.ws + WS_HB); const GAS f32x4* fw = (const GAS f32x4*)A.in[I_FNORMW];
    const int cu = (int)blockIdx.x - cu_lo; if (cu < 0 || cu >= cu_cnt) return;
    const int gw = cu * NWAVES + F.wave, NGW = cu_cnt * NWAVES;
    f32x4 w[4];
#pragma unroll
    for (int j = 0; j < 4; ++j) w[j] = fw[4 * F.lane + j];
    for (int m = row_lo + gw; m < row_hi; m += NGW) {
        const GAS v4u* xr = (const GAS v4u*)(HB + (size_t)m * DM) + 2 * F.lane; const v4u a = xr[0], b = xr[1]; f32x4 v[4]; float s = 0.f;
        v[0] = (f32x4){bf2f(a.x & 0xffffu), bf2f(a.x >> 16), bf2f(a.y & 0xffffu), bf2f(a.y >> 16)}; v[1] = (f32x4){bf2f(a.z & 0xffffu), bf2f(a.z >> 16), bf2f(a.w & 0xffffu), bf2f(a.w >> 16)};
        v[2] = (f32x4){bf2f(b.x & 0xffffu), bf2f(b.x >> 16), bf2f(b.y & 0xffffu), bf2f(b.y >> 16)}; v[3] = (f32x4){bf2f(b.z & 0xffffu), bf2f(b.z >> 16), bf2f(b.w & 0xffffu), bf2f(b.w >> 16)};
#pragma unroll
        for (int j = 0; j < 4; ++j) s += (v[j].x * v[j].x + v[j].y * v[j].y) + (v[j].z * v[j].z + v[j].w * v[j].w);
        const float r = __builtin_amdgcn_rsqf(wave_sum(s) * (1.0f / DM) + RMS_EPS);
        GAS f32x4* o = (GAS f32x4*)(A.out + (m < MP ? O_YP + (size_t)m * DM : O_YS + (size_t)(m - MP) * DM)) + 4 * F.lane;
#pragma unroll
        for (int j = 0; j < 4; ++j) o[j] = v[j] * r * w[j];
    }
}
__device__ __forceinline__ void p_zero16(Frame& F, void* p, size_t bytes) {
    GAS v4u* d = (GAS v4u*)p; const size_t n = bytes / 16, gt = (size_t)F.vcu * 512 + F.tid, GT_ = (size_t)F.G * 512;
    for (size_t i = gt; i < n; i += GT_) d[i] = (v4u){0u, 0u, 0u, 0u};
}
constexpr int P7_IMG_BYTES = 144 * 512, P7_HID = 2 * P7_IMG_BYTES, P7_HID_STRIDE = 144;
static_assert(P7_HID + 32 * P7_HID_STRIDE <= RING_BYTES, "compress LDS");
__device__ __forceinline__ int p7_swz(int pos_l, int g, int dchunk) { return pos_l * 512 + g * 128 + ((dchunk ^ ((pos_l >> 4) & 3) ^ ((g >> 1) << 2)) << 4); }
struct P7Unit { int isp, seq, seg; };
__device__ __forceinline__ bool p7_unit(int i, int cu2, int ncu2, P7Unit& U) {
    if (i == 0) { if (cu2 >= NBP * 64) return false; U.isp = 1; U.seq = cu2 >> 6; U.seg = cu2 & 63; return true; }
    const int v = (i - 1) * ncu2 + cu2; if (v >= NBS * NPAGE) return false; U.isp = 0; U.seq = v >> 4; U.seg = v & 15; return true;
}
struct P7Batch { f32x4 a[3], b[3]; };
template <int C0, int NCH> __device__ __forceinline__ void p7_load(P7Batch& R, const P7Unit& U, int k, const Args& A, int tid) {
    asm volatile("" : "+v"(tid));
    const int pos0 = U.seg * 128;
    if (U.isp) { const bf16* KVB = (const bf16*)(A.ws + WS_KVB);
#pragma unroll
        for (int i = 0; i < NCH; ++i) { const int c = tid + (C0 + i) * 512, pos_l = c >> 5, g = (c >> 3) & 3, dc = c & 7, pos = pos0 + pos_l; v4u r = (v4u){0u, 0u, 0u, 0u};
            if (pos < TP) r = *(const GAS v4u*)(KVB + ((size_t)U.seq * TP + pos) * NKV + k * 256 + g * 64 + dc * 8);
            R.a[i] = __builtin_bit_cast(f32x4, r); }
    } else { const int* ptab = (const int*)A.in[I_PT]; const float* cache = A.in[I_CCMP];
        const int pgA = ptab[U.seq * NPAGE + U.seg], pgB = U.seg < 15 ? ptab[U.seq * NPAGE + U.seg + 1] : 0;
#pragma unroll
        for (int i = 0; i < NCH; ++i) { const int c = tid + (C0 + i) * 512, pos_l = c >> 5, g = (c >> 3) & 3, dc = c & 7, pos = pos0 + pos_l;
            R.a[i] = (f32x4){0.f, 0.f, 0.f, 0.f}; R.b[i] = R.a[i];
            if (pos < PAST) { const float* s = cache + ((size_t)(pos_l < 128 ? pgA : pgB) * PAGE + (pos_l & 127)) * 512 + k * 256 + g * 64 + dc * 8; R.a[i] = *(const GAS f32x4*)s; R.b[i] = *(const GAS f32x4*)(s + 4); } }
    }
}
template <int C0, int NCH> __device__ __forceinline__ void p7_store(const P7Batch& R, const P7Unit& U, LAS unsigned char* img, int tid) {
    asm volatile("" : "+v"(tid));
#pragma unroll
    for (int i = 0; i < NCH; ++i) { const int c = tid + (C0 + i) * 512, pos_l = c >> 5, g = (c >> 3) & 3, dc = c & 7; v4u o;
        if (U.isp) o = __builtin_bit_cast(v4u, R.a[i]);
        else { o.x = pg8::cvt_pk_bf16(R.a[i][0], R.a[i][1]); o.y = pg8::cvt_pk_bf16(R.a[i][2], R.a[i][3]); o.z = pg8::cvt_pk_bf16(R.b[i][0], R.b[i][1]); o.w = pg8::cvt_pk_bf16(R.b[i][2], R.b[i][3]); }
        *(LAS v4u*)(img + p7_swz(pos_l, g, dc)) = o; }
}
__device__ __forceinline__ void p7_compress(Frame& F, const Args& A, int mode, int budget) {
    unsigned char* ws = A.ws; LAS unsigned char* L = F.lds + RING_OFF; LAS unsigned char* hidp = L + P7_HID;
    const bf16* W1T = (const bf16*)(ws + WS_W1T); const bf16* W2T = (const bf16*)(ws + WS_W2T); const float* PEB = (const float*)(ws + WS_PEB);
    const int lane = F.lane, w = F.wave, tid = F.tid, l15 = lane & 15, lq = lane >> 4;
    const int k = F.vcu & 1, cu2 = F.vcu >> 1, ncu2 = (F.G + 1 - k) >> 1;
    constexpr int NTK = NBS * NPAGE;
    unsigned* qctr = (unsigned*)(F.ctl + CW_Q7 + 64 * k);
    P7Unit U, Un; P7Batch R; bool have; int tnext = NTK, tnext2 = NTK;
    if (mode == 0) { have = p7_unit(0, cu2, ncu2, U); }
    else {
        if (budget <= 0) return;
        const unsigned n0 = budget >= 3 ? 3u : (unsigned)budget;
        if (tid == 0) F.MISC[17] = __hip_atomic_fetch_add(qctr, n0, __ATOMIC_RELAXED, __HIP_MEMORY_SCOPE_AGENT);
        __syncthreads();
        const int t0 = (int)F.MISC[17];
        __syncthreads();
        have = t0 < NTK; U.isp = 0; U.seq = t0 >> 4; U.seg = t0 & 15;
        if (n0 >= 2 && t0 + 1 < NTK) tnext = t0 + 1;
        if (n0 >= 3 && t0 + 2 < NTK) tnext2 = t0 + 2;
    }
    if (!have) return;
    bf16x8 bw[8][4];
#pragma unroll
    for (int kl = 0; kl < 8; ++kl)
#pragma unroll
        for (int nt = 0; nt < 4; ++nt) bw[kl][nt] = *(const GAS bf16x8*)(W1T + ((size_t)(k * 64 + nt * 16 + l15)) * 2048 + (8 * w + kl) * 32 + lq * 8);
    p7_load<0, 3>(R, U, k, A, tid); p7_store<0, 3>(R, U, L, tid); p7_load<3, 3>(R, U, k, A, tid); p7_store<3, 3>(R, U, L, tid); p7_load<6, 3>(R, U, k, A, tid); p7_store<6, 3>(R, U, L, tid);
    __syncthreads();
    int buf = 0, nrun = 0;
    while (have) {
        LAS unsigned char* img = L + buf * P7_IMG_BYTES; LAS unsigned char* nimg = L + (buf ^ 1) * P7_IMG_BYTES; LAS float* red = (LAS float*)img;
        const bool hn = tnext < NTK; Un.isp = 0; Un.seq = tnext >> 4; Un.seg = tnext & 15;
        const bool want3 = mode == 1 && tnext2 < NTK && nrun + 3 < budget; unsigned tk = 0u;
        if (want3 && tid == 0) tk = __hip_atomic_fetch_add(qctr, 1u, __ATOMIC_RELAXED, __HIP_MEMORY_SCOPE_AGENT);
        const int ntok = (U.isp ? U.seg == 63 : U.seg == 15) ? 7 : 8;
        f32x4 acc[2][4];
#pragma unroll
        for (int a = 0; a < 2; ++a)
#pragma unroll
            for (int b = 0; b < 4; ++b) acc[a][b] = (f32x4){0.f, 0.f, 0.f, 0.f};
        if (hn) p7_load<0, 3>(R, Un, k, A, tid);
#pragma unroll
        for (int kl = 0; kl < 8; ++kl) { const int ks = 8 * w + kl, j = ks >> 1, dh = ks & 1; bf16x8 afr[2];
            if (kl == 3 && hn) { p7_store<0, 3>(R, Un, nimg, tid); p7_load<3, 3>(R, Un, k, A, tid); }
            if (kl == 6 && hn) { p7_store<3, 3>(R, Un, nimg, tid); p7_load<6, 3>(R, Un, k, A, tid); }
#pragma unroll
            for (int mt = 0; mt < 2; ++mt) { const int tok = mt * 4 + (l15 >> 2), g = l15 & 3, pos_l = 16 * tok + j; afr[mt] = *(const LAS bf16x8*)(img + p7_swz(pos_l, g, dh * 4 + lq)); }
#pragma unroll
            for (int mt = 0; mt < 2; ++mt)
#pragma unroll
                for (int nt = 0; nt < 4; ++nt) acc[mt][nt] = __builtin_amdgcn_mfma_f32_16x16x32_bf16(afr[mt], bw[kl][nt], acc[mt][nt], 0, 0, 0);
        }
        if (hn) p7_store<6, 3>(R, Un, nimg, tid);
        __syncthreads();
#pragma unroll
        for (int mt = 0; mt < 2; ++mt)
#pragma unroll
            for (int nt = 0; nt < 4; ++nt)
#pragma unroll
                for (int rg = 0; rg < 4; ++rg) red[(w * 32 + mt * 16 + 4 * lq + rg) * 64 + nt * 16 + l15] = acc[mt][nt][rg];
        if (want3 && tid == 0) F.MISC[17] = tk;
        __syncthreads();
        { const int row = tid >> 4, col = (tid & 15) * 4; f32x4 s = *(const LAS f32x4*)(red + row * 64 + col);
#pragma unroll
            for (int ww = 1; ww < 8; ++ww) s += *(const LAS f32x4*)(red + (ww * 32 + row) * 64 + col);
            const f32x4 pb = *(const GAS f32x4*)(PEB + k * 64 + col); float h[4];
#pragma unroll
            for (int e = 0; e < 4; ++e) { const float x = s[e] + pb[e]; h[e] = x * __builtin_amdgcn_rcpf(1.0f + __builtin_amdgcn_exp2f(x * -1.4426950408889634f)); }
            v2u o; o.x = pg8::cvt_pk_bf16(h[0], h[1]); o.y = pg8::cvt_pk_bf16(h[2], h[3]); *(LAS v2u*)(hidp + row * P7_HID_STRIDE + col * 2) = o; }
        const int t3 = want3 ? (int)F.MISC[17] : NTK;
        __syncthreads();
        { const int mt = w >> 2, nt = w & 3; f32x4 a2 = (f32x4){0.f, 0.f, 0.f, 0.f};
#pragma unroll
            for (int k2 = 0; k2 < 2; ++k2) { const bf16x8 af = *(const LAS bf16x8*)(hidp + (mt * 16 + l15) * P7_HID_STRIDE + k2 * 64 + lq * 16);
                const bf16x8 bf = *(const GAS bf16x8*)(W2T + ((size_t)(k * 64 + nt * 16 + l15)) * 64 + k2 * 32 + lq * 8);
                a2 = __builtin_amdgcn_mfma_f32_16x16x32_bf16(af, bf, a2, 0, 0, 0); }
            const int tok = mt * 4 + lq; bf16* kc = U.isp ? (bf16*)(ws + WS_KCP) + (((size_t)U.seq * 512 + U.seg * 8 + tok) * 2 + k) * 256 : (bf16*)(ws + WS_KCS) + (((size_t)U.seq * 128 + U.seg * 8 + tok) * 2 + k) * 256;
#pragma unroll
            for (int rg = 0; rg < 4; ++rg) kc[rg * 64 + nt * 16 + l15] = (bf16)(tok < ntok ? f2bf(a2[rg]) : 0u); }
        U = Un; have = hn; tnext = tnext2; tnext2 = t3 < NTK ? t3 : NTK; ++nrun; buf ^= 1;
    }
    __syncthreads();
}
constexpr int KT_STRIDE = 144, VT_STRIDE = 160;
constexpr float S_NEG = -1.0e30f, M_INIT = -1000.0f, RESC_THR = 8.0f;
typedef short s16x4 __attribute__((ext_vector_type(4)));
struct AttState { float m[2], l[2]; f32x4 o[2][4]; f32x4 lo[2]; };
__device__ __forceinline__ void att_init(AttState& st) {
#pragma unroll
    for (int c = 0; c < 2; ++c) { st.m[c] = M_INIT; st.l[c] = 0.f; st.lo[c] = (f32x4){0.f, 0.f, 0.f, 0.f};
#pragma unroll
        for (int d = 0; d < 4; ++d) st.o[c][d] = (f32x4){0.f, 0.f, 0.f, 0.f}; }
}
__device__ __forceinline__ s16x4 tr_read(const LAS unsigned char* p) { return __builtin_bit_cast(s16x4, __builtin_amdgcn_ds_read_tr16_b64_v4i16((LAS s16x4*)p)); }
template <int NKT, int MODE>
__device__ __forceinline__ void wave_block(const LAS unsigned char* kt, const LAS unsigned char* vt, const bf16x8 (&qf)[2][2], AttState& st, const float (&bias)[2], const bool (&act)[2],
                                           bool boundary, const int (&lo)[2], const int (&hi)[2], int lane, LAS float* imp_row0, int imp_blk0, int imp_stride) {
    const int l15 = lane & 15, lq = lane >> 4;
    if (!act[0] && !act[1]) return;
    bf16x8 kf[NKT][2];
#pragma unroll
    for (int t = 0; t < NKT; ++t)
#pragma unroll
        for (int ks = 0; ks < 2; ++ks) kf[t][ks] = *(const LAS bf16x8*)(kt + (t * 16 + l15) * KT_STRIDE + ks * 64 + lq * 16);
    bf16x8 pfr[2][NKT / 2];
#pragma unroll
    for (int c = 0; c < 2; ++c) {
        if (!act[c]) continue;
        const float c0 = bias[c] - st.m[c];
        f32x4 s[NKT];
#pragma unroll
        for (int t = 0; t < NKT; ++t) { s[t] = (f32x4){c0, c0, c0, c0};
            s[t] = __builtin_amdgcn_mfma_f32_16x16x32_bf16(kf[t][0], qf[c][0], s[t], 0, 0, 0);
            s[t] = __builtin_amdgcn_mfma_f32_16x16x32_bf16(kf[t][1], qf[c][1], s[t], 0, 0, 0); }
        if (boundary) { const int l2 = lo[c] - 4 * lq, h2 = hi[c] - 4 * lq;
#pragma unroll
            for (int t = 0; t < NKT; ++t)
#pragma unroll
                for (int r = 0; r < 4; ++r) { const int kk = t * 16 + r; if (kk < l2 || kk > h2) s[t][r] = S_NEG; } }
        float mx = s[0][0];
#pragma unroll
        for (int t = 0; t < NKT; ++t)
#pragma unroll
            for (int r = 0; r < 4; ++r) mx = fmaxf(mx, s[t][r]);
        mx = fmaxf(mx, __shfl_xor(mx, 16)); mx = fmaxf(mx, __shfl_xor(mx, 32));
        if (MODE == 1) {
            const float dl = fmaxf(mx, 0.f), f = __builtin_amdgcn_exp2f(-dl); st.m[c] += dl; float a = 0.f;
#pragma unroll
            for (int t = 0; t < NKT; ++t)
#pragma unroll
                for (int r = 0; r < 4; ++r) a += __builtin_amdgcn_exp2f(s[t][r] - dl);
            st.l[c] = st.l[c] * f + a;
            continue;
        }
        if (MODE == 0) {
            if (__any(mx > RESC_THR)) {
                const float dl = fmaxf(mx, 0.f), f = __builtin_amdgcn_exp2f(-dl); st.m[c] += dl; st.l[c] *= f;
#pragma unroll
                for (int t = 0; t < NKT; ++t) s[t] = s[t] - dl;
#pragma unroll
                for (int r = 0; r < 4; ++r) { const float fr = __shfl(f, 4 * lq + r);
#pragma unroll
                    for (int dt = 0; dt < 4; ++dt) st.o[c][dt][r] *= fr; }
            }
        }
        float a = 0.f;
#pragma unroll
        for (int t = 0; t < NKT; ++t)
#pragma unroll
            for (int r = 0; r < 4; ++r) { s[t][r] = __builtin_amdgcn_exp2f(s[t][r]); a += s[t][r]; }
        if (MODE == 0) st.l[c] += a;
        if (MODE == 2) {
            const float li = st.l[c];
#pragma unroll
            for (int t = 0; t < NKT; ++t) { s[t] = s[t] * li;
                float ia = 2.f * (s[t][0] + s[t][1] + s[t][2]) + s[t][3], ib = s[t][3];
                ia += __shfl_xor(ia, 1); ia += __shfl_xor(ia, 2); ib += __shfl_xor(ib, 1); ib += __shfl_xor(ib, 2);
                if ((l15 & 3) == 0) { LAS float* ir = imp_row0 + (c * 4 + (l15 >> 2)) * imp_stride + imp_blk0 + 4 * t + lq; atomicAdd((float*)ir, ia); atomicAdd((float*)(ir + 1), ib); } }
        }
#pragma unroll
        for (int G = 0; G < NKT / 2; ++G) {
            v4u pw; pw.x = pg8::cvt_pk_bf16(s[2 * G][0], s[2 * G][1]); pw.y = pg8::cvt_pk_bf16(s[2 * G][2], s[2 * G][3]); pw.z = pg8::cvt_pk_bf16(s[2 * G + 1][0], s[2 * G + 1][1]); pw.w = pg8::cvt_pk_bf16(s[2 * G + 1][2], s[2 * G + 1][3]);
            pfr[c][G] = __builtin_bit_cast(bf16x8, pw); }
    }
    if (MODE == 1) return;
    asm volatile("" ::: "memory");
    const LAS unsigned char* vb = vt + (4 * lq + (l15 >> 2)) * VT_STRIDE + (l15 & 3) * 8;
#pragma unroll
    for (int G = 0; G < NKT / 2; ++G) {
        bf16x8 vf[4];
#pragma unroll
        for (int dt = 0; dt < 4; ++dt) { const s16x4 a = tr_read(vb + (32 * G) * VT_STRIDE + dt * 32), b = tr_read(vb + (32 * G + 16) * VT_STRIDE + dt * 32);
            vf[dt] = (bf16x8){a[0], a[1], a[2], a[3], b[0], b[1], b[2], b[3]}; }
#pragma unroll
        for (int c = 0; c < 2; ++c) { if (!act[c]) continue;
#pragma unroll
            for (int dt = 0; dt < 4; ++dt) st.o[c][dt] = __builtin_amdgcn_mfma_f32_16x16x32_bf16(pfr[c][G], vf[dt], st.o[c][dt], 0, 0, 0); }
        asm volatile("" ::: "memory");
    }
}
__device__ __forceinline__ void att_finish(const AttState& st, int c, int lane, float (&linv)[4]) {
    float l = st.l[c]; l += __shfl_xor(l, 16); l += __shfl_xor(l, 32);
    const float li = 1.0f / fmaxf(l, 1e-30f);
#pragma unroll
    for (int r = 0; r < 4; ++r) linv[r] = __shfl(li, 4 * (lane >> 4) + r);
}
__device__ __forceinline__ void select_blocks(float v0, float v1, int cur, int lane, unsigned long long& sel0, unsigned long long& sel1) {
    const unsigned k0 = __float_as_uint(v0), k1 = __float_as_uint(v1);
    const bool e0 = lane >= 1 && lane <= cur - 2, e1 = (lane + 64) <= cur - 2;
    const int nforced = cur >= 2 ? 3 : cur + 1, need = 16 - nforced, nelig = cur - 2 > 0 ? cur - 2 : 0;
    unsigned long long s0 = 1ull, s1 = 0ull;
    if (cur < 64) s0 |= 1ull << cur; else s1 |= 1ull << (cur - 64);
    if (cur >= 1) { if (cur - 1 < 64) s0 |= 1ull << (cur - 1); else s1 |= 1ull << (cur - 65); }
    if (nelig <= need) { s0 |= __ballot(e0); s1 |= __ballot(e1); }
    else {
        unsigned T = 0u;
        for (int bit = 30; bit >= 0; --bit) { const unsigned cand = T | (1u << bit);
            const int cnt = __popcll(__ballot(e0 && k0 >= cand)) + __popcll(__ballot(e1 && k1 >= cand));
            if (cnt >= need) T = cand; }
        const unsigned long long g0 = __ballot(e0 && k0 > T), g1 = __ballot(e1 && k1 > T);
        unsigned long long q0 = __ballot(e0 && k0 == T), q1 = __ballot(e1 && k1 == T);
        int rem = need - (__popcll(g0) + __popcll(g1));
        s0 |= g0; s1 |= g1;
        while (rem > 0 && (q0 | q1)) { if (q0) { const unsigned long long b = q0 & (~q0 + 1ull); s0 |= b; q0 ^= b; } else { const unsigned long long b = q1 & (~q1 + 1ull); s1 |= b; q1 ^= b; } --rem; }
    }
    sel0 = s0; sel1 = s1;
}

__device__ __forceinline__ void select_blocks4(const float (&v0)[4], const float (&v1)[4], int cur, int lane, unsigned long long (&sel0)[4], unsigned long long (&sel1)[4]) {
    const bool e0 = lane >= 1 && lane <= cur - 2, e1 = (lane + 64) <= cur - 2;
    const int nforced = cur >= 2 ? 3 : cur + 1, need = 16 - nforced, nelig = cur - 2 > 0 ? cur - 2 : 0;
    unsigned long long f0 = 1ull, f1 = 0ull;
    if (cur < 64) f0 |= 1ull << cur; else f1 |= 1ull << (cur - 64);
    if (cur >= 1) { if (cur - 1 < 64) f0 |= 1ull << (cur - 1); else f1 |= 1ull << (cur - 65); }
    if (nelig <= need) { const unsigned long long a = f0 | __ballot(e0), b = f1 | __ballot(e1);
#pragma unroll
        for (int t = 0; t < 4; ++t) { sel0[t] = a; sel1[t] = b; }
        return; }
    unsigned k0[4], k1[4], T[4];
#pragma unroll
    for (int t = 0; t < 4; ++t) { k0[t] = __float_as_uint(v0[t]); k1[t] = __float_as_uint(v1[t]); T[t] = 0u; }
    for (int bit = 30; bit >= 0; --bit) {
#pragma unroll
        for (int t = 0; t < 4; ++t) { const unsigned cand = T[t] | (1u << bit);
            const int cnt = __popcll(__ballot(e0 && k0[t] >= cand)) + __popcll(__ballot(e1 && k1[t] >= cand));
            if (cnt >= need) T[t] = cand; } }
#pragma unroll
    for (int t = 0; t < 4; ++t) {
        const unsigned long long g0 = __ballot(e0 && k0[t] > T[t]), g1 = __ballot(e1 && k1[t] > T[t]);
        unsigned long long q0 = __ballot(e0 && k0[t] == T[t]), q1 = __ballot(e1 && k1[t] == T[t]);
        int rem = need - (__popcll(g0) + __popcll(g1)); unsigned long long s0 = f0 | g0, s1 = f1 | g1;
        while (rem > 0 && (q0 | q1)) { if (q0) { const unsigned long long b = q0 & (~q0 + 1ull); s0 |= b; q0 ^= b; } else { const unsigned long long b = q1 & (~q1 + 1ull); s1 |= b; q1 ^= b; } --rem; }
        sel0[t] = s0; sel1[t] = s1; }
}
__device__ __forceinline__ unsigned pick4(const unsigned (&a)[4], int i) { return i == 0 ? a[0] : i == 1 ? a[1] : i == 2 ? a[2] : a[3]; }
constexpr int P8_GB = 65536, P8_SELB = 2 * P8_GB, P8_IMP = P8_GB  , P8_END = P8_SELB + 64 * 16;
static_assert(P8_END <= RING_BYTES && 64 * 132 * 4 <= P8_GB, "attention LDS");
__device__ __forceinline__ float amax3(float a, float b, float c) { float r; asm("v_max3_f32 %0, %1, %2, %3" : "=v"(r) : "v"(a), "v"(b), "v"(c)); return r; }
__device__ __forceinline__ float amax2(float a, float b) { float r; asm("v_max_f32_e32 %0, %1, %2" : "=v"(r) : "v"(a), "v"(b)); return r; }
__device__ __forceinline__ float rowmax4(float x) {
    auto r = __builtin_amdgcn_permlane16_swap(__float_as_uint(x), __float_as_uint(x), false, false); x = amax2(__uint_as_float(r[0]), __uint_as_float(r[1]));
    auto q = __builtin_amdgcn_permlane32_swap(__float_as_uint(x), __float_as_uint(x), false, false); return amax2(__uint_as_float(q[0]), __uint_as_float(q[1]));
}
__device__ __forceinline__ float rowsum4(float x) {
    auto r = __builtin_amdgcn_permlane16_swap(__float_as_uint(x), __float_as_uint(x), false, false); x = __uint_as_float(r[0]) + __uint_as_float(r[1]);
    auto q = __builtin_amdgcn_permlane32_swap(__float_as_uint(x), __float_as_uint(x), false, false); return __uint_as_float(q[0]) + __uint_as_float(q[1]);
}
__device__ __forceinline__ float quad_sum(float x) {
    x += __builtin_bit_cast(float, __builtin_amdgcn_mov_dpp(__builtin_bit_cast(int, x), 0xB1, 0xF, 0xF, true));
    x += __builtin_bit_cast(float, __builtin_amdgcn_mov_dpp(__builtin_bit_cast(int, x), 0x4E, 0xF, 0xF, true));
    return x;
}
struct TileAddr { int kofs[2]; int vofs[4]; };
__device__ __forceinline__ void tile_addr(TileAddr& T, int lane) {
    const int l15 = lane & 15, lq = lane >> 4, qp = l15 >> 2, p = l15 & 3, r7 = ((lq & 1) << 2) | qp;
#pragma unroll
    for (int ks = 0; ks < 2; ++ks) T.kofs[ks] = l15 * 128 + (((ks * 4 + lq) ^ (l15 & 7)) << 4);
#pragma unroll
    for (int dt = 0; dt < 4; ++dt) T.vofs[dt] = (4 * lq + qp) * 128 + (((dt * 2 + (p >> 1)) ^ r7) << 4) + (p & 1) * 8;
}
template <int MODE>
__device__ __forceinline__ void wave_block2(const LAS unsigned char* kt, const LAS unsigned char* vt, const TileAddr& T, const bf16x8 (&qf)[2][2], AttState& st, const float (&bias)[2], const bool (&act)[2],
                                            bool boundary, const int (&lo)[2], const int (&hi)[2], int lane, LAS float* imp_row0, int imp_blk0, int imp_stride) {
    const int l15 = lane & 15, lq = lane >> 4;
    if (!act[0] && !act[1]) return;
    bf16x8 kf[4][2];
#pragma unroll
    for (int t = 0; t < 4; ++t)
#pragma unroll
        for (int ks = 0; ks < 2; ++ks) kf[t][ks] = *(const LAS bf16x8*)(kt + t * 2048 + T.kofs[ks]);
    f32x4 s[2][4];
#pragma unroll
    for (int c = 0; c < 2; ++c) { if (!act[c]) continue;
        const float c0 = bias[c] - st.m[c];
#pragma unroll
        for (int t = 0; t < 4; ++t) { s[c][t] = (f32x4){c0, c0, c0, c0};
            s[c][t] = __builtin_amdgcn_mfma_f32_16x16x32_bf16(kf[t][0], qf[c][0], s[c][t], 0, 0, 0);
            s[c][t] = __builtin_amdgcn_mfma_f32_16x16x32_bf16(kf[t][1], qf[c][1], s[c][t], 0, 0, 0); } }
    bf16x8 vf[2][4];
    if (MODE != 1) {
#pragma unroll
        for (int G = 0; G < 2; ++G)
#pragma unroll
            for (int dt = 0; dt < 4; ++dt) { const s16x4 a = tr_read(vt + G * 4096 + T.vofs[dt]), b = tr_read(vt + G * 4096 + 2048 + T.vofs[dt]);
                vf[G][dt] = (bf16x8){a[0], a[1], a[2], a[3], b[0], b[1], b[2], b[3]}; }
    }
    bf16x8 pfr[2][2];
#pragma unroll
    for (int c = 0; c < 2; ++c) {
        if (!act[c]) continue;
        if (boundary) { const int l2 = lo[c] - 4 * lq, h2 = hi[c] - 4 * lq;
#pragma unroll
            for (int t = 0; t < 4; ++t)
#pragma unroll
                for (int r = 0; r < 4; ++r) { const int kk = t * 16 + r; if (kk < l2 || kk > h2) s[c][t][r] = S_NEG; } }
        float mx = amax3(s[c][0][0], s[c][0][1], s[c][0][2]);
        mx = amax3(mx, s[c][0][3], s[c][1][0]); mx = amax3(mx, s[c][1][1], s[c][1][2]); mx = amax3(mx, s[c][1][3], s[c][2][0]); mx = amax3(mx, s[c][2][1], s[c][2][2]);
        mx = amax3(mx, s[c][2][3], s[c][3][0]); mx = amax3(mx, s[c][3][1], s[c][3][2]); mx = amax2(mx, s[c][3][3]);
        mx = rowmax4(mx);
        if (MODE == 1) {
            const float dl = fmaxf(mx, 0.f), f = __builtin_amdgcn_exp2f(-dl); st.m[c] += dl; float a = 0.f;
#pragma unroll
            for (int t = 0; t < 4; ++t)
#pragma unroll
                for (int r = 0; r < 4; ++r) a += __builtin_amdgcn_exp2f(s[c][t][r] - dl);
            st.l[c] = st.l[c] * f + a;
            continue;
        }
        if (MODE == 0) {
            if (__any(mx > RESC_THR)) {
                const float dl = fmaxf(mx, 0.f), f = __builtin_amdgcn_exp2f(-dl); st.m[c] += dl;
#pragma unroll
                for (int t = 0; t < 4; ++t) s[c][t] = s[c][t] - dl;
#pragma unroll
                for (int r = 0; r < 4; ++r) { const float fr = __shfl(f, 4 * lq + r); st.lo[c][r] *= fr;
#pragma unroll
                    for (int dt = 0; dt < 4; ++dt) st.o[c][dt][r] *= fr; }
            }
        }
#pragma unroll
        for (int t = 0; t < 4; ++t)
#pragma unroll
            for (int r = 0; r < 4; ++r) s[c][t][r] = __builtin_amdgcn_exp2f(s[c][t][r]);
        if (MODE == 2) {
            const float li = st.l[c];
#pragma unroll
            for (int t = 0; t < 4; ++t) { s[c][t] = s[c][t] * li;
                float ia = 2.f * (s[c][t][0] + s[c][t][1] + s[c][t][2]) + s[c][t][3], ib = s[c][t][3];
                ia = quad_sum(ia); ib = quad_sum(ib);
                if ((l15 & 3) == 0) { LAS float* ir = imp_row0 + (c * 4 + (l15 >> 2)) * imp_stride + imp_blk0 + 4 * t + lq; atomicAdd((float*)ir, ia); atomicAdd((float*)(ir + 1), ib); } }
        }
#pragma unroll
        for (int G = 0; G < 2; ++G) {
            v4u pw; pw.x = pg8::cvt_pk_bf16(s[c][2 * G][0], s[c][2 * G][1]); pw.y = pg8::cvt_pk_bf16(s[c][2 * G][2], s[c][2 * G][3]); pw.z = pg8::cvt_pk_bf16(s[c][2 * G + 1][0], s[c][2 * G + 1][1]); pw.w = pg8::cvt_pk_bf16(s[c][2 * G + 1][2], s[c][2 * G + 1][3]);
            pfr[c][G] = __builtin_bit_cast(bf16x8, pw); }
    }
    if (MODE == 1) return;
#pragma unroll
    for (int G = 0; G < 2; ++G)
#pragma unroll
        for (int c = 0; c < 2; ++c) { if (!act[c]) continue;
#pragma unroll
            for (int dt = 0; dt < 4; ++dt) st.o[c][dt] = __builtin_amdgcn_mfma_f32_16x16x32_bf16(pfr[c][G], vf[G][dt], st.o[c][dt], 0, 0, 0);
            if (MODE == 0) { const v4u ow = (v4u){0x3f803f80u, 0x3f803f80u, 0x3f803f80u, 0x3f803f80u};
                st.lo[c] = __builtin_amdgcn_mfma_f32_16x16x32_bf16(pfr[c][G], __builtin_bit_cast(bf16x8, ow), st.lo[c], 0, 0, 0); } }
}
__device__ __forceinline__ void glds16(const void* gsrc, unsigned lds_dst) { unsigned keep;
    asm volatile("s_mov_b32 %0, m0\n\ts_mov_b32 m0, %2\n\ts_nop 0\n\tglobal_load_lds_dwordx4 %1, off\n\ts_mov_b32 m0, %0" : "=&s"(keep) : "v"(gsrc), "s"(lds_dst) : "memory"); }
__device__ __forceinline__ void p8_dma_group(const bf16* kbase, const bf16* vbase, size_t row_stride, int blk0, int nblk, LAS unsigned char* gb, int w, int lane) {
    asm volatile("" : "+v"(lane));
    const size_t loff = (size_t)(8 * w + (lane >> 3)) * row_stride + (((lane & 7) ^ (lane >> 3)) << 3);
#pragma unroll
    for (int i = 0; i < 4; ++i) { const int blk = blk0 + (i < nblk ? i : nblk - 1); const size_t boff = (size_t)blk * 64 * row_stride + loff;
        glds16(kbase + boff, (unsigned)__builtin_amdgcn_readfirstlane((unsigned)(uintptr_t)(gb + i * 16384 + w * 1024)));
        glds16(vbase + boff, (unsigned)__builtin_amdgcn_readfirstlane((unsigned)(uintptr_t)(gb + i * 16384 + 8192 + w * 1024))); }
}
#define P8_WAITV(n) asm volatile("s_waitcnt vmcnt(" #n ")" ::: "memory")
#define P8_BARRIER() do { asm volatile("s_waitcnt lgkmcnt(0)" ::: "memory"); __builtin_amdgcn_s_barrier(); asm volatile("" ::: "memory"); } while (0)

__device__ __forceinline__ void p8_prompt_unit(Frame& F, const Args& A, int b, int qb, int g) {
    unsigned char* ws = A.ws; const bf16* KVB = (const bf16*)(ws + WS_KVB); const bf16* QB = (const bf16*)(ws + WS_QB); const bf16* KCP = (const bf16*)(ws + WS_KCP);
    const float* GT = (const float*)(ws + WS_GT); bf16* O = (bf16*)(ws + WS_O);
    LAS unsigned char* L = F.lds + RING_OFF; LAS float* IMP = (LAS float*)(L + P8_IMP); LAS unsigned* SELB = (LAS unsigned*)(L + P8_SELB);
    const int lane = F.lane, w = F.wave, l15 = lane & 15, lq = lane >> 4;
    const size_t rowbase = (size_t)b * TP + (size_t)qb * 64;
    float* OTG = (float*)(ws + WS_OTG) + ((size_t)F.vcu * NWAVES + w) * 2048 + lane;
    TileAddr T; tile_addr(T, lane);
    bf16x8 qf[2][2];
#pragma unroll
    for (int c = 0; c < 2; ++c)
#pragma unroll
        for (int ks = 0; ks < 2; ++ks) qf[c][ks] = *(const GAS bf16x8*)(QB + (rowbase + 8 * w + 4 * c + (l15 >> 2)) * DM + g * 256 + (l15 & 3) * 64 + ks * 32 + lq * 8);
    int tl[2]; tl[0] = 8 * w + (l15 >> 2); tl[1] = tl[0] + 4;
    for (int i = lane; i < 8 * 132; i += 64) IMP[w * 8 * 132 + i] = 0.f;
    AttState st; const float zb[2] = {0.f, 0.f}; const bool on[2] = {true, true};
    auto combine = [&](int br) {
#pragma unroll
        for (int c = 0; c < 2; ++c) { float linv[4];
            if (br == 0) {
#pragma unroll
                for (int r = 0; r < 4; ++r) linv[r] = 1.f; }
            else {
#pragma unroll
                for (int r = 0; r < 4; ++r) linv[r] = 1.0f / fmaxf(st.lo[c][r], 1e-30f); }
#pragma unroll
            for (int r = 0; r < 4; ++r) { const float gt = GT[(rowbase + 8 * w + 4 * c + lq) * 48 + g * 12 + r * 3 + br] * linv[r];
#pragma unroll
                for (int d = 0; d < 4; ++d) { float* p = OTG + ((c * 4 + d) * 4 + r) * 64; const float v = gt * st.o[c][d][r];
                    if (br == 0) *p = v; else if (br == 1) *p += v;
                    else O[(rowbase + 8 * w + 4 * c + lq) * DM + g * 256 + r * 64 + d * 16 + l15] = (bf16)f2bf(*p + v); } } }
    };
    const int ncv = 4 * qb + 3, ncb = (ncv + 63) >> 6, ncg = (ncb + 3) >> 2;
    const bf16* kc0 = KCP + (size_t)b * 512 * 512 + g * 64;
    int clo[2] = {0, 0}, chi[2];
    att_init(st);
    const int imin = (qb * 64 - 31) >> 4;
    {
        { int ln = lane; asm volatile("" : "+v"(ln)); const size_t loff = (size_t)(8 * w + (ln >> 3)) * 512 + (((ln & 7) ^ (ln >> 3)) << 3);
          for (int i = 0; i < ncb; ++i) glds16(kc0 + (size_t)i * 64 * 512 + loff, (unsigned)__builtin_amdgcn_readfirstlane((unsigned)(uintptr_t)(L + i * 8192 + w * 1024))); }
        P8_WAITV(0); P8_BARRIER();
        for (int blk = 0; blk < ncb; ++blk) {
#pragma unroll
            for (int c = 0; c < 2; ++c) chi[c] = ((qb * 64 + tl[c] - 31) >> 4) - 64 * blk;
            wave_block2<1>(L + blk * 8192, L, T, qf, st, zb, on, 64 * blk + 63 > imin, clo, chi, lane, nullptr, 0, 0); }
        P8_BARRIER();
    }
#pragma unroll
    for (int c = 0; c < 2; ++c) st.l[c] = 1.0f / fmaxf(rowsum4(st.l[c]), 1e-30f);
    for (int gi = 0; gi < ncg; ++gi) {
        const int nb = ncb - 4 * gi < 4 ? ncb - 4 * gi : 4;
        p8_dma_group(kc0, kc0 + 256, 512, 4 * gi, nb, L, w, lane);
        P8_WAITV(0); P8_BARRIER();
        for (int i = 0; i < nb; ++i) { const int blk = 4 * gi + i;
#pragma unroll
            for (int c = 0; c < 2; ++c) chi[c] = ((qb * 64 + tl[c] - 31) >> 4) - 64 * blk;
            wave_block2<2>(L + i * 16384, L + i * 16384 + 8192, T, qf, st, zb, on, 64 * blk + 63 > imin, clo, chi, lane, IMP + w * 8 * 132, blk * 16, 132); }
        P8_BARRIER();
    }
    combine(0);
    LDS_WAIT();
    for (int h4 = 0; h4 < 2; ++h4) { float v0[4], v1[4]; unsigned long long s0[4], s1[4];
#pragma unroll
        for (int t = 0; t < 4; ++t) { const LAS float* ir = IMP + (w * 8 + h4 * 4 + t) * 132; v0[t] = ir[lane]; v1[t] = ir[lane + 64]; }
        select_blocks4(v0, v1, qb, lane, s0, s1);
#pragma unroll
        for (int t = 0; t < 4; ++t) if (lane == 0) { LAS unsigned* sb = SELB + (w * 8 + h4 * 4 + t) * 4; sb[0] = (unsigned)s0[t]; sb[1] = (unsigned)(s0[t] >> 32); sb[2] = (unsigned)s1[t]; sb[3] = (unsigned)(s1[t] >> 32); } }
    LDS_WAIT();
    unsigned mysel[2][4], usel[2][4];
#pragma unroll
    for (int c = 0; c < 2; ++c)
#pragma unroll
        for (int i = 0; i < 4; ++i) { mysel[c][i] = SELB[tl[c] * 4 + i];
            usel[c][i] = __builtin_amdgcn_readfirstlane(SELB[(8 * w + 4 * c + 0) * 4 + i] | SELB[(8 * w + 4 * c + 1) * 4 + i] | SELB[(8 * w + 4 * c + 2) * 4 + i] | SELB[(8 * w + 4 * c + 3) * 4 + i]); }
    P8_BARRIER();
    {
        att_init(st);
        const bf16* k0 = KVB + (size_t)b * TP * NKV + 512 + g * 64; int lo2[2] = {0, 0}, hi2[2] = {tl[0], tl[1]};
        const int nblk = qb + 1, ng = (nblk + 3) >> 2;
        p8_dma_group(k0, k0 + 256, NKV, 0, nblk < 4 ? nblk : 4, L, w, lane);
        for (int gi = 0; gi < ng; ++gi) {
            LAS unsigned char* gb = L + (gi & 1) * P8_GB;
            if (gi + 1 < ng) { const int n2 = nblk - 4 * (gi + 1); p8_dma_group(k0, k0 + 256, NKV, 4 * (gi + 1), n2 < 4 ? n2 : 4, L + ((gi + 1) & 1) * P8_GB, w, lane); P8_WAITV(8); }
            else P8_WAITV(0);
            P8_BARRIER();
            const int nb = nblk - 4 * gi < 4 ? nblk - 4 * gi : 4;
            for (int i = 0; i < nb; ++i) { const int jb = 4 * gi + i; float bias[2]; bool act[2];
#pragma unroll
                for (int c = 0; c < 2; ++c) { bias[c] = ((pick4(mysel[c], jb >> 5) >> (jb & 31)) & 1u) ? 0.f : S_NEG; act[c] = ((pick4(usel[c], jb >> 5) >> (jb & 31)) & 1u) != 0u; }
                wave_block2<0>(gb + i * 16384, gb + i * 16384 + 8192, T, qf, st, bias, act, jb == qb, lo2, hi2, lane, nullptr, 0, 0); }
            P8_BARRIER();
        }
        combine(1);
    }
    {
        att_init(st);
        const int jb0 = qb >= 8 ? qb - 8 : 0, nblk = qb - jb0 + 1, ng = (nblk + 3) >> 2;
        const bf16* k0 = KVB + ((size_t)b * TP + (size_t)jb0 * 64) * NKV + 1024 + g * 64;
        p8_dma_group(k0, k0 + 256, NKV, 0, nblk < 4 ? nblk : 4, L, w, lane);
        for (int gi = 0; gi < ng; ++gi) {
            LAS unsigned char* gb = L + (gi & 1) * P8_GB;
            if (gi + 1 < ng) { const int n2 = nblk - 4 * (gi + 1); p8_dma_group(k0, k0 + 256, NKV, 4 * (gi + 1), n2 < 4 ? n2 : 4, L + ((gi + 1) & 1) * P8_GB, w, lane); P8_WAITV(8); }
            else P8_WAITV(0);
            P8_BARRIER();
            const int nb = nblk - 4 * gi < 4 ? nblk - 4 * gi : 4;
            for (int i = 0; i < nb; ++i) { const int jb = jb0 + 4 * gi + i; int lo2[2], hi2[2]; const bool low = (qb >= 8 && jb == qb - 8), top = (jb == qb);
#pragma unroll
                for (int c = 0; c < 2; ++c) { lo2[c] = low ? tl[c] : 0; hi2[c] = top ? tl[c] : 63; }
                wave_block2<0>(gb + i * 16384, gb + i * 16384 + 8192, T, qf, st, zb, on, low || top, lo2, hi2, lane, nullptr, 0, 0); }
            P8_BARRIER();
        }
        combine(2);
    }
}
constexpr int P8S_WAVE = 11008, P8S_KT = 0, P8S_VT = 32 * KT_STRIDE, P8S_IMP = P8S_VT + 32 * VT_STRIDE, P8S_OL = 8 * P8S_WAVE, P8S_ML = P8S_OL + 8 * 8192, P8S_END = P8S_ML + 8 * 256;
static_assert(P8S_IMP + 8 * 40 * 4 <= P8S_WAVE && P8S_END <= RING_BYTES, "sample attention LDS");
struct P8sRegs { f32x4 k[8], v[8]; };
__device__ __forceinline__ void p8s_load_f32(P8sRegs& R, const float* kp, const float* vp, int lane) {
    asm volatile("" : "+v"(lane)); const int r0 = lane >> 4, ch = lane & 15;
#pragma unroll
    for (int i = 0; i < 8; ++i) { R.k[i] = *(const GAS f32x4*)(kp + (size_t)(4 * i + r0) * 512 + ch * 4); R.v[i] = *(const GAS f32x4*)(vp + (size_t)(4 * i + r0) * 512 + ch * 4); }
}
__device__ __forceinline__ void p8s_store_f32(const P8sRegs& R, LAS unsigned char* kt, LAS unsigned char* vt, int lane) {
    asm volatile("" : "+v"(lane)); const int r0 = lane >> 4, ch = lane & 15;
#pragma unroll
    for (int i = 0; i < 8; ++i) { v2u a, b; a.x = pg8::cvt_pk_bf16(R.k[i][0], R.k[i][1]); a.y = pg8::cvt_pk_bf16(R.k[i][2], R.k[i][3]); b.x = pg8::cvt_pk_bf16(R.v[i][0], R.v[i][1]); b.y = pg8::cvt_pk_bf16(R.v[i][2], R.v[i][3]);
        *(LAS v2u*)(kt + (4 * i + r0) * KT_STRIDE + ch * 8) = a; *(LAS v2u*)(vt + (4 * i + r0) * VT_STRIDE + ch * 8) = b; }
}
__device__ __forceinline__ void p8s_stage_bf16(const bf16* kp, const bf16* vp, size_t stride, int nrows, LAS unsigned char* kt, LAS unsigned char* vt, int lane) {
    asm volatile("" : "+v"(lane));
    v4u rk[4], rv[4]; const int r0 = lane >> 3, ch = lane & 7;
#pragma unroll
    for (int i = 0; i < 4; ++i) { const int row = 8 * i + r0; rk[i] = (v4u){0u, 0u, 0u, 0u}; rv[i] = rk[i];
        if (row < nrows) { rk[i] = *(const GAS v4u*)(kp + (size_t)row * stride + ch * 8); rv[i] = *(const GAS v4u*)(vp + (size_t)row * stride + ch * 8); } }
#pragma unroll
    for (int i = 0; i < 4; ++i) { const int row = 8 * i + r0; *(LAS v4u*)(kt + row * KT_STRIDE + ch * 16) = rk[i]; *(LAS v4u*)(vt + row * VT_STRIDE + ch * 16) = rv[i]; }
}
__device__ __forceinline__ void p8_sample_pair(Frame& F, const Args& A, int u, bool valid) {
    unsigned char* ws = A.ws; const bf16* KVB = (const bf16*)(ws + WS_KVB); const bf16* QB = (const bf16*)(ws + WS_QB); const bf16* KCS = (const bf16*)(ws + WS_KCS);
    const float* GT = (const float*)(ws + WS_GT); bf16* O = (bf16*)(ws + WS_O); const int* ptab = (const int*)A.in[I_PT];
    const int n = u >> 2, g = u & 3, sp = F.wave & 3, q0 = F.wave & 4;
    LAS unsigned char* L = F.lds + RING_OFF + F.wave * P8S_WAVE; LAS unsigned char* kt = L + P8S_KT; LAS unsigned char* vt = L + P8S_VT; LAS float* IMP = (LAS float*)(L + P8S_IMP);
    LAS float* OL = (LAS float*)(F.lds + RING_OFF + P8S_OL); LAS float* ML = (LAS float*)(F.lds + RING_OFF + P8S_ML);
    const int lane = F.lane, l15 = lane & 15, lq = lane >> 4;
    const size_t rowbase = (size_t)MP + (size_t)n * TS;
    bf16x8 qf[2][2];
#pragma unroll
    for (int c = 0; c < 2; ++c)
#pragma unroll
        for (int ks = 0; ks < 2; ++ks) qf[c][ks] = *(const GAS bf16x8*)(QB + (rowbase + 4 * c + (l15 >> 2)) * DM + g * 256 + (l15 & 3) * 64 + ks * 32 + lq * 8);
    int tl[2]; tl[0] = l15 >> 2; tl[1] = tl[0] + 4;
    for (int i = lane; i < 8 * 40; i += 64) IMP[i] = 0.f;
    AttState st; const float zb[2] = {0.f, 0.f}; const bool on[2] = {true, true};
    f32x4 fin[2];
    auto publish = [&]() {
#pragma unroll
        for (int c = 0; c < 2; ++c) { float l = st.l[c]; l += __shfl_xor(l, 16); l += __shfl_xor(l, 32);
            if (lq == 0) { ML[((F.wave * 2 + c) * 16 + l15) * 2] = st.m[c]; ML[((F.wave * 2 + c) * 16 + l15) * 2 + 1] = l; }
#pragma unroll
            for (int d = 0; d < 4; ++d)
#pragma unroll
                for (int r = 0; r < 4; ++r) OL[(F.wave * 32 + (c * 4 + d) * 4 + r) * 64 + lane] = st.o[c][d][r]; }
    };
    auto merge = [&](int br) {
#pragma unroll
        for (int k = 0; k < 2; ++k) { const int p = 2 * sp + k, c = p >> 2, d = p & 3;
#pragma unroll
            for (int r = 0; r < 4; ++r) { const int qrow = 4 * lq + r; float mi[4], li[4], M = -3.0e38f;
#pragma unroll
                for (int i = 0; i < 4; ++i) { mi[i] = ML[(((q0 + i) * 2 + c) * 16 + qrow) * 2]; li[i] = ML[(((q0 + i) * 2 + c) * 16 + qrow) * 2 + 1]; M = fmaxf(M, mi[i]); }
                float Ls = 0.f, Os = 0.f;
#pragma unroll
                for (int i = 0; i < 4; ++i) { const float wgt = __builtin_amdgcn_exp2f(mi[i] - M); Ls += wgt * li[i]; Os += wgt * OL[((q0 + i) * 32 + (c * 4 + d) * 4 + r) * 64 + lane]; }
                const float gt = GT[(rowbase + 4 * c + lq) * 48 + g * 12 + r * 3 + br];
                fin[k][r] += gt * Os / fmaxf(Ls, 1e-30f); } }
    };
#define WSYNC() do { LDS_WAIT(); asm volatile("" ::: "memory"); } while (0)
    if (valid) {
    const bf16* kc0 = KCS + (size_t)n * 128 * 512 + g * 64;
    int clo[2] = {0, 0}, chi[2];
    att_init(st);
    for (int pass = 0; pass < 2; ++pass) {
        if (pass == 1) {
#pragma unroll
            for (int c = 0; c < 2; ++c) { float l = st.l[c]; l += __shfl_xor(l, 16); l += __shfl_xor(l, 32); st.l[c] = 1.0f / fmaxf(l, 1e-30f); } }
        for (int hb = 0; hb < 4; ++hb) {
            WSYNC(); p8s_stage_bf16(kc0 + (size_t)hb * 32 * 512, kc0 + (size_t)hb * 32 * 512 + 256, 512, 32, kt, vt, lane); WSYNC();
            chi[0] = 126 - 32 * hb; chi[1] = chi[0];
            if (pass == 0) wave_block<2, 1>(kt, vt, qf, st, zb, on, hb == 3, clo, chi, lane, nullptr, 0, 0);
            else           wave_block<2, 2>(kt, vt, qf, st, zb, on, hb == 3, clo, chi, lane, IMP, hb * 8, 40);
        }
    }
#pragma unroll
    for (int c = 0; c < 2; ++c)
#pragma unroll
        for (int d = 0; d < 4; ++d)
#pragma unroll
            for (int r = 0; r < 4; ++r) OL[(F.wave * 32 + (c * 4 + d) * 4 + r) * 64 + lane] = st.o[c][d][r];
    WSYNC();
#pragma unroll
    for (int k = 0; k < 2; ++k) { const int p = 2 * sp + k, c = p >> 2, d = p & 3;
#pragma unroll
        for (int r = 0; r < 4; ++r) fin[k][r] = GT[(rowbase + 4 * c + lq) * 48 + g * 12 + r * 3 + 0] * OL[(F.wave * 32 + (c * 4 + d) * 4 + r) * 64 + lane]; }
    }
    unsigned mysel[2][2] = {{0u, 0u}, {0u, 0u}};
    if (valid) {
    WSYNC();
    unsigned selw[8][2];
#pragma unroll
    for (int t8 = 0; t8 < 8; ++t8) { unsigned long long s0, s1; const float v0 = lane < 33 ? IMP[t8 * 40 + lane] : 0.f; select_blocks(v0, 0.f, 32, lane, s0, s1); selw[t8][0] = (unsigned)s0; selw[t8][1] = (unsigned)(s0 >> 32); }
#pragma unroll
    for (int c = 0; c < 2; ++c)
#pragma unroll
        for (int i = 0; i < 2; ++i) { const int tt = l15 >> 2; const unsigned a0 = selw[4 * c + 0][i], a1 = selw[4 * c + 1][i], a2 = selw[4 * c + 2][i], a3 = selw[4 * c + 3][i];
            mysel[c][i] = tt == 0 ? a0 : tt == 1 ? a1 : tt == 2 ? a2 : a3; }
    }
    __syncthreads();
    if (valid) {
        att_init(st);
        const float* cache = A.in[I_CSLC]; int lo2[2] = {0, 0}, hi2[2] = {tl[0], tl[1]};
        P8sRegs R;
        { const int pg = ptab[n * NPAGE + (sp >> 2)]; const float* kp = cache + ((size_t)pg * PAGE + (sp & 3) * 32) * 512 + g * 64; p8s_load_f32(R, kp, kp + 256, lane); }
        for (int hb = sp; hb < 64; hb += 4) {
            WSYNC(); p8s_store_f32(R, kt, vt, lane);
            if (hb + 4 < 64) { const int h2 = hb + 4, pg = ptab[n * NPAGE + (h2 >> 2)]; const float* kp = cache + ((size_t)pg * PAGE + (h2 & 3) * 32) * 512 + g * 64; p8s_load_f32(R, kp, kp + 256, lane); }
            WSYNC();
            const int jb = hb >> 1; float bias[2];
#pragma unroll
            for (int c = 0; c < 2; ++c) bias[c] = (((jb < 32 ? mysel[c][0] : mysel[c][1]) >> (jb & 31)) & 1u) ? 0.f : S_NEG;
            wave_block<2, 0>(kt, vt, qf, st, bias, on, false, lo2, hi2, lane, nullptr, 0, 0);
        }
        if (sp == 0) {
            WSYNC(); { const bf16* kp = KVB + rowbase * NKV + 512 + g * 64; p8s_stage_bf16(kp, kp + 256, NKV, 8, kt, vt, lane); } WSYNC();
            wave_block<2, 0>(kt, vt, qf, st, zb, on, true, lo2, hi2, lane, nullptr, 0, 0);
        }
        publish();
    }
    __syncthreads();
    if (valid) merge(1);
    __syncthreads();
    if (valid) {
        att_init(st);
        const float* sw = A.in[I_SWIN] + (size_t)n * 512 * 512 + g * 64;
        P8sRegs R;
        p8s_load_f32(R, sw + (size_t)sp * 32 * 512, sw + (size_t)sp * 32 * 512 + 256, lane);
        for (int hb = sp; hb < 16; hb += 4) {
            WSYNC(); p8s_store_f32(R, kt, vt, lane);
            if (hb + 4 < 16) p8s_load_f32(R, sw + (size_t)(hb + 4) * 32 * 512, sw + (size_t)(hb + 4) * 32 * 512 + 256, lane);
            WSYNC();
            int lo2[2], hi2[2];
#pragma unroll
            for (int c = 0; c < 2; ++c) { lo2[c] = tl[c] - 32 * hb; hi2[c] = 512 + tl[c] - 32 * hb; }
            wave_block<2, 0>(kt, vt, qf, st, zb, on, hb == 0, lo2, hi2, lane, nullptr, 0, 0);
        }
        if (sp == 0) {
            WSYNC(); { const bf16* kp = KVB + rowbase * NKV + 1024 + g * 64; p8s_stage_bf16(kp, kp + 256, NKV, 8, kt, vt, lane); } WSYNC();
            int lo2[2], hi2[2];
#pragma unroll
            for (int c = 0; c < 2; ++c) { lo2[c] = tl[c] - 512; hi2[c] = tl[c]; }
            wave_block<2, 0>(kt, vt, qf, st, zb, on, true, lo2, hi2, lane, nullptr, 0, 0);
        }
        publish();
    }
    __syncthreads();
    if (valid) { merge(2);
#pragma unroll
        for (int k = 0; k < 2; ++k) { const int p = 2 * sp + k, c = p >> 2, d = p & 3;
#pragma unroll
            for (int r = 0; r < 4; ++r) O[(rowbase + 4 * c + lq) * DM + g * 256 + r * 64 + d * 16 + l15] = (bf16)f2bf(fin[k][r]); } }
    __syncthreads();
#undef WSYNC
}
__device__ __forceinline__ void p8_attention(Frame& F, const Args& A) {
    for (int ub = 2 * F.vcu; ub < NBS * 4; ub += 2 * F.G) { const int u = ub + (F.wave >> 2); p8_sample_pair(F, A, u < NBS * 4 ? u : 0, u < NBS * 4); }
    __syncthreads();
    for (;;) {
        if (F.tid == 0) F.MISC[16] = __hip_atomic_fetch_add((unsigned*)(F.ctl + CW_Q8), 1u, __ATOMIC_RELAXED, __HIP_MEMORY_SCOPE_AGENT);
        __syncthreads();
        const int u = (int)F.MISC[16];
        __syncthreads();
        if (u >= NBP * 128 * 4) break;
        const int qb = 127 - (u >> 3), b = (u >> 2) & 1, g = u & 3; p8_prompt_unit(F, A, b, qb, g);
    }
}
constexpr int N_PHASES = 15;
__global__ void __launch_bounds__(NWAVES * 64, 2) yoco_fwd(Args args) {
    extern __shared__ __attribute__((aligned(16))) unsigned char lds[];
    Frame F;
    F.lds = (LAS unsigned char*)lds; F.MISC = (volatile LAS unsigned*)(F.lds + MISC_OFF);
    F.tid = threadIdx.x; F.lane = F.tid & 63; F.wave = __builtin_amdgcn_readfirstlane(F.tid >> 6);
    F.G = gridDim.x; { const int bx = blockIdx.x; F.vcu = (F.G % 8 == 0) ? (bx % 8) * (F.G / 8) + bx / 8 : bx; }
    unsigned char* ws = args.ws;
    F.ctl = (gu32*)(ws + WS_CTL);
    for (int u = F.tid; u < (LDS_BYTES - LDSCTL_OFF) / 4; u += NWAVES * 64) ((LAS unsigned*)(F.lds + LDSCTL_OFF))[u] = 0u;
    __syncthreads();
    const int lo = args.ph_lo, hi = args.ph_hi;
    const bool multi = (hi - lo) > 1;
    XcdBarrier bar; bar.bar = (unsigned*)(F.ctl + CW_BAR); bar.x = 0; bar.st = nullptr;
    if (multi) bar = xcd_barrier_post((unsigned*)(F.ctl + CW_BAR), F.MISC + 8);
#define IN(k) (lo <= (k) && (k) < hi)
#define SEAM(k) do { if (IN(k) && IN((k) + 1)) xcd_barrier(bar); } while (0)
    bf16* const XB = (bf16*)(ws + WS_XB); bf16* const BBp = (bf16*)(ws + WS_BB); bf16* const VBp = (bf16*)(ws + WS_VB); bf16* const Zp = (bf16*)(ws + WS_Z);
    float* const Hp = (float*)(ws + WS_H); bf16* const HBp = (bf16*)(ws + WS_HB); bf16* const ACTp = (bf16*)(ws + WS_ACT); bf16* const KVBp = (bf16*)(ws + WS_KVB);
    bf16* const QBp = (bf16*)(ws + WS_QB); bf16* const Op = (bf16*)(ws + WS_O); float* const GTp = (float*)(ws + WS_GT);
    float* const SSQ = (float*)(ws + WS_SSQ); constexpr size_t SSQ_STRIDE = (size_t)MT * 16;
    const int c = (int)blockIdx.x;

    const bf16* const WAIN = (const bf16*)(ws + WS_WAIN); const bf16* const WAOUT = (const bf16*)(ws + WS_WAOUT); const bf16* const WKVQ = (const bf16*)(ws + WS_WKVQ); const bf16* const WBOUT = (const bf16*)(ws + WS_WBOUT);
    float* const SSQ0 = SSQ, * const SSQ1 = SSQ + SSQ_STRIDE, * const SSQ2 = SSQ + 2 * SSQ_STRIDE;
#define GEMM(EPI, E, SCH, S, Ap, Wp, N_, K_) pg8::gemm_phase<pg8::EPI, pg8::SCH, PG8_ALIGN, PG8_SP2>(F.lds + RING_OFF, pg8::Gemm{Ap, Wp, MT, N_, K_}, S, E)
    if (IN(0)) { p0_prologue(F, args); }
    SEAM(0);
    if (IN(1)) { pg8::StaticOrder S; S.init(MP, NAIN, F.G, c); pg8::EpiAin E{VBp, BBp, (const float*)(ws + WS_RSTD0)}; GEMM(EpiAin, E, StaticOrder, S, XB, WAIN, NAIN, DM); }
    SEAM(1);
    if (IN(2)) { if (c < 48) { pg8::SubOrder S; S.init(64, 4, 12, 48, c); pg8::EpiAin E{VBp, BBp, (const float*)(ws + WS_RSTD0)}; GEMM(EpiAin, E, SubOrder, S, XB, WAIN, NAIN, DM); }
                 else p2_conv(F, args, 0, MP, 48, F.G - 48); }
    SEAM(2);
    if (IN(3)) { { pg8::StaticOrder S; S.init(MP, DM, F.G, c); pg8::EpiRes E{XB, HBp, SSQ0}; GEMM(EpiRes, E, StaticOrder, S, Zp, WAOUT, DM, DM); }
                 p2_conv(F, args, MP, MT, 0, F.G); }
    SEAM(3);
    if (IN(4)) { if (c >= 240) { pg8::SubOrder S; S.init(64, 4, 4, 16, c - 240); pg8::EpiRes E{XB, HBp, SSQ0}; GEMM(EpiRes, E, SubOrder, S, Zp, WAOUT, DM, DM); }
                 { pg8::StaticOrder S; S.init(MP, NFF, F.G, c); pg8::EpiFfn E{ACTp, SSQ0}; GEMM(EpiFfn, E, StaticOrder, S, HBp, (const bf16*)(ws + WS_WFIN0), NFF, DM); } }
    SEAM(4);
    if (IN(5)) { { pg8::StaticOrder S; S.init(MP, DM, F.G, c); pg8::EpiRes E{HBp, HBp, SSQ1}; GEMM(EpiRes, E, StaticOrder, S, ACTp, (const bf16*)(ws + WS_WFOUT0), DM, DFF); }
                 if (c < 88) { pg8::SubOrder S; S.init(64, 4, 22, 88, c); pg8::EpiFfn E{ACTp, SSQ0}; GEMM(EpiFfn, E, SubOrder, S, HBp, (const bf16*)(ws + WS_WFIN0), NFF, DM); } }
    SEAM(5);
    if (IN(6)) { pg8::EpiKvq EK{KVBp, QBp, GTp, SSQ1, args.out + O_CMPP, args.out + O_CMPS, args.out + O_SLCP, args.out + O_SLCS, args.out + O_WINP, args.out + O_WINS};
                 if (c >= 240) { pg8::SubOrder S; S.init(64, 4, 4, 16, c - 240); pg8::EpiRes E{HBp, HBp, SSQ1}; GEMM(EpiRes, E, SubOrder, S, ACTp, (const bf16*)(ws + WS_WFOUT0), DM, DFF); }
                 else { pg8::StaticOrder S; S.init(MP, NKVQ, 240, c); GEMM(EpiKvq, EK, StaticOrder, S, HBp, WKVQ, NKVQ, DM); } }
    SEAM(6);
    if (IN(7)) { if (c < 44) { pg8::SubOrder S; S.init(64, 4, 11, 44, c); pg8::EpiKvq EK{KVBp, QBp, GTp, SSQ1, args.out + O_CMPP, args.out + O_CMPS, args.out + O_SLCP, args.out + O_SLCS, args.out + O_WINP, args.out + O_WINS};
                     GEMM(EpiKvq, EK, SubOrder, S, HBp, WKVQ, NKVQ, DM); }
                 p7_compress(F, args, 0, 1); p7_compress(F, args, 1, 4096); }
    SEAM(7);
    if (IN(9)) { p8_attention(F, args); }
    SEAM(9);
    if (IN(10)) { pg8::StaticOrder S; S.init(MP, DM, F.G, c); pg8::EpiRes E{HBp, HBp, SSQ2}; GEMM(EpiRes, E, StaticOrder, S, Op, WBOUT, DM, DM); }
    SEAM(10);
    if (IN(11)) { if (c >= 240) { pg8::SubOrder S; S.init(64, 4, 4, 16, c - 240); pg8::EpiRes E{HBp, HBp, SSQ2}; GEMM(EpiRes, E, SubOrder, S, Op, WBOUT, DM, DM); }
                  { pg8::StaticOrder S; S.init(MP, NFF, F.G, c); pg8::EpiFfn E{ACTp, SSQ2}; GEMM(EpiFfn, E, StaticOrder, S, HBp, (const bf16*)(ws + WS_WFIN1), NFF, DM); } }
    SEAM(11);
    if (IN(12)) { { pg8::StaticOrder S; S.init(MP, DM, F.G, c); pg8::EpiRes E{HBp, HBp, nullptr}; GEMM(EpiRes, E, StaticOrder, S, ACTp, (const bf16*)(ws + WS_WFOUT1), DM, DFF); }
                  if (c < 88) { pg8::SubOrder S; S.init(64, 4, 22, 88, c); pg8::EpiFfn E{ACTp, SSQ2}; GEMM(EpiFfn, E, SubOrder, S, HBp, (const bf16*)(ws + WS_WFIN1), NFF, DM); } }
    SEAM(12);
    if (IN(13)) { if (c >= 240) { pg8::SubOrder S; S.init(64, 4, 4, 16, c - 240); pg8::EpiRes E{HBp, HBp, nullptr}; GEMM(EpiRes, E, SubOrder, S, ACTp, (const bf16*)(ws + WS_WFOUT1), DM, DFF); }
                  else { p_final(F, args, 0, MP, 0, 240); p_wincopy(F, args, 0, 240); } }
    SEAM(13);
    if (IN(14)) { p_final(F, args, MP, MT, 0, F.G); }
#undef GEMM
#undef IN
#undef SEAM
}

#ifndef MK_PER_PHASE
#define MK_PER_PHASE 0
#endif
extern "C" void kernel_launch(void* const* d_in, const int* in_sizes, int n_in, void* d_out, int out_size, void* d_ws, size_t ws_size, hipStream_t stream) {
    static int grid = 0;
    if (grid == 0) {
        if (n_in != 21 || out_size != (int)O_END || ws_size < WS_END) { fprintf(stderr, "kernel_launch: unexpected shapes (n_in %d out %d ws %zu)\n", n_in, out_size, ws_size); grid = -1; return; }
        int dev = 0, cus = 0, per_cu = 0;
        if (hipGetDevice(&dev) != hipSuccess || hipDeviceGetAttribute(&cus, hipDeviceAttributeMultiprocessorCount, dev) != hipSuccess) { grid = -1; return; }
        if (hipFuncSetAttribute((const void*)yoco_fwd, hipFuncAttributeMaxDynamicSharedMemorySize, LDS_BYTES) != hipSuccess) { fprintf(stderr, "kernel_launch: hipFuncSetAttribute failed\n"); grid = -1; return; }
        if (hipOccupancyMaxActiveBlocksPerMultiprocessor(&per_cu, (const void*)yoco_fwd, NWAVES * 64, LDS_BYTES) != hipSuccess || per_cu < 1) { fprintf(stderr, "kernel_launch: occupancy query says %d\n", per_cu); }
        (void)hipGetLastError();
        grid = cus;
    }
    if (grid < 0) return;
    if (hipMemsetAsync((char*)d_ws + WS_CTL, 0, CTL_ZERO_BYTES, stream) != hipSuccess) return;
    Args a{};
    for (int i = 0; i < 21; ++i) a.in[i] = (const float*)d_in[i];
    a.out = (float*)d_out; a.ws = (unsigned char*)d_ws;
#if MK_PER_PHASE
    for (int p = 0; p < N_PHASES; ++p) { a.ph_lo = p; a.ph_hi = p + 1; hipLaunchKernelGGL(yoco_fwd, dim3(grid), dim3(NWAVES * 64), LDS_BYTES, stream, a); }
#else
    a.ph_lo = 0; a.ph_hi = N_PHASES; hipLaunchKernelGGL(yoco_fwd, dim3(grid), dim3(NWAVES * 64), LDS_BYTES, stream, a);
#endif
}
```

```cpp
#include <hip/hip_runtime.h>
#include <cstdio>
#include <cstdint>
namespace pg8 {
#define PG8_LAS __attribute__((address_space(3)))
typedef unsigned short bf16_t;
typedef short bf16x8 __attribute__((ext_vector_type(8)));
typedef float f32x4 __attribute__((ext_vector_type(4)));
typedef unsigned u32x4 __attribute__((ext_vector_type(4)));
constexpr int BM = 256, BK = 64, HALF = 128, HTB = HALF * BK * 2  , STAGE_BYTES = 8 * HTB, NXCD = 8, WGM = 8;

__host__ __device__ __forceinline__ int lds_byte(int r, int c) { const int st = (r >> 4) * 2 + (c >> 5), rr = r & 15, cc = c & 31, ob = rr * 64 + cc * 2; return st * 1024 + (ob ^ (((ob >> 9) & 1) << 5)); }
__host__ __device__ __forceinline__ void stage_rc(int b, int& R, int& C) { const int st = b / 1024, sb = b % 1024, swz = sb ^ (((sb >> 9) & 1) << 5); R = (st >> 1) * 16 + swz / 64; C = (st & 1) * 32 + (swz % 64) / 2; }
__host__ __device__ __forceinline__ int perm32(int rho) { const int n = rho >> 4, i = rho & 15; return 8 * (i >> 2) + 4 * n + (i & 3); }

struct Unit { int pm, pn; };
struct Gemm { const bf16_t* A; const bf16_t* Bt; int M, N, K; };

struct StaticOrder {
    int nM, nN, nwg, G, c;
    __host__ __device__ void init(int M, int N, int G_, int c_) { nM = M / BM; nN = N / BM; nwg = nM * nN; G = G_; c = c_; }
    __host__ __device__ bool next(int i, Unit& u) const {
        const long L = (long)i * G + c; if (L >= nwg) return false;
        int wgid = (int)L; { const int q = nwg / NXCD, r = nwg % NXCD, xcd = wgid % NXCD, off = wgid / NXCD; wgid = (xcd < r ? xcd * (q + 1) : r * (q + 1) + (xcd - r) * q) + off; }
        const int nig = WGM * nN, gid = wgid / nig, fm = gid * WGM, gsz = (nM - fm) < WGM ? (nM - fm) : WGM;
        u.pm = fm + ((wgid % nig) % gsz); u.pn = (wgid % nig) / gsz; return true;
    }
    __device__ __forceinline__ void a_ready(const Unit&) const {}
    __device__ __forceinline__ void done(const Unit&) const {}
};

__device__ __forceinline__ unsigned cvt_pk_bf16(float lo, float hi) { unsigned r; asm volatile("v_cvt_pk_bf16_f32 %0, %1, %2" : "=v"(r) : "v"(lo), "v"(hi)); return r; }
constexpr int E_MP = 16384;
constexpr float E_EPS = 1e-6f;
__device__ __forceinline__ float row_rstd16(const float* ssqp, int row, int fq) {
    const f32x4 p = *(const f32x4*)(ssqp + (size_t)row * 16 + fq * 4);
    float s = (p[0] + p[1]) + (p[2] + p[3]); s += __shfl_xor(s, 16); s += __shfl_xor(s, 32);
    return __builtin_amdgcn_rsqf(s * (1.0f / 1024.0f) + E_EPS);
}
__device__ __forceinline__ u32x4 pack8(const f32x4 a, const f32x4 b) { u32x4 w; w.x = cvt_pk_bf16(a[0], a[1]); w.y = cvt_pk_bf16(a[2], a[3]); w.z = cvt_pk_bf16(b[0], b[1]); w.w = cvt_pk_bf16(b[2], b[3]); return w; }

struct EpiAin {
    static constexpr bool PERM = true, AFTER_DRAIN = false;
    bf16_t* VB; bf16_t* BB; const float* rstd;
    __device__ __forceinline__ void operator()(const f32x4 (&acc)[2][2][4][2], const Unit& u, int wr, int wc, int fr, int fq) const {
        const int row0 = u.pm * BM + wr * 64 + fr;
        if (u.pn < 8) {
            const int ch = u.pn * 128 + wc * 32 + 8 * fq;
#pragma unroll
            for (int ai = 0; ai < 2; ++ai)
#pragma unroll
                for (int m = 0; m < 4; ++m) { const int row = row0 + ai * HALF + m * 16; const float r = rstd[row], r2 = r * r;
                    const f32x4 v0 = acc[ai][0][m][0] * acc[ai][1][m][0] * r2, v1 = acc[ai][0][m][1] * acc[ai][1][m][1] * r2;
                    *(u32x4*)(VB + (size_t)row * 1024 + ch) = pack8(v0, v1); }
        } else {
            const int ch = (u.pn - 8) * 256 + wc * 32 + 8 * fq;
#pragma unroll
            for (int ai = 0; ai < 2; ++ai)
#pragma unroll
                for (int m = 0; m < 4; ++m) { const int row = row0 + ai * HALF + m * 16; const float r = rstd[row];
#pragma unroll
                    for (int bj = 0; bj < 2; ++bj) *(u32x4*)(BB + (size_t)row * 1024 + ch + bj * HALF) = pack8(acc[ai][bj][m][0] * r, acc[ai][bj][m][1] * r); }
        }
    }
};
struct EpiRes {
    static constexpr bool PERM = true, AFTER_DRAIN = false;
    const bf16_t* base; bf16_t* HB; float* ssqp;
    __device__ __forceinline__ void operator()(const f32x4 (&acc)[2][2][4][2], const Unit& u, int wr, int wc, int fr, int fq) const {
        const int row0 = u.pm * BM + wr * 64 + fr, col0 = u.pn * BM + wc * 32 + 8 * fq;
#pragma unroll
        for (int ai = 0; ai < 2; ++ai)
#pragma unroll
            for (int m = 0; m < 4; ++m) { const int row = row0 + ai * HALF + m * 16; const size_t off = (size_t)row * 1024 + col0; float ss = 0.f;
#pragma unroll
                for (int bj = 0; bj < 2; ++bj) { const u32x4 bw = *(const u32x4*)(base + off + bj * HALF);
                    f32x4 h0, h1;
                    h0[0] = __builtin_bit_cast(float, bw.x << 16) + acc[ai][bj][m][0][0]; h0[1] = __builtin_bit_cast(float, bw.x & 0xffff0000u) + acc[ai][bj][m][0][1];
                    h0[2] = __builtin_bit_cast(float, bw.y << 16) + acc[ai][bj][m][0][2]; h0[3] = __builtin_bit_cast(float, bw.y & 0xffff0000u) + acc[ai][bj][m][0][3];
                    h1[0] = __builtin_bit_cast(float, bw.z << 16) + acc[ai][bj][m][1][0]; h1[1] = __builtin_bit_cast(float, bw.z & 0xffff0000u) + acc[ai][bj][m][1][1];
                    h1[2] = __builtin_bit_cast(float, bw.w << 16) + acc[ai][bj][m][1][2]; h1[3] = __builtin_bit_cast(float, bw.w & 0xffff0000u) + acc[ai][bj][m][1][3];
                    const u32x4 o = pack8(h0, h1); *(u32x4*)(HB + off + bj * HALF) = o;
                    if (ssqp) { const float r0 = __builtin_bit_cast(float, o.x << 16), r1 = __builtin_bit_cast(float, o.x & 0xffff0000u), r2 = __builtin_bit_cast(float, o.y << 16), r3 = __builtin_bit_cast(float, o.y & 0xffff0000u),
                                            r4 = __builtin_bit_cast(float, o.z << 16), r5 = __builtin_bit_cast(float, o.z & 0xffff0000u), r6 = __builtin_bit_cast(float, o.w << 16), r7 = __builtin_bit_cast(float, o.w & 0xffff0000u);
                        ss += (r0 * r0 + r1 * r1) + (r2 * r2 + r3 * r3) + (r4 * r4 + r5 * r5) + (r6 * r6 + r7 * r7); } }
                if (ssqp) { ss += __shfl_xor(ss, 16); ss += __shfl_xor(ss, 32); if (fq == 0) ssqp[(size_t)row * 16 + u.pn * 4 + wc] = ss; }
                if (m & 1) asm volatile("" ::: "memory"); }
    }
};
struct EpiFfn {
    static constexpr bool PERM = true, AFTER_DRAIN = false;
    bf16_t* ACT; const float* ssqp;
    __device__ __forceinline__ void operator()(const f32x4 (&acc)[2][2][4][2], const Unit& u, int wr, int wc, int fr, int fq) const {
        const int row0 = u.pm * BM + wr * 64 + fr, ch = u.pn * 128 + wc * 32 + 8 * fq;
#pragma unroll
        for (int ai = 0; ai < 2; ++ai)
#pragma unroll
            for (int m = 0; m < 4; ++m) { const int row = row0 + ai * HALF + m * 16; const float r = row_rstd16(ssqp, row, fq);
                f32x4 o[2];
#pragma unroll
                for (int n = 0; n < 2; ++n)
#pragma unroll
                    for (int e = 0; e < 4; ++e) { const float g = acc[ai][0][m][n][e] * r, up = acc[ai][1][m][n][e] * r;
                        o[n][e] = g * up * __builtin_amdgcn_rcpf(1.0f + __builtin_amdgcn_exp2f(g * -1.4426950408889634f)); }
                *(u32x4*)(ACT + (size_t)row * 2816 + ch) = pack8(o[0], o[1]); }
    }
};
struct EpiKvq {
    static constexpr bool PERM = true, AFTER_DRAIN = false;
    bf16_t* KVB; bf16_t* QB; float* GT; const float* ssqp;
    float *cmp_p, *cmp_s, *slc_p, *slc_s, *win_p, *win_s;
    __device__ __forceinline__ void operator()(const f32x4 (&acc)[2][2][4][2], const Unit& u, int wr, int wc, int fr, int fq) const {
        const int row0 = u.pm * BM + wr * 64 + fr, cw = wc * 32 + 8 * fq;
#pragma unroll
        for (int ai = 0; ai < 2; ++ai)
#pragma unroll
            for (int m = 0; m < 4; ++m) { const int row = row0 + ai * HALF + m * 16; const float r = row_rstd16(ssqp, row, fq);
                if (u.pn < 6) {
                    const int br = u.pn >> 1; float* orow = nullptr;
                    if (row < E_MP) { if (br == 0) orow = cmp_p + (size_t)row * 512; else if (br == 1) orow = slc_p + (size_t)row * 512;
                        else { const int t = row & 8191; if (t >= 7680) orow = win_p + ((size_t)(row >> 13) * 512 + (t - 7680)) * 512; } }
                    else { const int rs = row - E_MP; if (br == 0) orow = cmp_s + (size_t)rs * 512; else if (br == 1) orow = slc_s + (size_t)rs * 512;
                        else orow = win_s + ((size_t)(rs >> 3) * 512 + 504 + (rs & 7)) * 512; }
#pragma unroll
                    for (int bj = 0; bj < 2; ++bj) { const int col = u.pn * BM + bj * HALF + cw; const f32x4 a = acc[ai][bj][m][0] * r, b = acc[ai][bj][m][1] * r;
                        *(u32x4*)(KVB + (size_t)row * 1536 + col) = pack8(a, b);
                        if (orow) { *(f32x4*)(orow + (col & 511)) = a; *(f32x4*)(orow + (col & 511) + 4) = b; } }
                } else if (u.pn < 10) {
#pragma unroll
                    for (int bj = 0; bj < 2; ++bj) { const int col = (u.pn - 6) * BM + bj * HALF + cw;
                        *(u32x4*)(QB + (size_t)row * 1024 + col) = pack8(acc[ai][0 + bj][m][0] * r, acc[ai][0 + bj][m][1] * r); }
                } else {
                    if (cw < 48) {
                        f32x4 s0, s1;
#pragma unroll
                        for (int e = 0; e < 4; ++e) { s0[e] = __builtin_amdgcn_rcpf(1.0f + __builtin_amdgcn_exp2f(acc[ai][0][m][0][e] * r * -1.4426950408889634f));
                                                      s1[e] = __builtin_amdgcn_rcpf(1.0f + __builtin_amdgcn_exp2f(acc[ai][0][m][1][e] * r * -1.4426950408889634f)); }
                        *(f32x4*)(GT + (size_t)row * 48 + cw) = s0; *(f32x4*)(GT + (size_t)row * 48 + cw + 4) = s1; }
                }
            }
    }
};

struct SubOrder {
    int pm0, nM, nwg, Gs, cl;
    __host__ __device__ void init(int pm0_, int nM_, int nN_, int Gs_, int cl_) { pm0 = pm0_; nM = nM_; nwg = nM_ * nN_; Gs = Gs_; cl = cl_; }
    __host__ __device__ bool next(int i, Unit& u) const { if (cl < 0 || cl >= Gs) return false; const int L = i * Gs + cl; if (L >= nwg) return false; u.pm = pm0 + L % nM; u.pn = L / nM; return true; }
    __device__ __forceinline__ void a_ready(const Unit&) const {}
    __device__ __forceinline__ void done(const Unit&) const {}
};
template <class Epi, class Sched, bool ALIGN_EPI = false, bool SP2 = false>
__device__ __forceinline__ void gemm_phase(PG8_LAS unsigned char* lds, const Gemm g, const Sched& S, const Epi& E) {
    const int tid = threadIdx.x, wid = __builtin_amdgcn_readfirstlane(tid >> 6), lane = tid & 63, wr = wid >> 2, wc = wid & 3, fr = lane & 15, fq = lane >> 4;
    const int K = g.K, nt = K / BK;
    unsigned voffA[2], voffB[2];
#pragma unroll
    for (int i = 0; i < 2; ++i) { int R, C; stage_rc(tid * 16 + i * 8192, R, C); const int Rb = Epi::PERM ? ((R & ~31) + perm32(R & 31)) : R;
        voffA[i] = (unsigned)(R * K + C) * 2u; voffB[i] = (unsigned)(Rb * K + C) * 2u; }
    const size_t kstep = (size_t)(BK * 2);
    const size_t hstep = (size_t)HALF * K * 2;
    const size_t tstep = 2 * hstep;
    const unsigned ldsw = (unsigned)wid * 1024u;
    const int aoff = lds_byte(wr * 64 + fr, fq * 8), boff = lds_byte(wc * 32 + fr, fq * 8);
#define PG8_SA(b, h) (((b) * 2 + (h)) * HTB)
#define PG8_SB(b, h) ((4 + (b) * 2 + (h)) * HTB)
#define PG8_STAGE(bufoff, gbase, voff) do { _Pragma("unroll") for (int _i = 0; _i < 2; ++_i) \
        __builtin_amdgcn_global_load_lds((const unsigned*)((const char*)(gbase) + (voff)[_i]), (PG8_LAS unsigned*)(lds + (bufoff) + ldsw + _i * 8192), 16, 0, 0); } while (0)
#define PG8_LDA(dst, b, h) do { _Pragma("unroll") for (int m = 0; m < 4; ++m) _Pragma("unroll") for (int k = 0; k < 2; ++k) dst[m][k] = *(const PG8_LAS bf16x8*)(lds + PG8_SA(b, h) + aoff + m * 2048 + k * 1024); } while (0)
#define PG8_LDB(dst, b, h) do { _Pragma("unroll") for (int n = 0; n < 2; ++n) _Pragma("unroll") for (int k = 0; k < 2; ++k) dst[n][k] = *(const PG8_LAS bf16x8*)(lds + PG8_SB(b, h) + boff + n * 2048 + k * 1024); } while (0)
#define PG8_MMA(ai, bj, At, Bt) do { __builtin_amdgcn_s_setprio(1); _Pragma("unroll") for (int m = 0; m < 4; ++m) _Pragma("unroll") for (int n = 0; n < 2; ++n) _Pragma("unroll") for (int k = 0; k < 2; ++k) \
        acc[ai][bj][m][n] = __builtin_amdgcn_mfma_f32_16x16x32_bf16(Bt[n][k], At[m][k], acc[ai][bj][m][n], 0, 0, 0); __builtin_amdgcn_s_setprio(0); } while (0)
#define PG8_WAIT_V(n) asm volatile("s_waitcnt vmcnt(" #n ")" ::: "memory")
#define PG8_WAIT_L(n) asm volatile("s_waitcnt lgkmcnt(" #n ")" ::: "memory")
#define PG8_BAR __builtin_amdgcn_s_barrier()
#define PG8_SCHED __builtin_amdgcn_sched_barrier(0)
    Unit cur, nxt; int ui = 0;
    if (!S.next(0, cur)) return;
    f32x4 acc[2][2][4][2];
#pragma unroll
    for (int a = 0; a < 2; ++a)
#pragma unroll
        for (int b = 0; b < 2; ++b)
#pragma unroll
            for (int m = 0; m < 4; ++m)
#pragma unroll
                for (int n = 0; n < 2; ++n) acc[a][b][m][n] = (f32x4){0.f, 0.f, 0.f, 0.f};
    bf16x8 At[4][2], B0[2][2], B1[2][2];
    const char* cA = (const char*)g.A + (size_t)cur.pm * tstep; const char* cB = (const char*)g.Bt + (size_t)cur.pn * tstep;
    S.a_ready(cur);
    if constexpr (SP2) {
        PG8_STAGE(PG8_SB(0, 0), cB, voffB); PG8_STAGE(PG8_SB(0, 1), cB + hstep, voffB); PG8_STAGE(PG8_SA(0, 0), cA, voffA); PG8_STAGE(PG8_SA(0, 1), cA + hstep, voffA);
        if (wr == 1) PG8_BAR;
        PG8_WAIT_V(2); PG8_BAR;
        PG8_STAGE(PG8_SB(1, 0), cB + kstep, voffB); PG8_STAGE(PG8_SA(1, 0), cA + kstep, voffA); PG8_STAGE(PG8_SB(1, 1), cB + hstep + kstep, voffB);
        PG8_WAIT_V(6); PG8_BAR;
    } else {
        PG8_STAGE(PG8_SB(0, 0), cB, voffB); PG8_STAGE(PG8_SA(0, 0), cA, voffA); PG8_STAGE(PG8_SB(0, 1), cB + hstep, voffB); PG8_STAGE(PG8_SA(0, 1), cA + hstep, voffA);
        if (wr == 1) PG8_BAR;
        PG8_WAIT_V(4); PG8_BAR;
        PG8_STAGE(PG8_SB(1, 0), cB + kstep, voffB); PG8_STAGE(PG8_SA(1, 0), cA + kstep, voffA); PG8_STAGE(PG8_SB(1, 1), cB + hstep + kstep, voffB);
        PG8_WAIT_V(6); PG8_BAR;
    }
    for (;;) {
        const bool has_next = S.next(ui + 1, nxt);
        const char* nA = has_next ? (const char*)g.A + (size_t)nxt.pm * tstep : cA; const char* nB = has_next ? (const char*)g.Bt + (size_t)nxt.pn * tstep : cB;
        for (int t = 0; t < nt; t += 2) {
            const bool last = (t == nt - 2);
            const char* a1 = cA + (size_t)(t + 1) * kstep;
            const char* a2 = last ? nA : cA + (size_t)(t + 2) * kstep; const char* b2 = last ? nB : cB + (size_t)(t + 2) * kstep;
            const char* a3 = a2 + kstep; const char* b3 = b2 + kstep;
            if (last && has_next) S.a_ready(nxt);
            if constexpr (SP2) {
            PG8_LDB(B0, 0, 0); PG8_LDB(B1, 0, 1); PG8_SCHED; PG8_LDA(At, 0, 0); PG8_STAGE(PG8_SA(1, 1), a1 + hstep, voffA);
            PG8_WAIT_V(8); PG8_WAIT_L(0); PG8_BAR; PG8_MMA(0, 0, At, B0); PG8_MMA(0, 1, At, B1); PG8_BAR; PG8_SCHED;
            PG8_LDA(At, 0, 1); PG8_STAGE(PG8_SB(0, 0), b2, voffB); PG8_STAGE(PG8_SB(0, 1), b2 + hstep, voffB); PG8_STAGE(PG8_SA(0, 0), a2, voffA);
            PG8_WAIT_V(8); PG8_WAIT_L(0); PG8_BAR; PG8_MMA(1, 0, At, B0); PG8_MMA(1, 1, At, B1); PG8_BAR; PG8_SCHED;
            PG8_LDB(B0, 1, 0); PG8_LDB(B1, 1, 1); PG8_SCHED; PG8_LDA(At, 1, 0); PG8_STAGE(PG8_SA(0, 1), a2 + hstep, voffA);
            PG8_WAIT_V(8); PG8_WAIT_L(0); PG8_BAR; PG8_MMA(0, 0, At, B0); PG8_MMA(0, 1, At, B1); PG8_BAR; PG8_SCHED;
            PG8_LDA(At, 1, 1); PG8_STAGE(PG8_SB(1, 0), b3, voffB); PG8_STAGE(PG8_SB(1, 1), b3 + hstep, voffB); PG8_STAGE(PG8_SA(1, 0), a3, voffA);
            PG8_WAIT_V(8); PG8_WAIT_L(0); PG8_BAR; PG8_MMA(1, 0, At, B0); PG8_MMA(1, 1, At, B1); PG8_BAR; PG8_SCHED;
            } else {
            PG8_LDB(B0, 0, 0); PG8_SCHED; PG8_LDA(At, 0, 0); PG8_STAGE(PG8_SA(1, 1), a1 + hstep, voffA);
            PG8_WAIT_L(8); PG8_BAR; PG8_WAIT_L(0); PG8_MMA(0, 0, At, B0); PG8_BAR; PG8_SCHED;
            PG8_LDB(B1, 0, 1); PG8_STAGE(PG8_SB(0, 0), b2, voffB);
            PG8_BAR; PG8_WAIT_L(0); PG8_MMA(0, 1, At, B1); PG8_BAR;
            PG8_LDA(At, 0, 1); PG8_STAGE(PG8_SA(0, 0), a2, voffA);
            PG8_BAR; PG8_WAIT_L(0); PG8_MMA(1, 0, At, B0); PG8_BAR; PG8_SCHED;
            PG8_STAGE(PG8_SB(0, 1), b2 + hstep, voffB);
            PG8_WAIT_V(6); PG8_BAR; PG8_MMA(1, 1, At, B1); PG8_BAR;
            PG8_LDB(B0, 1, 0); PG8_SCHED; PG8_LDA(At, 1, 0); PG8_STAGE(PG8_SA(0, 1), a2 + hstep, voffA);
            PG8_WAIT_L(8); PG8_BAR; PG8_WAIT_L(0); PG8_MMA(0, 0, At, B0); PG8_BAR; PG8_SCHED;
            PG8_LDB(B1, 1, 1); PG8_STAGE(PG8_SB(1, 0), b3, voffB);
            PG8_BAR; PG8_WAIT_L(0); PG8_MMA(0, 1, At, B1); PG8_BAR;
            PG8_LDA(At, 1, 1); PG8_STAGE(PG8_SA(1, 0), a3, voffA);
            PG8_BAR; PG8_WAIT_L(0); PG8_MMA(1, 0, At, B0); PG8_BAR; PG8_SCHED;
            PG8_STAGE(PG8_SB(1, 1), b3 + hstep, voffB);
            PG8_WAIT_V(6); PG8_BAR; PG8_MMA(1, 1, At, B1); PG8_BAR;
            }
        }
        if constexpr (ALIGN_EPI) { if (wr == 0) PG8_BAR; }
        if constexpr (!Epi::AFTER_DRAIN) { E(acc, cur, wr, wc, fr, fq); S.done(cur); }
        if (!has_next) break;
#pragma unroll
        for (int a = 0; a < 2; ++a)
#pragma unroll
            for (int b = 0; b < 2; ++b)
#pragma unroll
                for (int m = 0; m < 4; ++m)
#pragma unroll
                    for (int n = 0; n < 2; ++n) acc[a][b][m][n] = (f32x4){0.f, 0.f, 0.f, 0.f};
        cur = nxt; cA = nA; cB = nB; ++ui;
        if constexpr (ALIGN_EPI) { if (wr == 1) PG8_BAR; }
    }
    PG8_WAIT_V(0);
    if constexpr (!ALIGN_EPI) { if (wr == 0) PG8_BAR; }
    PG8_BAR;
    if constexpr (Epi::AFTER_DRAIN) { E.fused(acc, cur, wr, wc, fr, fq, lds, wid, lane); S.done(cur); }
#undef PG8_SA
#undef PG8_SB
#undef PG8_STAGE
#undef PG8_LDA
#undef PG8_LDB
#undef PG8_MMA
#undef PG8_WAIT_V
#undef PG8_WAIT_L
#undef PG8_BAR
#undef PG8_SCHED
}
}
#ifndef PG8_SP2
#define PG8_SP2 true
#endif
#ifndef PG8_ALIGN
#define PG8_ALIGN true
#endif
constexpr int NWAVES = 8;
constexpr int DM = 1024, TP = 8192, NBP = 2, MP = NBP * TP, NBS = 128, TS = 8, MS = NBS * TS, MT = MP + MS;
constexpr int DFF = 2816, NFF = 2 * DFF, NAIN = 3 * DM, NKVQ = 2816, NKV = 1536, PAST = 2048, NPAGE = 16, PAGE = 128;
constexpr int NCP = 511, NCS = 127;
constexpr float RMS_EPS = 1e-6f;
constexpr float QSCALE = 0.125f * 1.4426950408889634f;
constexpr size_t O_YP = 0, O_YS = O_YP + (size_t)MP * DM, O_CONVP = O_YS + (size_t)MS * DM, O_CONVS = O_CONVP + 2 * 2 * DM, O_CMPP = O_CONVS + (size_t)NBS * 2 * DM,
                 O_CMPS = O_CMPP + (size_t)MP * 512, O_SLCP = O_CMPS + (size_t)MS * 512, O_SLCS = O_SLCP + (size_t)MP * 512, O_WINP = O_SLCS + (size_t)MS * 512,
                 O_WINS = O_WINP + (size_t)NBP * 512 * 512, O_END = O_WINS + (size_t)NBS * 512 * 512;
static_assert(O_END == 69996544, "output size");
constexpr size_t MiB = 1u << 20;
constexpr size_t WS_CTL = 0, CTL_ZERO_BYTES = 1 * MiB;
constexpr size_t WS_WAIN = 2 * MiB, WS_WAOUT = 8 * MiB, WS_WFIN0 = 10 * MiB, WS_WFIN1 = 21 * MiB, WS_WFOUT0 = 32 * MiB, WS_WFOUT1 = 38 * MiB, WS_WKVQ = 44 * MiB, WS_WBOUT = 50 * MiB,
                 WS_W1T = 52 * MiB, WS_W2T = 53 * MiB, WS_PEB = 53 * MiB + 65536, WS_RSTD0 = 54 * MiB, WS_SSQ = 55 * MiB  , WS_GT = 60 * MiB  ,
                 WS_KCP = 64 * MiB  , WS_KCS = 65 * MiB  , WS_SELS = 82 * MiB,
                 WS_XB = 96 * MiB, WS_BB = 132 * MiB, WS_VB = 168 * MiB, WS_Z = 204 * MiB, WS_H = 240 * MiB, WS_HB = 312 * MiB, WS_ACT = 348 * MiB, WS_KVB = 444 * MiB, WS_QB = 496 * MiB, WS_O = 532 * MiB, WS_OTG = 568 * MiB  , WS_END = 600 * MiB;
static_assert(WS_XB + (size_t)MT * DM * 2 <= WS_BB && WS_H + (size_t)MT * DM * 4 <= WS_HB && WS_ACT + (size_t)MT * DFF * 2 <= WS_KVB && WS_KVB + (size_t)MT * NKV * 2 <= WS_QB && WS_O + (size_t)MT * DM * 2 <= WS_OTG, "ws map");
static_assert(WS_SSQ + 4 * (size_t)MT * 16 * 4 <= WS_GT && WS_GT + (size_t)MT * 48 * 4 <= WS_KCP && WS_KCS + (size_t)NBS * 128 * 512 * 2 <= WS_SELS, "ws map 2");
constexpr int CW_TMO = 0, CW_CODE = 1, CW_Q8 = 64, CW_Q7 = 256, CW_BAR = 4096;
constexpr int RING_OFF = 0, RING_BYTES = 155648, LDSCTL_OFF = RING_BYTES, MISC_OFF = LDSCTL_OFF + 320, LDS_BYTES = 159744;

#define GAS __attribute__((address_space(1)))
#define LAS __attribute__((address_space(3)))
typedef unsigned short bf16;
typedef unsigned v4u __attribute__((ext_vector_type(4)));
typedef unsigned v2u __attribute__((ext_vector_type(2)));
typedef float f32x4 __attribute__((ext_vector_type(4)));
typedef short bf16x8 __attribute__((ext_vector_type(8)));
typedef GAS unsigned gu32;
#define RLX_AGENT __ATOMIC_RELAXED, __HIP_MEMORY_SCOPE_AGENT
#define LDS_WAIT() asm volatile("s_waitcnt lgkmcnt(0)" ::: "memory")
#define VM_WAIT() asm volatile("s_waitcnt vmcnt(0)" ::: "memory")
__device__ __forceinline__ unsigned f2bf(float f) { unsigned u = __builtin_bit_cast(unsigned, f); return (u + 0x7fffu + ((u >> 16) & 1u)) >> 16; }
__device__ __forceinline__ unsigned pk2(float lo, float hi) { return f2bf(lo) | (f2bf(hi) << 16); }
__device__ __forceinline__ float bf2f(unsigned h) { return __builtin_bit_cast(float, h << 16); }
#define XB_TMO      128
#define XB_XCNT(j)  (256  + 64 * (j))
#define XB_XSUB(j)  (1280 + 64 * (j))
#define XB_XGEN(j)  (2304 + 64 * (j))
#define XB_TOP      3328
#define XB_TOPGEN   3392
#define XCD_BAR_WORDS 3456
#define XB_SPIN_CAP (1u << 18)

__device__ __forceinline__ unsigned xb_ld(unsigned* p)              { return __hip_atomic_load(p, __ATOMIC_RELAXED, __HIP_MEMORY_SCOPE_AGENT); }
__device__ __forceinline__ unsigned xb_add(unsigned* p, unsigned v) { return __hip_atomic_fetch_add(p, v, __ATOMIC_RELAXED, __HIP_MEMORY_SCOPE_AGENT); }
__device__ __forceinline__ unsigned xb_xcc_id() { return (unsigned)__builtin_amdgcn_s_getreg((3 << 11) | 20) & 0xFu; }
#define XB_SPIN(cond, bar) do { unsigned _sp = 0; while (cond) { __builtin_amdgcn_s_sleep(1); \
    if ((++_sp & 255u) == 0u) { if (xb_ld(&(bar)[XB_TMO])) break; if (_sp > XB_SPIN_CAP) { atomicAdd(&(bar)[XB_TMO], 1u); break; } } } } while (0)

struct XcdBarrier {
    unsigned* bar; unsigned x;
    volatile LAS unsigned* st;
};

__device__ __forceinline__ XcdBarrier xcd_barrier_post(unsigned* bar, volatile LAS unsigned* st) {
    XcdBarrier b; b.bar = bar; b.x = xb_xcc_id(); b.st = st;
    if (threadIdx.x == 0) (void)xb_add(&bar[XB_XCNT(b.x)], 1u);
    return b;
}
__device__ __forceinline__ void xcd_barrier_complete(unsigned* bar, unsigned x, unsigned& nloc, unsigned& nx) {
    const unsigned G = gridDim.x * gridDim.y * gridDim.z;
    unsigned sum, cnt, mine, sp = 0u;
    for (;;) {
        sum = 0u; cnt = 0u; mine = 0u;
#pragma unroll
        for (unsigned j = 0; j < 16; ++j) { const unsigned c = xb_ld(&bar[XB_XCNT(j)]); sum += c; cnt += (c > 0u) ? 1u : 0u; mine = (j == x) ? c : mine; }
        if (sum == G) break;
        __builtin_amdgcn_s_sleep(1);
        if ((++sp & 255u) == 0u) { if (xb_ld(&bar[XB_TMO])) break; if (sp > XB_SPIN_CAP) { atomicAdd(&bar[XB_TMO], 1u); break; } }
    }
    nloc = mine > 0u ? mine : 1u; nx = cnt > 0u ? cnt : 1u;
}

__device__ __forceinline__ void xcd_barrier(const XcdBarrier& b) {
    asm volatile("s_waitcnt vmcnt(0)" ::: "memory");
    __syncthreads();
    if (threadIdx.x == 0) {
        unsigned* bar = b.bar;
        __builtin_amdgcn_s_waitcnt(0);
        unsigned nloc = b.st[0], nx = b.st[1];
        if (nloc == 0u) { xcd_barrier_complete(bar, b.x, nloc, nx); b.st[0] = nloc; b.st[1] = nx; }
        const unsigned old = xb_add(&bar[XB_XSUB(b.x)], 1u);
        const unsigned gen = old / nloc;
        if (old + 1u == (gen + 1u) * nloc) {
            __builtin_amdgcn_fence(__ATOMIC_RELEASE, "agent");
            asm volatile("s_waitcnt vmcnt(0)" ::: "memory");
            const unsigned og = xb_add(&bar[XB_TOP], 1u);
            const unsigned tg = og / nx;
            if (og + 1u == (tg + 1u) * nx) xb_add(&bar[XB_TOPGEN], 1u);
            else XB_SPIN(xb_ld(&bar[XB_TOPGEN]) == tg, bar);
            __builtin_amdgcn_fence(__ATOMIC_ACQUIRE, "agent");
            xb_add(&bar[XB_XGEN(b.x)], 1u);
            asm volatile("s_waitcnt vmcnt(0)" ::: "memory");
        } else {
            XB_SPIN(xb_ld(&bar[XB_XGEN(b.x)]) == gen, bar);
            __builtin_amdgcn_fence(__ATOMIC_ACQUIRE, "agent");
            asm volatile("s_waitcnt vmcnt(0)" ::: "memory");
        }
    }
    __syncthreads();
}

struct Args { const float* in[21]; float* out; unsigned char* ws; int ph_lo, ph_hi; };
struct Frame {
    LAS unsigned char* lds; volatile LAS unsigned* MISC; gu32* ctl;
    int tid, lane, wave, vcu, G;
};
__device__ __forceinline__ float wave_sum(float v) {
#pragma unroll
    for (int o = 1; o < 64; o <<= 1) v += __shfl_xor(v, o);
    return v;
}
__device__ __forceinline__ void tr_item(const float* src, int ldsrc, int scol, int nvalid, const float* kscale, float cscale, bf16* dst, int K, int n0, int k0, LAS float* scr, int lane) {
    { const int c = lane & 31, kh = lane >> 5; float v[32], ks[32];
#pragma unroll
    for (int i = 0; i < 32; ++i) { v[i] = 0.f; ks[i] = 1.f; if (c < nvalid) { v[i] = src[(size_t)(k0 + 2 * i + kh) * ldsrc + scol + c]; if (kscale) ks[i] = kscale[k0 + 2 * i + kh]; } }
#pragma unroll
    for (int i = 0; i < 32; ++i) scr[(2 * i + kh) * 33 + c] = v[i] * cscale * ks[i]; }
    LDS_WAIT(); asm volatile("" ::: "memory");
    const int c = lane & 7;
#pragma unroll
    for (int j = 0; j < 4; ++j) { const int n = (lane >> 3) + 8 * j; const LAS float* s = scr + (8 * c) * 33 + n;
        v4u o; o.x = pk2(s[0 * 33], s[1 * 33]); o.y = pk2(s[2 * 33], s[3 * 33]); o.z = pk2(s[4 * 33], s[5 * 33]); o.w = pk2(s[6 * 33], s[7 * 33]);
        *(GAS v4u*)(dst + (size_t)(n0 + n) * K + k0 + 8 * c) = o; }
    LDS_WAIT(); asm volatile("" ::: "memory");
}
enum { I_XP = 0, I_XS, I_CCMP, I_CSLC, I_SWIN, I_SCONV, I_PT, I_NORMW, I_FNORMW, I_AIN, I_ACONV, I_AOUT, I_BIN, I_BOUT, I_KVNORM, I_KVW, I_PE, I_W1, I_W2, I_FIN, I_FOUT };

__device__ __forceinline__ void p0_prologue(Frame& F, const Args& A) {
    unsigned char* ws = A.ws;
    LAS float* scr = (LAS float*)(F.lds + RING_OFF + F.wave * 16384);
    const int gw = F.vcu * NWAVES + F.wave, NGW = F.G * NWAVES;
    const float* normw = A.in[I_NORMW];
    constexpr int IT_AIN = (NAIN / 32) * (DM / 64), IT_SQ = (DM / 32) * (DM / 64), IT_FIN = (NFF / 32) * (DM / 64), IT_FOUT = (DM / 32) * (DFF / 64), IT_KVQ = (NKVQ / 32) * (DM / 64),
                  IT_W1 = 2 * (64 / 32) * (2048 / 64), IT_W2 = 2 * 2;
    constexpr int NITEMS = IT_AIN + 2 * IT_SQ + 2 * IT_FIN + 2 * IT_FOUT + IT_KVQ + IT_W1 + IT_W2;
    for (int it = gw; it < NITEMS; it += NGW) {
        int r = it;
        if (r < IT_AIN) { const int ng = r / 16, kb = r % 16, n0 = ng * 32, pn = n0 >> 8, w = n0 & 255;
            const int scol = pn < 8 ? (w < 128 ? 1024 + pn * 128 + w : 2048 + pn * 128 + (w - 128)) : (pn - 8) * 256 + w;
            tr_item(A.in[I_AIN], NAIN, scol, 32, normw, 1.f, (bf16*)(ws + WS_WAIN), DM, n0, kb * 64, scr, F.lane); continue; } r -= IT_AIN;
        if (r < IT_SQ) { const int ng = r / 16, kb = r % 16; tr_item(A.in[I_AOUT], DM, ng * 32, 32, nullptr, 1.f, (bf16*)(ws + WS_WAOUT), DM, ng * 32, kb * 64, scr, F.lane); continue; } r -= IT_SQ;
        if (r < IT_SQ) { const int ng = r / 16, kb = r % 16; tr_item(A.in[I_BOUT], DM, ng * 32, 32, nullptr, 1.f, (bf16*)(ws + WS_WBOUT), DM, ng * 32, kb * 64, scr, F.lane); continue; } r -= IT_SQ;
        if (r < 2 * IT_FIN) { const int l = r / IT_FIN, q = r % IT_FIN, ng = q / 16, kb = q % 16, n0 = ng * 32, pn = n0 >> 8, w = n0 & 255;
            const int scol = w < 128 ? pn * 128 + w : DFF + pn * 128 + (w - 128);
            tr_item(A.in[I_FIN] + (size_t)l * DM * NFF, NFF, scol, 32, normw + (l * 2 + 1) * DM, 1.f, (bf16*)(ws + (l ? WS_WFIN1 : WS_WFIN0)), DM, n0, kb * 64, scr, F.lane); continue; } r -= 2 * IT_FIN;
        if (r < 2 * IT_FOUT) { const int l = r / IT_FOUT, q = r % IT_FOUT, ng = q / 44, kb = q % 44;
            tr_item(A.in[I_FOUT] + (size_t)l * DFF * DM, DM, ng * 32, 32, nullptr, 1.f, (bf16*)(ws + (l ? WS_WFOUT1 : WS_WFOUT0)), DFF, ng * 32, kb * 64, scr, F.lane); continue; } r -= 2 * IT_FOUT;
        if (r < IT_KVQ) { const int ng = r / 16, kb = r % 16, n0 = ng * 32; bf16* dst = (bf16*)(ws + WS_WKVQ);
            if (n0 < NKV) tr_item(A.in[I_KVW], NKV, n0, 32, A.in[I_KVNORM], 1.f, dst, DM, n0, kb * 64, scr, F.lane);
            else if (n0 < NKV + 1024) tr_item(A.in[I_BIN], 1072, n0 - NKV, 32, normw + 2 * DM, QSCALE, dst, DM, n0, kb * 64, scr, F.lane);
            else { const int g0 = n0 - (NKV + 1024); const int nv = g0 >= 48 ? 0 : (48 - g0 < 32 ? 48 - g0 : 32);
                tr_item(A.in[I_BIN], 1072, 1024 + (nv ? g0 : 0), nv, normw + 2 * DM, 1.f, dst, DM, n0, kb * 64, scr, F.lane); }
            continue; } r -= IT_KVQ;
        if (r < IT_W1) { const int k = r / 64, q = r % 64, ng = q / 32, kb = q % 32;
            tr_item(A.in[I_W1] + (size_t)k * 2048 * 64, 64, ng * 32, 32, nullptr, 1.f, (bf16*)(ws + WS_W1T) + (size_t)k * 64 * 2048, 2048, ng * 32, kb * 64, scr, F.lane); continue; } r -= IT_W1;
        { const int k = r / 2, ng = r % 2;
            tr_item(A.in[I_W2] + (size_t)k * 64 * 64, 64, ng * 32, 32, nullptr, 1.f, (bf16*)(ws + WS_W2T) + (size_t)k * 64 * 64, 64, ng * 32, 0, scr, F.lane); }
    }
    for (int o = gw; o < 128; o += NGW) { const int k = o >> 6, h = o & 63; const float* pe = A.in[I_PE] + (size_t)k * 2048; const float* w1 = A.in[I_W1] + (size_t)k * 2048 * 64 + h;
        float s = 0.f; for (int i = F.lane; i < 2048; i += 64) s += pe[i] * w1[(size_t)i * 64];
        s = wave_sum(s); if (F.lane == 0) ((float*)(ws + WS_PEB))[o] = s; }
    for (int m0 = 2 * gw; m0 < MT; m0 += 2 * NGW) {
        f32x4 v[2][4]; float s[2];
#pragma unroll
        for (int r = 0; r < 2; ++r) { const int m = m0 + r; const float* xrow = m < MP ? A.in[I_XP] + (size_t)m * DM : A.in[I_XS] + (size_t)(m - MP) * DM;
            const GAS f32x4* xr = (const GAS f32x4*)xrow + F.lane;
#pragma unroll
            for (int j = 0; j < 4; ++j) v[r][j] = xr[64 * j]; }
#pragma unroll
        for (int r = 0; r < 2; ++r) { const int m = m0 + r; s[r] = 0.f;
#pragma unroll
            for (int j = 0; j < 4; ++j) s[r] += (v[r][j].x * v[r][j].x + v[r][j].y * v[r][j].y) + (v[r][j].z * v[r][j].z + v[r][j].w * v[r][j].w);
            s[r] = wave_sum(s[r]);
            GAS v2u* o8 = (GAS v2u*)((bf16*)(ws + WS_XB) + (size_t)m * DM) + F.lane;
#pragma unroll
            for (int j = 0; j < 4; ++j) { v2u wv; wv.x = pk2(v[r][j].x, v[r][j].y); wv.y = pk2(v[r][j].z, v[r][j].w); o8[64 * j] = wv; }
            if (F.lane == 0) ((float*)(ws + WS_RSTD0))[m] = __builtin_amdgcn_rsqf(s[r] * (1.0f / DM) + RMS_EPS); }
    }
}
__device__ __forceinline__ void p_wincopy(Frame& F, const Args& A, int cu_lo, int cu_cnt) {
    const int cu = (int)blockIdx.x - cu_lo; if (cu < 0 || cu >= cu_cnt) return;
    const GAS f32x4* src = (const GAS f32x4*)A.in[I_SWIN]; GAS f32x4* dst = (GAS f32x4*)(A.out + O_WINS);
    const size_t per = (size_t)504 * 128, total = (size_t)NBS * per; const size_t gt = (size_t)cu * 512 + F.tid, GT_ = (size_t)cu_cnt * 512;
    for (size_t i = gt; i < total; i += 4 * GT_) { f32x4 v[4];
#pragma unroll
        for (int j = 0; j < 4; ++j) { const size_t ii = i + j * GT_; if (ii < total) { const size_t n = ii / per, rem = ii % per; v[j] = __builtin_nontemporal_load(src + n * (512 * 128) + 8 * 128 + rem); } }
#pragma unroll
        for (int j = 0; j < 4; ++j) { const size_t ii = i + j * GT_; if (ii < total) { const size_t n = ii / per, rem = ii % per; __builtin_nontemporal_store(v[j], dst + n * (512 * 128) + rem); } } }
}
__device__ __forceinline__ void p2_conv(Frame& F, const Args& A, int row_lo, int row_hi, int cu_lo, int cu_cnt) {
    unsigned char* ws = A.ws; const bf16* VB = (const bf16*)(ws + WS_VB); const bf16* BB = (const bf16*)(ws + WS_BB); bf16* Z = (bf16*)(ws + WS_Z);
    const float* cw = A.in[I_ACONV]; const float* sc = A.in[I_SCONV];
    const int cu = (int)blockIdx.x - cu_lo; if (cu < 0 || cu >= cu_cnt) return;
    const size_t gt = (size_t)cu * 512 + F.tid, GT_ = (size_t)cu_cnt * 512, total = (size_t)(row_hi - row_lo) * 128;
    const int c8 = (int)(gt & 127) * 8;
    float cw0[8], cw1[8], cw2[8];
#pragma unroll
    for (int e = 0; e < 8; ++e) { cw0[e] = cw[c8 + e]; cw1[e] = cw[DM + c8 + e]; cw2[e] = cw[2 * DM + c8 + e]; }
    for (size_t i = gt; i < total; i += GT_) {
        const int row = row_lo + (int)(i >> 7); int t, tlen; const float* pre = nullptr;
        if (row < MP) { t = row & (TP - 1); tlen = TP; } else { const int rs = row - MP; t = rs & 7; tlen = TS; pre = sc + (size_t)(rs >> 3) * 2 * DM; }
        const v4u vb = *(const GAS v4u*)(BB + (size_t)row * DM + c8), v2 = *(const GAS v4u*)(VB + (size_t)row * DM + c8);
        float f1[8], f0[8];
        if (t >= 1) { const v4u q = *(const GAS v4u*)(VB + (size_t)(row - 1) * DM + c8);
#pragma unroll
            for (int e = 0; e < 4; ++e) { f1[2 * e] = bf2f(q[e] & 0xffffu); f1[2 * e + 1] = bf2f(q[e] >> 16); } }
        else {
#pragma unroll
            for (int e = 0; e < 8; ++e) f1[e] = pre ? pre[DM + c8 + e] : 0.f; }
        if (t >= 2) { const v4u q = *(const GAS v4u*)(VB + (size_t)(row - 2) * DM + c8);
#pragma unroll
            for (int e = 0; e < 4; ++e) { f0[2 * e] = bf2f(q[e] & 0xffffu); f0[2 * e + 1] = bf2f(q[e] >> 16); } }
        else {
#pragma unroll
            for (int e = 0; e < 8; ++e) f0[e] = pre ? pre[(size_t)t * DM + c8 + e] : 0.f; }
        float z[8], vv[8];
#pragma unroll
        for (int e = 0; e < 4; ++e) { vv[2 * e] = bf2f(v2[e] & 0xffffu); vv[2 * e + 1] = bf2f(v2[e] >> 16); }
#pragma unroll
        for (int e = 0; e < 8; ++e) { const float b = bf2f((vb[e >> 1] >> ((e & 1) * 16)) & 0xffffu);
            z[e] = b * (cw0[e] * f0[e] + cw1[e] * f1[e] + cw2[e] * vv[e]); }
        v4u o; o.x = pk2(z[0], z[1]); o.y = pk2(z[2], z[3]); o.z = pk2(z[4], z[5]); o.w = pk2(z[6], z[7]);
        *(GAS v4u*)(Z + (size_t)row * DM + c8) = o;
        if (t >= tlen - 2) { float* dst = row < MP ? A.out + O_CONVP + ((size_t)(row >> 13) * 2 + (t - (tlen - 2))) * DM + c8
                                                  : A.out + O_CONVS + ((size_t)((row - MP) >> 3) * 2 + (t - (tlen - 2))) * DM + c8;
#pragma unroll
            for (int e = 0; e < 8; ++e) dst[e] = vv[e]; }
    }
}
__device__ __forceinline__ void p_final(Frame& F, const Args& A, int row_lo, int row_hi, int cu_lo, int cu_cnt) {
    const bf16* HB = (const bf16*)(A.ws + WS_HB); const GAS f32x4* fw = (const GAS f32x4*)A.in[I_FNORMW];
    const int cu = (int)blockIdx.x - cu_lo; if (cu < 0 || cu >= cu_cnt) return;
    const int gw = cu * NWAVES + F.wave, NGW = cu_cnt * NWAVES;
    f32x4 w[4];
#pragma unroll
    for (int j = 0; j < 4; ++j) w[j] = fw[4 * F.lane + j];
    for (int m = row_lo + gw; m < row_hi; m += NGW) {
        const GAS v4u* xr = (const GAS v4u*)(HB + (size_t)m * DM) + 2 * F.lane; const v4u a = xr[0], b = xr[1]; f32x4 v[4]; float s = 0.f;
        v[0] = (f32x4){bf2f(a.x & 0xffffu), bf2f(a.x >> 16), bf2f(a.y & 0xffffu), bf2f(a.y >> 16)}; v[1] = (f32x4){bf2f(a.z & 0xffffu), bf2f(a.z >> 16), bf2f(a.w & 0xffffu), bf2f(a.w >> 16)};
        v[2] = (f32x4){bf2f(b.x & 0xffffu), bf2f(b.x >> 16), bf2f(b.y & 0xffffu), bf2f(b.y >> 16)}; v[3] = (f32x4){bf2f(b.z & 0xffffu), bf2f(b.z >> 16), bf2f(b.w & 0xffffu), bf2f(b.w >> 16)};
#pragma unroll
        for (int j = 0; j < 4; ++j) s += (v[j].x * v[j].x + v[j].y * v[j].y) + (v[j].z * v[j].z + v[j].w * v[j].w);
        const float r = __builtin_amdgcn_rsqf(wave_sum(s) * (1.0f / DM) + RMS_EPS);
        GAS f32x4* o = (GAS f32x4*)(A.out + (m < MP ? O_YP + (size_t)m * DM : O_YS + (size_t)(m - MP) * DM)) + 4 * F.lane;
#pragma unroll
        for (int j = 0; j < 4; ++j) o[j] = v[j] * r * w[j];
    }
}
__device__ __forceinline__ void p_zero16(Frame& F, void* p, size_t bytes) {
    GAS v4u* d = (GAS v4u*)p; const size_t n = bytes / 16, gt = (size_t)F.vcu * 512 + F.tid, GT_ = (size_t)F.G * 512;
    for (size_t i = gt; i < n; i += GT_) d[i] = (v4u){0u, 0u, 0u, 0u};
}
constexpr int P7_IMG_BYTES = 144 * 512, P7_HID = 2 * P7_IMG_BYTES, P7_HID_STRIDE = 144;
static_assert(P7_HID + 32 * P7_HID_STRIDE <= RING_BYTES, "compress LDS");
__device__ __forceinline__ int p7_swz(int pos_l, int g, int dchunk) { return pos_l * 512 + g * 128 + ((dchunk ^ ((pos_l >> 4) & 3) ^ ((g >> 1) << 2)) << 4); }
struct P7Unit { int isp, seq, seg; };
__device__ __forceinline__ bool p7_unit(int i, int cu2, int ncu2, P7Unit& U) {
    if (i == 0) { if (cu2 >= NBP * 64) return false; U.isp = 1; U.seq = cu2 >> 6; U.seg = cu2 & 63; return true; }
    const int v = (i - 1) * ncu2 + cu2; if (v >= NBS * NPAGE) return false; U.isp = 0; U.seq = v >> 4; U.seg = v & 15; return true;
}
struct P7Batch { f32x4 a[3], b[3]; };
template <int C0, int NCH> __device__ __forceinline__ void p7_load(P7Batch& R, const P7Unit& U, int k, const Args& A, int tid) {
    asm volatile("" : "+v"(tid));
    const int pos0 = U.seg * 128;
    if (U.isp) { const bf16* KVB = (const bf16*)(A.ws + WS_KVB);
#pragma unroll
        for (int i = 0; i < NCH; ++i) { const int c = tid + (C0 + i) * 512, pos_l = c >> 5, g = (c >> 3) & 3, dc = c & 7, pos = pos0 + pos_l; v4u r = (v4u){0u, 0u, 0u, 0u};
            if (pos < TP) r = *(const GAS v4u*)(KVB + ((size_t)U.seq * TP + pos) * NKV + k * 256 + g * 64 + dc * 8);
            R.a[i] = __builtin_bit_cast(f32x4, r); }
    } else { const int* ptab = (const int*)A.in[I_PT]; const float* cache = A.in[I_CCMP];
        const int pgA = ptab[U.seq * NPAGE + U.seg], pgB = U.seg < 15 ? ptab[U.seq * NPAGE + U.seg + 1] : 0;
#pragma unroll
        for (int i = 0; i < NCH; ++i) { const int c = tid + (C0 + i) * 512, pos_l = c >> 5, g = (c >> 3) & 3, dc = c & 7, pos = pos0 + pos_l;
            R.a[i] = (f32x4){0.f, 0.f, 0.f, 0.f}; R.b[i] = R.a[i];
            if (pos < PAST) { const float* s = cache + ((size_t)(pos_l < 128 ? pgA : pgB) * PAGE + (pos_l & 127)) * 512 + k * 256 + g * 64 + dc * 8; R.a[i] = *(const GAS f32x4*)s; R.b[i] = *(const GAS f32x4*)(s + 4); } }
    }
}
template <int C0, int NCH> __device__ __forceinline__ void p7_store(const P7Batch& R, const P7Unit& U, LAS unsigned char* img, int tid) {
    asm volatile("" : "+v"(tid));
#pragma unroll
    for (int i = 0; i < NCH; ++i) { const int c = tid + (C0 + i) * 512, pos_l = c >> 5, g = (c >> 3) & 3, dc = c & 7; v4u o;
        if (U.isp) o = __builtin_bit_cast(v4u, R.a[i]);
        else { o.x = pg8::cvt_pk_bf16(R.a[i][0], R.a[i][1]); o.y = pg8::cvt_pk_bf16(R.a[i][2], R.a[i][3]); o.z = pg8::cvt_pk_bf16(R.b[i][0], R.b[i][1]); o.w = pg8::cvt_pk_bf16(R.b[i][2], R.b[i][3]); }
        *(LAS v4u*)(img + p7_swz(pos_l, g, dc)) = o; }
}
__device__ __forceinline__ void p7_compress(Frame& F, const Args& A, int mode, int budget) {
    unsigned char* ws = A.ws; LAS unsigned char* L = F.lds + RING_OFF; LAS unsigned char* hidp = L + P7_HID;
    const bf16* W1T = (const bf16*)(ws + WS_W1T); const bf16* W2T = (const bf16*)(ws + WS_W2T); const float* PEB = (const float*)(ws + WS_PEB);
    const int lane = F.lane, w = F.wave, tid = F.tid, l15 = lane & 15, lq = lane >> 4;
    const int k = F.vcu & 1, cu2 = F.vcu >> 1, ncu2 = (F.G + 1 - k) >> 1;
    constexpr int NTK = NBS * NPAGE;
    unsigned* qctr = (unsigned*)(F.ctl + CW_Q7 + 64 * k);
    P7Unit U, Un; P7Batch R; bool have; int tnext = NTK, tnext2 = NTK;
    if (mode == 0) { have = p7_unit(0, cu2, ncu2, U); }
    else {
        if (budget <= 0) return;
        const unsigned n0 = budget >= 3 ? 3u : (unsigned)budget;
        if (tid == 0) F.MISC[17] = __hip_atomic_fetch_add(qctr, n0, __ATOMIC_RELAXED, __HIP_MEMORY_SCOPE_AGENT);
        __syncthreads();
        const int t0 = (int)F.MISC[17];
        __syncthreads();
        have = t0 < NTK; U.isp = 0; U.seq = t0 >> 4; U.seg = t0 & 15;
        if (n0 >= 2 && t0 + 1 < NTK) tnext = t0 + 1;
        if (n0 >= 3 && t0 + 2 < NTK) tnext2 = t0 + 2;
    }
    if (!have) return;
    bf16x8 bw[8][4];
#pragma unroll
    for (int kl = 0; kl < 8; ++kl)
#pragma unroll
        for (int nt = 0; nt < 4; ++nt) bw[kl][nt] = *(const GAS bf16x8*)(W1T + ((size_t)(k * 64 + nt * 16 + l15)) * 2048 + (8 * w + kl) * 32 + lq * 8);
    p7_load<0, 3>(R, U, k, A, tid); p7_store<0, 3>(R, U, L, tid); p7_load<3, 3>(R, U, k, A, tid); p7_store<3, 3>(R, U, L, tid); p7_load<6, 3>(R, U, k, A, tid); p7_store<6, 3>(R, U, L, tid);
    __syncthreads();
    int buf = 0, nrun = 0;
    while (have) {
        LAS unsigned char* img = L + buf * P7_IMG_BYTES; LAS unsigned char* nimg = L + (buf ^ 1) * P7_IMG_BYTES; LAS float* red = (LAS float*)img;
        const bool hn = tnext < NTK; Un.isp = 0; Un.seq = tnext >> 4; Un.seg = tnext & 15;
        const bool want3 = mode == 1 && tnext2 < NTK && nrun + 3 < budget; unsigned tk = 0u;
        if (want3 && tid == 0) tk = __hip_atomic_fetch_add(qctr, 1u, __ATOMIC_RELAXED, __HIP_MEMORY_SCOPE_AGENT);
        const int ntok = (U.isp ? U.seg == 63 : U.seg == 15) ? 7 : 8;
        f32x4 acc[2][4];
#pragma unroll
        for (int a = 0; a < 2; ++a)
#pragma unroll
            for (int b = 0; b < 4; ++b) acc[a][b] = (f32x4){0.f, 0.f, 0.f, 0.f};
        if (hn) p7_load<0, 3>(R, Un, k, A, tid);
#pragma unroll
        for (int kl = 0; kl < 8; ++kl) { const int ks = 8 * w + kl, j = ks >> 1, dh = ks & 1; bf16x8 afr[2];
            if (kl == 3 && hn) { p7_store<0, 3>(R, Un, nimg, tid); p7_load<3, 3>(R, Un, k, A, tid); }
            if (kl == 6 && hn) { p7_store<3, 3>(R, Un, nimg, tid); p7_load<6, 3>(R, Un, k, A, tid); }
#pragma unroll
            for (int mt = 0; mt < 2; ++mt) { const int tok = mt * 4 + (l15 >> 2), g = l15 & 3, pos_l = 16 * tok + j; afr[mt] = *(const LAS bf16x8*)(img + p7_swz(pos_l, g, dh * 4 + lq)); }
#pragma unroll
            for (int mt = 0; mt < 2; ++mt)
#pragma unroll
                for (int nt = 0; nt < 4; ++nt) acc[mt][nt] = __builtin_amdgcn_mfma_f32_16x16x32_bf16(afr[mt], bw[kl][nt], acc[mt][nt], 0, 0, 0);
        }
        if (hn) p7_store<6, 3>(R, Un, nimg, tid);
        __syncthreads();
#pragma unroll
        for (int mt = 0; mt < 2; ++mt)
#pragma unroll
            for (int nt = 0; nt < 4; ++nt)
#pragma unroll
                for (int rg = 0; rg < 4; ++rg) red[(w * 32 + mt * 16 + 4 * lq + rg) * 64 + nt * 16 + l15] = acc[mt][nt][rg];
        if (want3 && tid == 0) F.MISC[17] = tk;
        __syncthreads();
        { const int row = tid >> 4, col = (tid & 15) * 4; f32x4 s = *(const LAS f32x4*)(red + row * 64 + col);
#pragma unroll
            for (int ww = 1; ww < 8; ++ww) s += *(const LAS f32x4*)(red + (ww * 32 + row) * 64 + col);
            const f32x4 pb = *(const GAS f32x4*)(PEB + k * 64 + col); float h[4];
#pragma unroll
            for (int e = 0; e < 4; ++e) { const float x = s[e] + pb[e]; h[e] = x * __builtin_amdgcn_rcpf(1.0f + __builtin_amdgcn_exp2f(x * -1.4426950408889634f)); }
            v2u o; o.x = pg8::cvt_pk_bf16(h[0], h[1]); o.y = pg8::cvt_pk_bf16(h[2], h[3]); *(LAS v2u*)(hidp + row * P7_HID_STRIDE + col * 2) = o; }
        const int t3 = want3 ? (int)F.MISC[17] : NTK;
        __syncthreads();
        { const int mt = w >> 2, nt = w & 3; f32x4 a2 = (f32x4){0.f, 0.f, 0.f, 0.f};
#pragma unroll
            for (int k2 = 0; k2 < 2; ++k2) { const bf16x8 af = *(const LAS bf16x8*)(hidp + (mt * 16 + l15) * P7_HID_STRIDE + k2 * 64 + lq * 16);
                const bf16x8 bf = *(const GAS bf16x8*)(W2T + ((size_t)(k * 64 + nt * 16 + l15)) * 64 + k2 * 32 + lq * 8);
                a2 = __builtin_amdgcn_mfma_f32_16x16x32_bf16(af, bf, a2, 0, 0, 0); }
            const int tok = mt * 4 + lq; bf16* kc = U.isp ? (bf16*)(ws + WS_KCP) + (((size_t)U.seq * 512 + U.seg * 8 + tok) * 2 + k) * 256 : (bf16*)(ws + WS_KCS) + (((size_t)U.seq * 128 + U.seg * 8 + tok) * 2 + k) * 256;
#pragma unroll
            for (int rg = 0; rg < 4; ++rg) kc[rg * 64 + nt * 16 + l15] = (bf16)(tok < ntok ? f2bf(a2[rg]) : 0u); }
        U = Un; have = hn; tnext = tnext2; tnext2 = t3 < NTK ? t3 : NTK; ++nrun; buf ^= 1;
    }
    __syncthreads();
}
constexpr int KT_STRIDE = 144, VT_STRIDE = 160;
constexpr float S_NEG = -1.0e30f, M_INIT = -1000.0f, RESC_THR = 8.0f;
typedef short s16x4 __attribute__((ext_vector_type(4)));
struct AttState { float m[2], l[2]; f32x4 o[2][4]; f32x4 lo[2]; };
__device__ __forceinline__ void att_init(AttState& st) {
#pragma unroll
    for (int c = 0; c < 2; ++c) { st.m[c] = M_INIT; st.l[c] = 0.f; st.lo[c] = (f32x4){0.f, 0.f, 0.f, 0.f};
#pragma unroll
        for (int d = 0; d < 4; ++d) st.o[c][d] = (f32x4){0.f, 0.f, 0.f, 0.f}; }
}
__device__ __forceinline__ s16x4 tr_read(const LAS unsigned char* p) { return __builtin_bit_cast(s16x4, __builtin_amdgcn_ds_read_tr16_b64_v4i16((LAS s16x4*)p)); }
template <int NKT, int MODE>
__device__ __forceinline__ void wave_block(const LAS unsigned char* kt, const LAS unsigned char* vt, const bf16x8 (&qf)[2][2], AttState& st, const float (&bias)[2], const bool (&act)[2],
                                           bool boundary, const int (&lo)[2], const int (&hi)[2], int lane, LAS float* imp_row0, int imp_blk0, int imp_stride) {
    const int l15 = lane & 15, lq = lane >> 4;
    if (!act[0] && !act[1]) return;
    bf16x8 kf[NKT][2];
#pragma unroll
    for (int t = 0; t < NKT; ++t)
#pragma unroll
        for (int ks = 0; ks < 2; ++ks) kf[t][ks] = *(const LAS bf16x8*)(kt + (t * 16 + l15) * KT_STRIDE + ks * 64 + lq * 16);
    bf16x8 pfr[2][NKT / 2];
#pragma unroll
    for (int c = 0; c < 2; ++c) {
        if (!act[c]) continue;
        const float c0 = bias[c] - st.m[c];
        f32x4 s[NKT];
#pragma unroll
        for (int t = 0; t < NKT; ++t) { s[t] = (f32x4){c0, c0, c0, c0};
            s[t] = __builtin_amdgcn_mfma_f32_16x16x32_bf16(kf[t][0], qf[c][0], s[t], 0, 0, 0);
            s[t] = __builtin_amdgcn_mfma_f32_16x16x32_bf16(kf[t][1], qf[c][1], s[t], 0, 0, 0); }
        if (boundary) { const int l2 = lo[c] - 4 * lq, h2 = hi[c] - 4 * lq;
#pragma unroll
            for (int t = 0; t < NKT; ++t)
#pragma unroll
                for (int r = 0; r < 4; ++r) { const int kk = t * 16 + r; if (kk < l2 || kk > h2) s[t][r] = S_NEG; } }
        float mx = s[0][0];
#pragma unroll
        for (int t = 0; t < NKT; ++t)
#pragma unroll
            for (int r = 0; r < 4; ++r) mx = fmaxf(mx, s[t][r]);
        mx = fmaxf(mx, __shfl_xor(mx, 16)); mx = fmaxf(mx, __shfl_xor(mx, 32));
        if (MODE == 1) {
            const float dl = fmaxf(mx, 0.f), f = __builtin_amdgcn_exp2f(-dl); st.m[c] += dl; float a = 0.f;
#pragma unroll
            for (int t = 0; t < NKT; ++t)
#pragma unroll
                for (int r = 0; r < 4; ++r) a += __builtin_amdgcn_exp2f(s[t][r] - dl);
            st.l[c] = st.l[c] * f + a;
            continue;
        }
        if (MODE == 0) {
            if (__any(mx > RESC_THR)) {
                const float dl = fmaxf(mx, 0.f), f = __builtin_amdgcn_exp2f(-dl); st.m[c] += dl; st.l[c] *= f;
#pragma unroll
                for (int t = 0; t < NKT; ++t) s[t] = s[t] - dl;
#pragma unroll
                for (int r = 0; r < 4; ++r) { const float fr = __shfl(f, 4 * lq + r);
#pragma unroll
                    for (int dt = 0; dt < 4; ++dt) st.o[c][dt][r] *= fr; }
            }
        }
        float a = 0.f;
#pragma unroll
        for (int t = 0; t < NKT; ++t)
#pragma unroll
            for (int r = 0; r < 4; ++r) { s[t][r] = __builtin_amdgcn_exp2f(s[t][r]); a += s[t][r]; }
        if (MODE == 0) st.l[c] += a;
        if (MODE == 2) {
            const float li = st.l[c];
#pragma unroll
            for (int t = 0; t < NKT; ++t) { s[t] = s[t] * li;
                float ia = 2.f * (s[t][0] + s[t][1] + s[t][2]) + s[t][3], ib = s[t][3];
                ia += __shfl_xor(ia, 1); ia += __shfl_xor(ia, 2); ib += __shfl_xor(ib, 1); ib += __shfl_xor(ib, 2);
                if ((l15 & 3) == 0) { LAS float* ir = imp_row0 + (c * 4 + (l15 >> 2)) * imp_stride + imp_blk0 + 4 * t + lq; atomicAdd((float*)ir, ia); atomicAdd((float*)(ir + 1), ib); } }
        }
#pragma unroll
        for (int G = 0; G < NKT / 2; ++G) {
            v4u pw; pw.x = pg8::cvt_pk_bf16(s[2 * G][0], s[2 * G][1]); pw.y = pg8::cvt_pk_bf16(s[2 * G][2], s[2 * G][3]); pw.z = pg8::cvt_pk_bf16(s[2 * G + 1][0], s[2 * G + 1][1]); pw.w = pg8::cvt_pk_bf16(s[2 * G + 1][2], s[2 * G + 1][3]);
            pfr[c][G] = __builtin_bit_cast(bf16x8, pw); }
    }
    if (MODE == 1) return;
    asm volatile("" ::: "memory");
    const LAS unsigned char* vb = vt + (4 * lq + (l15 >> 2)) * VT_STRIDE + (l15 & 3) * 8;
#pragma unroll
    for (int G = 0; G < NKT / 2; ++G) {
        bf16x8 vf[4];
#pragma unroll
        for (int dt = 0; dt < 4; ++dt) { const s16x4 a = tr_read(vb + (32 * G) * VT_STRIDE + dt * 32), b = tr_read(vb + (32 * G + 16) * VT_STRIDE + dt * 32);
            vf[dt] = (bf16x8){a[0], a[1], a[2], a[3], b[0], b[1], b[2], b[3]}; }
#pragma unroll
        for (int c = 0; c < 2; ++c) { if (!act[c]) continue;
#pragma unroll
            for (int dt = 0; dt < 4; ++dt) st.o[c][dt] = __builtin_amdgcn_mfma_f32_16x16x32_bf16(pfr[c][G], vf[dt], st.o[c][dt], 0, 0, 0); }
        asm volatile("" ::: "memory");
    }
}
__device__ __forceinline__ void att_finish(const AttState& st, int c, int lane, float (&linv)[4]) {
    float l = st.l[c]; l += __shfl_xor(l, 16); l += __shfl_xor(l, 32);
    const float li = 1.0f / fmaxf(l, 1e-30f);
#pragma unroll
    for (int r = 0; r < 4; ++r) linv[r] = __shfl(li, 4 * (lane >> 4) + r);
}
__device__ __forceinline__ void select_blocks(float v0, float v1, int cur, int lane, unsigned long long& sel0, unsigned long long& sel1) {
    const unsigned k0 = __float_as_uint(v0), k1 = __float_as_uint(v1);
    const bool e0 = lane >= 1 && lane <= cur - 2, e1 = (lane + 64) <= cur - 2;
    const int nforced = cur >= 2 ? 3 : cur + 1, need = 16 - nforced, nelig = cur - 2 > 0 ? cur - 2 : 0;
    unsigned long long s0 = 1ull, s1 = 0ull;
    if (cur < 64) s0 |= 1ull << cur; else s1 |= 1ull << (cur - 64);
    if (cur >= 1) { if (cur - 1 < 64) s0 |= 1ull << (cur - 1); else s1 |= 1ull << (cur - 65); }
    if (nelig <= need) { s0 |= __ballot(e0); s1 |= __ballot(e1); }
    else {
        unsigned T = 0u;
        for (int bit = 30; bit >= 0; --bit) { const unsigned cand = T | (1u << bit);
            const int cnt = __popcll(__ballot(e0 && k0 >= cand)) + __popcll(__ballot(e1 && k1 >= cand));
            if (cnt >= need) T = cand; }
        const unsigned long long g0 = __ballot(e0 && k0 > T), g1 = __ballot(e1 && k1 > T);
        unsigned long long q0 = __ballot(e0 && k0 == T), q1 = __ballot(e1 && k1 == T);
        int rem = need - (__popcll(g0) + __popcll(g1));
        s0 |= g0; s1 |= g1;
        while (rem > 0 && (q0 | q1)) { if (q0) { const unsigned long long b = q0 & (~q0 + 1ull); s0 |= b; q0 ^= b; } else { const unsigned long long b = q1 & (~q1 + 1ull); s1 |= b; q1 ^= b; } --rem; }
    }
    sel0 = s0; sel1 = s1;
}

__device__ __forceinline__ void select_blocks4(const float (&v0)[4], const float (&v1)[4], int cur, int lane, unsigned long long (&sel0)[4], unsigned long long (&sel1)[4]) {
    const bool e0 = lane >= 1 && lane <= cur - 2, e1 = (lane + 64) <= cur - 2;
    const int nforced = cur >= 2 ? 3 : cur + 1, need = 16 - nforced, nelig = cur - 2 > 0 ? cur - 2 : 0;
    unsigned long long f0 = 1ull, f1 = 0ull;
    if (cur < 64) f0 |= 1ull << cur; else f1 |= 1ull << (cur - 64);
    if (cur >= 1) { if (cur - 1 < 64) f0 |= 1ull << (cur - 1); else f1 |= 1ull << (cur - 65); }
    if (nelig <= need) { const unsigned long long a = f0 | __ballot(e0), b = f1 | __ballot(e1);
#pragma unroll
        for (int t = 0; t < 4; ++t) { sel0[t] = a; sel1[t] = b; }
        return; }
    unsigned k0[4], k1[4], T[4];
#pragma unroll
    for (int t = 0; t < 4; ++t) { k0[t] = __float_as_uint(v0[t]); k1[t] = __float_as_uint(v1[t]); T[t] = 0u; }
    for (int bit = 30; bit >= 0; --bit) {
#pragma unroll
        for (int t = 0; t < 4; ++t) { const unsigned cand = T[t] | (1u << bit);
            const int cnt = __popcll(__ballot(e0 && k0[t] >= cand)) + __popcll(__ballot(e1 && k1[t] >= cand));
            if (cnt >= need) T[t] = cand; } }
#pragma unroll
    for (int t = 0; t < 4; ++t) {
        const unsigned long long g0 = __ballot(e0 && k0[t] > T[t]), g1 = __ballot(e1 && k1[t] > T[t]);
        unsigned long long q0 = __ballot(e0 && k0[t] == T[t]), q1 = __ballot(e1 && k1[t] == T[t]);
        int rem = need - (__popcll(g0) + __popcll(g1)); unsigned long long s0 = f0 | g0, s1 = f1 | g1;
        while (rem > 0 && (q0 | q1)) { if (q0) { const unsigned long long b = q0 & (~q0 + 1ull); s0 |= b; q0 ^= b; } else { const unsigned long long b = q1 & (~q1 + 1ull); s1 |= b; q1 ^= b; } --rem; }
        sel0[t] = s0; sel1[t] = s1; }
}
__device__ __forceinline__ unsigned pick4(const unsigned (&a)[4], int i) { return i == 0 ? a[0] : i == 1 ? a[1] : i == 2 ? a[2] : a[3]; }
constexpr int P8_GB = 65536, P8_SELB = 2 * P8_GB, P8_IMP = P8_GB  , P8_END = P8_SELB + 64 * 16;
static_assert(P8_END <= RING_BYTES && 64 * 132 * 4 <= P8_GB, "attention LDS");
__device__ __forceinline__ float amax3(float a, float b, float c) { float r; asm("v_max3_f32 %0, %1, %2, %3" : "=v"(r) : "v"(a), "v"(b), "v"(c)); return r; }
__device__ __forceinline__ float amax2(float a, float b) { float r; asm("v_max_f32_e32 %0, %1, %2" : "=v"(r) : "v"(a), "v"(b)); return r; }
__device__ __forceinline__ float rowmax4(float x) {
    auto r = __builtin_amdgcn_permlane16_swap(__float_as_uint(x), __float_as_uint(x), false, false); x = amax2(__uint_as_float(r[0]), __uint_as_float(r[1]));
    auto q = __builtin_amdgcn_permlane32_swap(__float_as_uint(x), __float_as_uint(x), false, false); return amax2(__uint_as_float(q[0]), __uint_as_float(q[1]));
}
__device__ __forceinline__ float rowsum4(float x) {
    auto r = __builtin_amdgcn_permlane16_swap(__float_as_uint(x), __float_as_uint(x), false, false); x = __uint_as_float(r[0]) + __uint_as_float(r[1]);
    auto q = __builtin_amdgcn_permlane32_swap(__float_as_uint(x), __float_as_uint(x), false, false); return __uint_as_float(q[0]) + __uint_as_float(q[1]);
}
__device__ __forceinline__ float quad_sum(float x) {
    x += __builtin_bit_cast(float, __builtin_amdgcn_mov_dpp(__builtin_bit_cast(int, x), 0xB1, 0xF, 0xF, true));
    x += __builtin_bit_cast(float, __builtin_amdgcn_mov_dpp(__builtin_bit_cast(int, x), 0x4E, 0xF, 0xF, true));
    return x;
}
struct TileAddr { int kofs[2]; int vofs[4]; };
__device__ __forceinline__ void tile_addr(TileAddr& T, int lane) {
    const int l15 = lane & 15, lq = lane >> 4, qp = l15 >> 2, p = l15 & 3, r7 = ((lq & 1) << 2) | qp;
#pragma unroll
    for (int ks = 0; ks < 2; ++ks) T.kofs[ks] = l15 * 128 + (((ks * 4 + lq) ^ (l15 & 7)) << 4);
#pragma unroll
    for (int dt = 0; dt < 4; ++dt) T.vofs[dt] = (4 * lq + qp) * 128 + (((dt * 2 + (p >> 1)) ^ r7) << 4) + (p & 1) * 8;
}
template <int MODE>
__device__ __forceinline__ void wave_block2(const LAS unsigned char* kt, const LAS unsigned char* vt, const TileAddr& T, const bf16x8 (&qf)[2][2], AttState& st, const float (&bias)[2], const bool (&act)[2],
                                            bool boundary, const int (&lo)[2], const int (&hi)[2], int lane, LAS float* imp_row0, int imp_blk0, int imp_stride) {
    const int l15 = lane & 15, lq = lane >> 4;
    if (!act[0] && !act[1]) return;
    bf16x8 kf[4][2];
#pragma unroll
    for (int t = 0; t < 4; ++t)
#pragma unroll
        for (int ks = 0; ks < 2; ++ks) kf[t][ks] = *(const LAS bf16x8*)(kt + t * 2048 + T.kofs[ks]);
    f32x4 s[2][4];
#pragma unroll
    for (int c = 0; c < 2; ++c) { if (!act[c]) continue;
        const float c0 = MODE == 2 ? (bias[c] - st.m[c]) + st.l[c] : bias[c] - st.m[c];
#pragma unroll
        for (int t = 0; t < 4; ++t) { s[c][t] = (f32x4){c0, c0, c0, c0};
            s[c][t] = __builtin_amdgcn_mfma_f32_16x16x32_bf16(kf[t][0], qf[c][0], s[c][t], 0, 0, 0);
            s[c][t] = __builtin_amdgcn_mfma_f32_16x16x32_bf16(kf[t][1], qf[c][1], s[c][t], 0, 0, 0); } }
    bf16x8 vf[2][4];
    if (MODE != 1) {
#pragma unroll
        for (int G = 0; G < 2; ++G)
#pragma unroll
            for (int dt = 0; dt < 4; ++dt) { const s16x4 a = tr_read(vt + G * 4096 + T.vofs[dt]), b = tr_read(vt + G * 4096 + 2048 + T.vofs[dt]);
                vf[G][dt] = (bf16x8){a[0], a[1], a[2], a[3], b[0], b[1], b[2], b[3]}; }
    }
    bf16x8 pfr[2][2];
#pragma unroll
    for (int c = 0; c < 2; ++c) {
        if (!act[c]) continue;
        if (boundary) { const int l2 = lo[c] - 4 * lq, h2 = hi[c] - 4 * lq;
#pragma unroll
            for (int t = 0; t < 4; ++t)
#pragma unroll
                for (int r = 0; r < 4; ++r) { const int kk = t * 16 + r; if (kk < l2 || kk > h2) s[c][t][r] = S_NEG; } }
        float mx;
        asm("v_max3_f32 %0, %1, %2, %3\n\tv_max3_f32 %0, %0, %4, %5\n\tv_max3_f32 %0, %0, %6, %7\n\tv_max3_f32 %0, %0, %8, %9\n\tv_max3_f32 %0, %0, %10, %11\n\t"
            "v_max3_f32 %0, %0, %12, %13\n\tv_max3_f32 %0, %0, %14, %15\n\tv_max_f32_e32 %0, %0, %16"
            : "=&v"(mx) : "v"(s[c][0][0]), "v"(s[c][0][1]), "v"(s[c][0][2]), "v"(s[c][0][3]), "v"(s[c][1][0]), "v"(s[c][1][1]), "v"(s[c][1][2]), "v"(s[c][1][3]),
                          "v"(s[c][2][0]), "v"(s[c][2][1]), "v"(s[c][2][2]), "v"(s[c][2][3]), "v"(s[c][3][0]), "v"(s[c][3][1]), "v"(s[c][3][2]), "v"(s[c][3][3]));
        if (MODE != 0) mx = rowmax4(mx);
        if (MODE == 1) {
            if (__any(mx > RESC_THR)) { const float dl = fmaxf(mx, 0.f), f = __builtin_amdgcn_exp2f(-dl); st.m[c] += dl; st.l[c] *= f;
#pragma unroll
                for (int t = 0; t < 4; ++t) s[c][t] = s[c][t] - dl; }
            float a = 0.f;
#pragma unroll
            for (int t = 0; t < 4; ++t)
#pragma unroll
                for (int r = 0; r < 4; ++r) a += __builtin_amdgcn_exp2f(s[c][t][r]);
            st.l[c] += a;
            continue;
        }
        if (MODE == 0) {
            if (__any(mx > RESC_THR)) {
                mx = rowmax4(mx);
                const float dl = fmaxf(mx, 0.f), f = __builtin_amdgcn_exp2f(-dl); st.m[c] += dl;
#pragma unroll
                for (int t = 0; t < 4; ++t) s[c][t] = s[c][t] - dl;
#pragma unroll
                for (int r = 0; r < 4; ++r) { const float fr = __shfl(f, 4 * lq + r); st.lo[c][r] *= fr;
#pragma unroll
                    for (int dt = 0; dt < 4; ++dt) st.o[c][dt][r] *= fr; }
            }
        }
#pragma unroll
        for (int t = 0; t < 4; ++t)
#pragma unroll
            for (int r = 0; r < 4; ++r) s[c][t][r] = __builtin_amdgcn_exp2f(s[c][t][r]);
        if (MODE == 2) {
#pragma unroll
            for (int t = 0; t < 4; ++t) {
                float ia = 2.f * (s[c][t][0] + s[c][t][1] + s[c][t][2]) + s[c][t][3], ib = s[c][t][3];
                ia = quad_sum(ia); ib = quad_sum(ib);
                if ((l15 & 3) == 0) { LAS float* ir = imp_row0 + (c * 4 + (l15 >> 2)) * imp_stride + imp_blk0 + 4 * t + lq; atomicAdd((float*)ir, ia); atomicAdd((float*)(ir + 1), ib); } }
        }
#pragma unroll
        for (int G = 0; G < 2; ++G) {
            v4u pw; pw.x = pg8::cvt_pk_bf16(s[c][2 * G][0], s[c][2 * G][1]); pw.y = pg8::cvt_pk_bf16(s[c][2 * G][2], s[c][2 * G][3]); pw.z = pg8::cvt_pk_bf16(s[c][2 * G + 1][0], s[c][2 * G + 1][1]); pw.w = pg8::cvt_pk_bf16(s[c][2 * G + 1][2], s[c][2 * G + 1][3]);
            pfr[c][G] = __builtin_bit_cast(bf16x8, pw); }
    }
    if (MODE == 1) return;
#pragma unroll
    for (int G = 0; G < 2; ++G)
#pragma unroll
        for (int c = 0; c < 2; ++c) { if (!act[c]) continue;
#pragma unroll
            for (int dt = 0; dt < 4; ++dt) st.o[c][dt] = __builtin_amdgcn_mfma_f32_16x16x32_bf16(pfr[c][G], vf[G][dt], st.o[c][dt], 0, 0, 0);
            if (MODE == 0) { const v4u ow = (v4u){0x3f803f80u, 0x3f803f80u, 0x3f803f80u, 0x3f803f80u};
                st.lo[c] = __builtin_amdgcn_mfma_f32_16x16x32_bf16(pfr[c][G], __builtin_bit_cast(bf16x8, ow), st.lo[c], 0, 0, 0); } }
}
__device__ __forceinline__ void glds16(const void* gsrc, unsigned lds_dst) { unsigned keep;
    asm volatile("s_mov_b32 %0, m0\n\ts_mov_b32 m0, %2\n\ts_nop 0\n\tglobal_load_lds_dwordx4 %1, off\n\ts_mov_b32 m0, %0" : "=&s"(keep) : "v"(gsrc), "s"(lds_dst) : "memory"); }
__device__ __forceinline__ void p8_dma_group(const bf16* kbase, const bf16* vbase, size_t row_stride, int blk0, int nblk, LAS unsigned char* gb, int w, int lane) {
    asm volatile("" : "+v"(lane));
    const size_t loff = (size_t)(8 * w + (lane >> 3)) * row_stride + (((lane & 7) ^ (lane >> 3)) << 3);
#pragma unroll
    for (int i = 0; i < 4; ++i) { const int blk = blk0 + (i < nblk ? i : nblk - 1); const size_t boff = (size_t)blk * 64 * row_stride + loff;
        glds16(kbase + boff, (unsigned)__builtin_amdgcn_readfirstlane((unsigned)(uintptr_t)(gb + i * 16384 + w * 1024)));
        glds16(vbase + boff, (unsigned)__builtin_amdgcn_readfirstlane((unsigned)(uintptr_t)(gb + i * 16384 + 8192 + w * 1024))); }
}
#define P8_WAITV(n) asm volatile("s_waitcnt vmcnt(" #n ")" ::: "memory")
#define P8_BARRIER() do { asm volatile("s_waitcnt lgkmcnt(0)" ::: "memory"); __builtin_amdgcn_s_barrier(); asm volatile("" ::: "memory"); } while (0)

__device__ __forceinline__ void p8_prompt_unit(Frame& F, const Args& A, int b, int qb, int g) {
    unsigned char* ws = A.ws; const bf16* KVB = (const bf16*)(ws + WS_KVB); const bf16* QB = (const bf16*)(ws + WS_QB); const bf16* KCP = (const bf16*)(ws + WS_KCP);
    const float* GT = (const float*)(ws + WS_GT); bf16* O = (bf16*)(ws + WS_O);
    LAS unsigned char* L = F.lds + RING_OFF; LAS float* IMP = (LAS float*)(L + P8_IMP); LAS unsigned* SELB = (LAS unsigned*)(L + P8_SELB);
    const int lane = F.lane, w = F.wave, l15 = lane & 15, lq = lane >> 4;
    const size_t rowbase = (size_t)b * TP + (size_t)qb * 64;
    float* OTG = (float*)(ws + WS_OTG) + ((size_t)F.vcu * NWAVES + w) * 2048 + lane;
    TileAddr T; tile_addr(T, lane);
    bf16x8 qf[2][2];
#pragma unroll
    for (int c = 0; c < 2; ++c)
#pragma unroll
        for (int ks = 0; ks < 2; ++ks) qf[c][ks] = *(const GAS bf16x8*)(QB + (rowbase + 8 * w + 4 * c + (l15 >> 2)) * DM + g * 256 + (l15 & 3) * 64 + ks * 32 + lq * 8);
    int tl[2]; tl[0] = 8 * w + (l15 >> 2); tl[1] = tl[0] + 4;
    for (int i = lane; i < 8 * 132; i += 64) IMP[w * 8 * 132 + i] = 0.f;
    AttState st; const float zb[2] = {0.f, 0.f}; const bool on[2] = {true, true};
    auto combine = [&](int br) {
#pragma unroll
        for (int c = 0; c < 2; ++c) { float linv[4];
            if (br == 0) {
#pragma unroll
                for (int r = 0; r < 4; ++r) linv[r] = 1.f; }
            else {
#pragma unroll
                for (int r = 0; r < 4; ++r) linv[r] = 1.0f / fmaxf(st.lo[c][r], 1e-30f); }
#pragma unroll
            for (int r = 0; r < 4; ++r) { const float gt = GT[(rowbase + 8 * w + 4 * c + lq) * 48 + g * 12 + r * 3 + br] * linv[r];
#pragma unroll
                for (int d = 0; d < 4; ++d) { float* p = OTG + ((c * 4 + d) * 4 + r) * 64; const float v = gt * st.o[c][d][r];
                    if (br == 0) *p = v; else if (br == 1) *p += v;
                    else O[(rowbase + 8 * w + 4 * c + lq) * DM + g * 256 + r * 64 + d * 16 + l15] = (bf16)f2bf(*p + v); } } }
    };
    const int ncv = 4 * qb + 3, ncb = (ncv + 63) >> 6, ncg = (ncb + 3) >> 2;
    const bf16* kc0 = KCP + (size_t)b * 512 * 512 + g * 64;
    int clo[2] = {0, 0}, chi[2];
    att_init(st);
    const int imin = (qb * 64 - 31) >> 4;
    {
        { int ln = lane; asm volatile("" : "+v"(ln)); const size_t loff = (size_t)(8 * w + (ln >> 3)) * 512 + (((ln & 7) ^ (ln >> 3)) << 3);
          for (int i = 0; i < ncb; ++i) glds16(kc0 + (size_t)i * 64 * 512 + loff, (unsigned)__builtin_amdgcn_readfirstlane((unsigned)(uintptr_t)(L + i * 8192 + w * 1024))); }
        P8_WAITV(0); P8_BARRIER();
        for (int blk = 0; blk < ncb; ++blk) {
#pragma unroll
            for (int c = 0; c < 2; ++c) chi[c] = ((qb * 64 + tl[c] - 31) >> 4) - 64 * blk;
            wave_block2<1>(L + blk * 8192, L, T, qf, st, zb, on, 64 * blk + 63 > imin, clo, chi, lane, nullptr, 0, 0); }
        P8_BARRIER();
    }
#pragma unroll
    for (int c = 0; c < 2; ++c) st.l[c] = -__builtin_amdgcn_logf(fmaxf(rowsum4(st.l[c]), 1e-30f));
    for (int gi = 0; gi < ncg; ++gi) {
        const int nb = ncb - 4 * gi < 4 ? ncb - 4 * gi : 4;
        p8_dma_group(kc0, kc0 + 256, 512, 4 * gi, nb, L, w, lane);
        P8_WAITV(0); P8_BARRIER();
        for (int i = 0; i < nb; ++i) { const int blk = 4 * gi + i;
#pragma unroll
            for (int c = 0; c < 2; ++c) chi[c] = ((qb * 64 + tl[c] - 31) >> 4) - 64 * blk;
            wave_block2<2>(L + i * 16384, L + i * 16384 + 8192, T, qf, st, zb, on, 64 * blk + 63 > imin, clo, chi, lane, IMP + w * 8 * 132, blk * 16, 132); }
        P8_BARRIER();
    }
    combine(0);
    LDS_WAIT();
    for (int h4 = 0; h4 < 2; ++h4) { float v0[4], v1[4]; unsigned long long s0[4], s1[4];
#pragma unroll
        for (int t = 0; t < 4; ++t) { const LAS float* ir = IMP + (w * 8 + h4 * 4 + t) * 132; v0[t] = ir[lane]; v1[t] = ir[lane + 64]; }
        select_blocks4(v0, v1, qb, lane, s0, s1);
#pragma unroll
        for (int t = 0; t < 4; ++t) if (lane == 0) { LAS unsigned* sb = SELB + (w * 8 + h4 * 4 + t) * 4; sb[0] = (unsigned)s0[t]; sb[1] = (unsigned)(s0[t] >> 32); sb[2] = (unsigned)s1[t]; sb[3] = (unsigned)(s1[t] >> 32); } }
    LDS_WAIT();
    unsigned mysel[2][4], usel[2][4];
#pragma unroll
    for (int c = 0; c < 2; ++c)
#pragma unroll
        for (int i = 0; i < 4; ++i) { mysel[c][i] = SELB[tl[c] * 4 + i];
            usel[c][i] = __builtin_amdgcn_readfirstlane(SELB[(8 * w + 4 * c + 0) * 4 + i] | SELB[(8 * w + 4 * c + 1) * 4 + i] | SELB[(8 * w + 4 * c + 2) * 4 + i] | SELB[(8 * w + 4 * c + 3) * 4 + i]); }
    P8_BARRIER();
    {
        att_init(st);
        const bf16* k0 = KVB + (size_t)b * TP * NKV + 512 + g * 64; int lo2[2] = {0, 0}, hi2[2] = {tl[0], tl[1]};
        const int nblk = qb + 1, ng = (nblk + 3) >> 2;
        p8_dma_group(k0, k0 + 256, NKV, 0, nblk < 4 ? nblk : 4, L, w, lane);
        for (int gi = 0; gi < ng; ++gi) {
            LAS unsigned char* gb = L + (gi & 1) * P8_GB;
            if (gi + 1 < ng) { const int n2 = nblk - 4 * (gi + 1); p8_dma_group(k0, k0 + 256, NKV, 4 * (gi + 1), n2 < 4 ? n2 : 4, L + ((gi + 1) & 1) * P8_GB, w, lane); P8_WAITV(8); }
            else P8_WAITV(0);
            P8_BARRIER();
            const int nb = nblk - 4 * gi < 4 ? nblk - 4 * gi : 4;
            for (int i = 0; i < nb; ++i) { const int jb = 4 * gi + i; float bias[2]; bool act[2];
#pragma unroll
                for (int c = 0; c < 2; ++c) { bias[c] = ((pick4(mysel[c], jb >> 5) >> (jb & 31)) & 1u) ? 0.f : S_NEG; act[c] = ((pick4(usel[c], jb >> 5) >> (jb & 31)) & 1u) != 0u; }
                wave_block2<0>(gb + i * 16384, gb + i * 16384 + 8192, T, qf, st, bias, act, jb == qb, lo2, hi2, lane, nullptr, 0, 0); }
            P8_BARRIER();
        }
        combine(1);
    }
    {
        att_init(st);
        const int jb0 = qb >= 8 ? qb - 8 : 0, nblk = qb - jb0 + 1, ng = (nblk + 3) >> 2;
        const bf16* k0 = KVB + ((size_t)b * TP + (size_t)jb0 * 64) * NKV + 1024 + g * 64;
        p8_dma_group(k0, k0 + 256, NKV, 0, nblk < 4 ? nblk : 4, L, w, lane);
        for (int gi = 0; gi < ng; ++gi) {
            LAS unsigned char* gb = L + (gi & 1) * P8_GB;
            if (gi + 1 < ng) { const int n2 = nblk - 4 * (gi + 1); p8_dma_group(k0, k0 + 256, NKV, 4 * (gi + 1), n2 < 4 ? n2 : 4, L + ((gi + 1) & 1) * P8_GB, w, lane); P8_WAITV(8); }
            else P8_WAITV(0);
            P8_BARRIER();
            const int nb = nblk - 4 * gi < 4 ? nblk - 4 * gi : 4;
            for (int i = 0; i < nb; ++i) { const int jb = jb0 + 4 * gi + i; int lo2[2], hi2[2]; const bool low = (qb >= 8 && jb == qb - 8), top = (jb == qb);
#pragma unroll
                for (int c = 0; c < 2; ++c) { lo2[c] = low ? tl[c] : 0; hi2[c] = top ? tl[c] : 63; }
                wave_block2<0>(gb + i * 16384, gb + i * 16384 + 8192, T, qf, st, zb, on, low || top, lo2, hi2, lane, nullptr, 0, 0); }
            P8_BARRIER();
        }
        combine(2);
    }
}
constexpr int P8S_WAVE = 11008, P8S_KT = 0, P8S_VT = 32 * KT_STRIDE, P8S_IMP = P8S_VT + 32 * VT_STRIDE, P8S_OL = 8 * P8S_WAVE, P8S_ML = P8S_OL + 8 * 8192, P8S_END = P8S_ML + 8 * 256;
static_assert(P8S_IMP + 8 * 40 * 4 <= P8S_WAVE && P8S_END <= RING_BYTES, "sample attention LDS");
struct P8sRegs { f32x4 k[8], v[8]; };
__device__ __forceinline__ void p8s_load_f32(P8sRegs& R, const float* kp, const float* vp, int lane) {
    asm volatile("" : "+v"(lane)); const int r0 = lane >> 4, ch = lane & 15;
#pragma unroll
    for (int i = 0; i < 8; ++i) { R.k[i] = *(const GAS f32x4*)(kp + (size_t)(4 * i + r0) * 512 + ch * 4); R.v[i] = *(const GAS f32x4*)(vp + (size_t)(4 * i + r0) * 512 + ch * 4); }
}
__device__ __forceinline__ void p8s_store_f32(const P8sRegs& R, LAS unsigned char* kt, LAS unsigned char* vt, int lane) {
    asm volatile("" : "+v"(lane)); const int r0 = lane >> 4, ch = lane & 15;
#pragma unroll
    for (int i = 0; i < 8; ++i) { v2u a, b; a.x = pg8::cvt_pk_bf16(R.k[i][0], R.k[i][1]); a.y = pg8::cvt_pk_bf16(R.k[i][2], R.k[i][3]); b.x = pg8::cvt_pk_bf16(R.v[i][0], R.v[i][1]); b.y = pg8::cvt_pk_bf16(R.v[i][2], R.v[i][3]);
        *(LAS v2u*)(kt + (4 * i + r0) * KT_STRIDE + ch * 8) = a; *(LAS v2u*)(vt + (4 * i + r0) * VT_STRIDE + ch * 8) = b; }
}
__device__ __forceinline__ void p8s_stage_bf16(const bf16* kp, const bf16* vp, size_t stride, int nrows, LAS unsigned char* kt, LAS unsigned char* vt, int lane) {
    asm volatile("" : "+v"(lane));
    v4u rk[4], rv[4]; const int r0 = lane >> 3, ch = lane & 7;
#pragma unroll
    for (int i = 0; i < 4; ++i) { const int row = 8 * i + r0; rk[i] = (v4u){0u, 0u, 0u, 0u}; rv[i] = rk[i];
        if (row < nrows) { rk[i] = *(const GAS v4u*)(kp + (size_t)row * stride + ch * 8); rv[i] = *(const GAS v4u*)(vp + (size_t)row * stride + ch * 8); } }
#pragma unroll
    for (int i = 0; i < 4; ++i) { const int row = 8 * i + r0; *(LAS v4u*)(kt + row * KT_STRIDE + ch * 16) = rk[i]; *(LAS v4u*)(vt + row * VT_STRIDE + ch * 16) = rv[i]; }
}
__device__ __forceinline__ void p8_sample_pair(Frame& F, const Args& A, int u, bool valid) {
    unsigned char* ws = A.ws; const bf16* KVB = (const bf16*)(ws + WS_KVB); const bf16* QB = (const bf16*)(ws + WS_QB); const bf16* KCS = (const bf16*)(ws + WS_KCS);
    const float* GT = (const float*)(ws + WS_GT); bf16* O = (bf16*)(ws + WS_O); const int* ptab = (const int*)A.in[I_PT];
    const int n = u >> 2, g = u & 3, sp = F.wave & 3, q0 = F.wave & 4;
    LAS unsigned char* L = F.lds + RING_OFF + F.wave * P8S_WAVE; LAS unsigned char* kt = L + P8S_KT; LAS unsigned char* vt = L + P8S_VT; LAS float* IMP = (LAS float*)(L + P8S_IMP);
    LAS float* OL = (LAS float*)(F.lds + RING_OFF + P8S_OL); LAS float* ML = (LAS float*)(F.lds + RING_OFF + P8S_ML);
    const int lane = F.lane, l15 = lane & 15, lq = lane >> 4;
    const size_t rowbase = (size_t)MP + (size_t)n * TS;
    bf16x8 qf[2][2];
#pragma unroll
    for (int c = 0; c < 2; ++c)
#pragma unroll
        for (int ks = 0; ks < 2; ++ks) qf[c][ks] = *(const GAS bf16x8*)(QB + (rowbase + 4 * c + (l15 >> 2)) * DM + g * 256 + (l15 & 3) * 64 + ks * 32 + lq * 8);
    int tl[2]; tl[0] = l15 >> 2; tl[1] = tl[0] + 4;
    for (int i = lane; i < 8 * 40; i += 64) IMP[i] = 0.f;
    AttState st; const float zb[2] = {0.f, 0.f}; const bool on[2] = {true, true};
    f32x4 fin[2];
    auto publish = [&]() {
#pragma unroll
        for (int c = 0; c < 2; ++c) { float l = st.l[c]; l += __shfl_xor(l, 16); l += __shfl_xor(l, 32);
            if (lq == 0) { ML[((F.wave * 2 + c) * 16 + l15) * 2] = st.m[c]; ML[((F.wave * 2 + c) * 16 + l15) * 2 + 1] = l; }
#pragma unroll
            for (int d = 0; d < 4; ++d)
#pragma unroll
                for (int r = 0; r < 4; ++r) OL[(F.wave * 32 + (c * 4 + d) * 4 + r) * 64 + lane] = st.o[c][d][r]; }
    };
    auto merge = [&](int br) {
#pragma unroll
        for (int k = 0; k < 2; ++k) { const int p = 2 * sp + k, c = p >> 2, d = p & 3;
#pragma unroll
            for (int r = 0; r < 4; ++r) { const int qrow = 4 * lq + r; float mi[4], li[4], M = -3.0e38f;
#pragma unroll
                for (int i = 0; i < 4; ++i) { mi[i] = ML[(((q0 + i) * 2 + c) * 16 + qrow) * 2]; li[i] = ML[(((q0 + i) * 2 + c) * 16 + qrow) * 2 + 1]; M = fmaxf(M, mi[i]); }
                float Ls = 0.f, Os = 0.f;
#pragma unroll
                for (int i = 0; i < 4; ++i) { const float wgt = __builtin_amdgcn_exp2f(mi[i] - M); Ls += wgt * li[i]; Os += wgt * OL[((q0 + i) * 32 + (c * 4 + d) * 4 + r) * 64 + lane]; }
                const float gt = GT[(rowbase + 4 * c + lq) * 48 + g * 12 + r * 3 + br];
                fin[k][r] += gt * Os / fmaxf(Ls, 1e-30f); } }
    };
#define WSYNC() do { LDS_WAIT(); asm volatile("" ::: "memory"); } while (0)
    if (valid) {
    const bf16* kc0 = KCS + (size_t)n * 128 * 512 + g * 64;
    int clo[2] = {0, 0}, chi[2];
    att_init(st);
    for (int pass = 0; pass < 2; ++pass) {
        if (pass == 1) {
#pragma unroll
            for (int c = 0; c < 2; ++c) { float l = st.l[c]; l += __shfl_xor(l, 16); l += __shfl_xor(l, 32); st.l[c] = 1.0f / fmaxf(l, 1e-30f); } }
        for (int hb = 0; hb < 4; ++hb) {
            WSYNC(); p8s_stage_bf16(kc0 + (size_t)hb * 32 * 512, kc0 + (size_t)hb * 32 * 512 + 256, 512, 32, kt, vt, lane); WSYNC();
            chi[0] = 126 - 32 * hb; chi[1] = chi[0];
            if (pass == 0) wave_block<2, 1>(kt, vt, qf, st, zb, on, hb == 3, clo, chi, lane, nullptr, 0, 0);
            else           wave_block<2, 2>(kt, vt, qf, st, zb, on, hb == 3, clo, chi, lane, IMP, hb * 8, 40);
        }
    }
#pragma unroll
    for (int c = 0; c < 2; ++c)
#pragma unroll
        for (int d = 0; d < 4; ++d)
#pragma unroll
            for (int r = 0; r < 4; ++r) OL[(F.wave * 32 + (c * 4 + d) * 4 + r) * 64 + lane] = st.o[c][d][r];
    WSYNC();
#pragma unroll
    for (int k = 0; k < 2; ++k) { const int p = 2 * sp + k, c = p >> 2, d = p & 3;
#pragma unroll
        for (int r = 0; r < 4; ++r) fin[k][r] = GT[(rowbase + 4 * c + lq) * 48 + g * 12 + r * 3 + 0] * OL[(F.wave * 32 + (c * 4 + d) * 4 + r) * 64 + lane]; }
    }
    unsigned mysel[2][2] = {{0u, 0u}, {0u, 0u}};
    if (valid) {
    WSYNC();
    unsigned selw[8][2];
#pragma unroll
    for (int t8 = 0; t8 < 8; ++t8) { unsigned long long s0, s1; const float v0 = lane < 33 ? IMP[t8 * 40 + lane] : 0.f; select_blocks(v0, 0.f, 32, lane, s0, s1); selw[t8][0] = (unsigned)s0; selw[t8][1] = (unsigned)(s0 >> 32); }
#pragma unroll
    for (int c = 0; c < 2; ++c)
#pragma unroll
        for (int i = 0; i < 2; ++i) { const int tt = l15 >> 2; const unsigned a0 = selw[4 * c + 0][i], a1 = selw[4 * c + 1][i], a2 = selw[4 * c + 2][i], a3 = selw[4 * c + 3][i];
            mysel[c][i] = tt == 0 ? a0 : tt == 1 ? a1 : tt == 2 ? a2 : a3; }
    }
    __syncthreads();
    if (valid) {
        att_init(st);
        const float* cache = A.in[I_CSLC]; int lo2[2] = {0, 0}, hi2[2] = {tl[0], tl[1]};
        P8sRegs R;
        { const int pg = ptab[n * NPAGE + (sp >> 2)]; const float* kp = cache + ((size_t)pg * PAGE + (sp & 3) * 32) * 512 + g * 64; p8s_load_f32(R, kp, kp + 256, lane); }
        for (int hb = sp; hb < 64; hb += 4) {
            WSYNC(); p8s_store_f32(R, kt, vt, lane);
            if (hb + 4 < 64) { const int h2 = hb + 4, pg = ptab[n * NPAGE + (h2 >> 2)]; const float* kp = cache + ((size_t)pg * PAGE + (h2 & 3) * 32) * 512 + g * 64; p8s_load_f32(R, kp, kp + 256, lane); }
            WSYNC();
            const int jb = hb >> 1; float bias[2];
#pragma unroll
            for (int c = 0; c < 2; ++c) bias[c] = (((jb < 32 ? mysel[c][0] : mysel[c][1]) >> (jb & 31)) & 1u) ? 0.f : S_NEG;
            wave_block<2, 0>(kt, vt, qf, st, bias, on, false, lo2, hi2, lane, nullptr, 0, 0);
        }
        if (sp == 0) {
            WSYNC(); { const bf16* kp = KVB + rowbase * NKV + 512 + g * 64; p8s_stage_bf16(kp, kp + 256, NKV, 8, kt, vt, lane); } WSYNC();
            wave_block<2, 0>(kt, vt, qf, st, zb, on, true, lo2, hi2, lane, nullptr, 0, 0);
        }
        publish();
    }
    __syncthreads();
    if (valid) merge(1);
    __syncthreads();
    if (valid) {
        att_init(st);
        const float* sw = A.in[I_SWIN] + (size_t)n * 512 * 512 + g * 64;
        P8sRegs R;
        p8s_load_f32(R, sw + (size_t)sp * 32 * 512, sw + (size_t)sp * 32 * 512 + 256, lane);
        for (int hb = sp; hb < 16; hb += 4) {
            WSYNC(); p8s_store_f32(R, kt, vt, lane);
            if (hb + 4 < 16) p8s_load_f32(R, sw + (size_t)(hb + 4) * 32 * 512, sw + (size_t)(hb + 4) * 32 * 512 + 256, lane);
            WSYNC();
            int lo2[2], hi2[2];
#pragma unroll
            for (int c = 0; c < 2; ++c) { lo2[c] = tl[c] - 32 * hb; hi2[c] = 512 + tl[c] - 32 * hb; }
            wave_block<2, 0>(kt, vt, qf, st, zb, on, hb == 0, lo2, hi2, lane, nullptr, 0, 0);
        }
        if (sp == 0) {
            WSYNC(); { const bf16* kp = KVB + rowbase * NKV + 1024 + g * 64; p8s_stage_bf16(kp, kp + 256, NKV, 8, kt, vt, lane); } WSYNC();
            int lo2[2], hi2[2];
#pragma unroll
            for (int c = 0; c < 2; ++c) { lo2[c] = tl[c] - 512; hi2[c] = tl[c]; }
            wave_block<2, 0>(kt, vt, qf, st, zb, on, true, lo2, hi2, lane, nullptr, 0, 0);
        }
        publish();
    }
    __syncthreads();
    if (valid) { merge(2);
#pragma unroll
        for (int k = 0; k < 2; ++k) { const int p = 2 * sp + k, c = p >> 2, d = p & 3;
#pragma unroll
            for (int r = 0; r < 4; ++r) O[(rowbase + 4 * c + lq) * DM + g * 256 + r * 64 + d * 16 + l15] = (bf16)f2bf(fin[k][r]); } }
    __syncthreads();
#undef WSYNC
}
__device__ __forceinline__ void p8_attention(Frame& F, const Args& A) {
    for (int ub = 2 * F.vcu; ub < NBS * 4; ub += 2 * F.G) { const int u = ub + (F.wave >> 2); p8_sample_pair(F, A, u < NBS * 4 ? u : 0, u < NBS * 4); }
    __syncthreads();
    for (;;) {
        if (F.tid == 0) F.MISC[16] = __hip_atomic_fetch_add((unsigned*)(F.ctl + CW_Q8), 1u, __ATOMIC_RELAXED, __HIP_MEMORY_SCOPE_AGENT);
        __syncthreads();
        const int u = (int)F.MISC[16];
        __syncthreads();
        if (u >= NBP * 128 * 4) break;
        const int qb = 127 - (u >> 3), b = (u >> 2) & 1, g = u & 3; p8_prompt_unit(F, A, b, qb, g);
    }
}
constexpr int N_PHASES = 15;
__global__ void __launch_bounds__(NWAVES * 64, 2) yoco_fwd(Args args) {
    extern __shared__ __attribute__((aligned(16))) unsigned char lds[];
    Frame F;
    F.lds = (LAS unsigned char*)lds; F.MISC = (volatile LAS unsigned*)(F.lds + MISC_OFF);
    F.tid = threadIdx.x; F.lane = F.tid & 63; F.wave = __builtin_amdgcn_readfirstlane(F.tid >> 6);
    F.G = gridDim.x; { const int bx = blockIdx.x; F.vcu = (F.G % 8 == 0) ? (bx % 8) * (F.G / 8) + bx / 8 : bx; }
    unsigned char* ws = args.ws;
    F.ctl = (gu32*)(ws + WS_CTL);
    for (int u = F.tid; u < (LDS_BYTES - LDSCTL_OFF) / 4; u += NWAVES * 64) ((LAS unsigned*)(F.lds + LDSCTL_OFF))[u] = 0u;
    __syncthreads();
    const int lo = args.ph_lo, hi = args.ph_hi;
    const bool multi = (hi - lo) > 1;
    XcdBarrier bar; bar.bar = (unsigned*)(F.ctl + CW_BAR); bar.x = 0; bar.st = nullptr;
    if (multi) bar = xcd_barrier_post((unsigned*)(F.ctl + CW_BAR), F.MISC + 8);
#define IN(k) (lo <= (k) && (k) < hi)
#define SEAM(k) do { if (IN(k) && IN((k) + 1)) xcd_barrier(bar); } while (0)
    bf16* const XB = (bf16*)(ws + WS_XB); bf16* const BBp = (bf16*)(ws + WS_BB); bf16* const VBp = (bf16*)(ws + WS_VB); bf16* const Zp = (bf16*)(ws + WS_Z);
    float* const Hp = (float*)(ws + WS_H); bf16* const HBp = (bf16*)(ws + WS_HB); bf16* const ACTp = (bf16*)(ws + WS_ACT); bf16* const KVBp = (bf16*)(ws + WS_KVB);
    bf16* const QBp = (bf16*)(ws + WS_QB); bf16* const Op = (bf16*)(ws + WS_O); float* const GTp = (float*)(ws + WS_GT);
    float* const SSQ = (float*)(ws + WS_SSQ); constexpr size_t SSQ_STRIDE = (size_t)MT * 16;
    const int c = (int)blockIdx.x;

    const bf16* const WAIN = (const bf16*)(ws + WS_WAIN); const bf16* const WAOUT = (const bf16*)(ws + WS_WAOUT); const bf16* const WKVQ = (const bf16*)(ws + WS_WKVQ); const bf16* const WBOUT = (const bf16*)(ws + WS_WBOUT);
    float* const SSQ0 = SSQ, * const SSQ1 = SSQ + SSQ_STRIDE, * const SSQ2 = SSQ + 2 * SSQ_STRIDE;
#define GEMM(EPI, E, SCH, S, Ap, Wp, N_, K_) pg8::gemm_phase<pg8::EPI, pg8::SCH, PG8_ALIGN, PG8_SP2>(F.lds + RING_OFF, pg8::Gemm{Ap, Wp, MT, N_, K_}, S, E)
    if (IN(0)) { p0_prologue(F, args); }
    SEAM(0);
    if (IN(1)) { pg8::StaticOrder S; S.init(MP, NAIN, F.G, c); pg8::EpiAin E{VBp, BBp, (const float*)(ws + WS_RSTD0)}; GEMM(EpiAin, E, StaticOrder, S, XB, WAIN, NAIN, DM); }
    SEAM(1);
    if (IN(2)) { if (c < 48) { pg8::SubOrder S; S.init(64, 4, 12, 48, c); pg8::EpiAin E{VBp, BBp, (const float*)(ws + WS_RSTD0)}; GEMM(EpiAin, E, SubOrder, S, XB, WAIN, NAIN, DM); }
                 else p2_conv(F, args, 0, MP, 48, F.G - 48); }
    SEAM(2);
    if (IN(3)) { { pg8::StaticOrder S; S.init(MP, DM, F.G, c); pg8::EpiRes E{XB, HBp, SSQ0}; GEMM(EpiRes, E, StaticOrder, S, Zp, WAOUT, DM, DM); }
                 p2_conv(F, args, MP, MT, 0, F.G); }
    SEAM(3);
    if (IN(4)) { if (c >= 240) { pg8::SubOrder S; S.init(64, 4, 4, 16, c - 240); pg8::EpiRes E{XB, HBp, SSQ0}; GEMM(EpiRes, E, SubOrder, S, Zp, WAOUT, DM, DM); }
                 { pg8::StaticOrder S; S.init(MP, NFF, F.G, c); pg8::EpiFfn E{ACTp, SSQ0}; GEMM(EpiFfn, E, StaticOrder, S, HBp, (const bf16*)(ws + WS_WFIN0), NFF, DM); } }
    SEAM(4);
    if (IN(5)) { { pg8::StaticOrder S; S.init(MP, DM, F.G, c); pg8::EpiRes E{HBp, HBp, SSQ1}; GEMM(EpiRes, E, StaticOrder, S, ACTp, (const bf16*)(ws + WS_WFOUT0), DM, DFF); }
                 if (c < 88) { pg8::SubOrder S; S.init(64, 4, 22, 88, c); pg8::EpiFfn E{ACTp, SSQ0}; GEMM(EpiFfn, E, SubOrder, S, HBp, (const bf16*)(ws + WS_WFIN0), NFF, DM); } }
    SEAM(5);
    if (IN(6)) { pg8::EpiKvq EK{KVBp, QBp, GTp, SSQ1, args.out + O_CMPP, args.out + O_CMPS, args.out + O_SLCP, args.out + O_SLCS, args.out + O_WINP, args.out + O_WINS};
                 if (c >= 240) { pg8::SubOrder S; S.init(64, 4, 4, 16, c - 240); pg8::EpiRes E{HBp, HBp, SSQ1}; GEMM(EpiRes, E, SubOrder, S, ACTp, (const bf16*)(ws + WS_WFOUT0), DM, DFF); }
                 else { pg8::StaticOrder S; S.init(MP, NKVQ, 240, c); GEMM(EpiKvq, EK, StaticOrder, S, HBp, WKVQ, NKVQ, DM); } }
    SEAM(6);
    if (IN(7)) { if (c < 44) { pg8::SubOrder S; S.init(64, 4, 11, 44, c); pg8::EpiKvq EK{KVBp, QBp, GTp, SSQ1, args.out + O_CMPP, args.out + O_CMPS, args.out + O_SLCP, args.out + O_SLCS, args.out + O_WINP, args.out + O_WINS};
                     GEMM(EpiKvq, EK, SubOrder, S, HBp, WKVQ, NKVQ, DM); }
                 p7_compress(F, args, 0, 1); p7_compress(F, args, 1, 4096); }
    SEAM(7);
    if (IN(9)) { p8_attention(F, args); }
    SEAM(9);
    if (IN(10)) { pg8::StaticOrder S; S.init(MP, DM, F.G, c); pg8::EpiRes E{HBp, HBp, SSQ2}; GEMM(EpiRes, E, StaticOrder, S, Op, WBOUT, DM, DM); }
    SEAM(10);
    if (IN(11)) { if (c >= 240) { pg8::SubOrder S; S.init(64, 4, 4, 16, c - 240); pg8::EpiRes E{HBp, HBp, SSQ2}; GEMM(EpiRes, E, SubOrder, S, Op, WBOUT, DM, DM); }
                  { pg8::StaticOrder S; S.init(MP, NFF, F.G, c); pg8::EpiFfn E{ACTp, SSQ2}; GEMM(EpiFfn, E, StaticOrder, S, HBp, (const bf16*)(ws + WS_WFIN1), NFF, DM); } }
    SEAM(11);
    if (IN(12)) { { pg8::StaticOrder S; S.init(MP, DM, F.G, c); pg8::EpiRes E{HBp, HBp, nullptr}; GEMM(EpiRes, E, StaticOrder, S, ACTp, (const bf16*)(ws + WS_WFOUT1), DM, DFF); }
                  if (c < 88) { pg8::SubOrder S; S.init(64, 4, 22, 88, c); pg8::EpiFfn E{ACTp, SSQ2}; GEMM(EpiFfn, E, SubOrder, S, HBp, (const bf16*)(ws + WS_WFIN1), NFF, DM); } }
    SEAM(12);
    if (IN(13)) { if (c >= 240) { pg8::SubOrder S; S.init(64, 4, 4, 16, c - 240); pg8::EpiRes E{HBp, HBp, nullptr}; GEMM(EpiRes, E, SubOrder, S, ACTp, (const bf16*)(ws + WS_WFOUT1), DM, DFF); }
                  else { p_final(F, args, 0, MP, 0, 240); p_wincopy(F, args, 0, 240); } }
    SEAM(13);
    if (IN(14)) { p_final(F, args, MP, MT, 0, F.G); }
#undef GEMM
#undef IN
#undef SEAM
}

#ifndef MK_PER_PHASE
#define MK_PER_PHASE 0
#endif
extern "C" void kernel_launch(void* const* d_in, const int* in_sizes, int n_in, void* d_out, int out_size, void* d_ws, size_t ws_size, hipStream_t stream) {
    static int grid = 0;
    if (grid == 0) {
        if (n_in != 21 || out_size != (int)O_END || ws_size < WS_END) { fprintf(stderr, "kernel_launch: unexpected shapes (n_in %d out %d ws %zu)\n", n_in, out_size, ws_size); grid = -1; return; }
        int dev = 0, cus = 0, per_cu = 0;
        if (hipGetDevice(&dev) != hipSuccess || hipDeviceGetAttribute(&cus, hipDeviceAttributeMultiprocessorCount, dev) != hipSuccess) { grid = -1; return; }
        if (hipFuncSetAttribute((const void*)yoco_fwd, hipFuncAttributeMaxDynamicSharedMemorySize, LDS_BYTES) != hipSuccess) { fprintf(stderr, "kernel_launch: hipFuncSetAttribute failed\n"); grid = -1; return; }
        if (hipOccupancyMaxActiveBlocksPerMultiprocessor(&per_cu, (const void*)yoco_fwd, NWAVES * 64, LDS_BYTES) != hipSuccess || per_cu < 1) { fprintf(stderr, "kernel_launch: occupancy query says %d\n", per_cu); }
        (void)hipGetLastError();
        grid = cus;
    }
    if (grid < 0) return;
    if (hipMemsetAsync((char*)d_ws + WS_CTL, 0, CTL_ZERO_BYTES, stream) != hipSuccess) return;
    Args a{};
    for (int i = 0; i < 21; ++i) a.in[i] = (const float*)d_in[i];
    a.out = (float*)d_out; a.ws = (unsigned char*)d_ws;
#if MK_PER_PHASE
    for (int p = 0; p < N_PHASES; ++p) { a.ph_lo = p; a.ph_hi = p + 1; hipLaunchKernelGGL(yoco_fwd, dim3(grid), dim3(NWAVES * 64), LDS_BYTES, stream, a); }
#else
    a.ph_lo = 0; a.ph_hi = N_PHASES; hipLaunchKernelGGL(yoco_fwd, dim3(grid), dim3(NWAVES * 64), LDS_BYTES, stream, a);
#endif
}
```

```cpp
#include <hip/hip_runtime.h>
#include <cstdio>
#include <cstdint>
namespace pg8 {
#define PG8_LAS __attribute__((address_space(3)))
typedef unsigned short bf16_t;
typedef short bf16x8 __attribute__((ext_vector_type(8)));
typedef float f32x4 __attribute__((ext_vector_type(4)));
typedef unsigned u32x4 __attribute__((ext_vector_type(4)));
constexpr int BM = 256, BK = 64, HALF = 128, HTB = HALF * BK * 2  , STAGE_BYTES = 8 * HTB, NXCD = 8, WGM = 8;

__host__ __device__ __forceinline__ int lds_byte(int r, int c) { const int st = (r >> 4) * 2 + (c >> 5), rr = r & 15, cc = c & 31, ob = rr * 64 + cc * 2; return st * 1024 + (ob ^ (((ob >> 9) & 1) << 5)); }
__host__ __device__ __forceinline__ void stage_rc(int b, int& R, int& C) { const int st = b / 1024, sb = b % 1024, swz = sb ^ (((sb >> 9) & 1) << 5); R = (st >> 1) * 16 + swz / 64; C = (st & 1) * 32 + (swz % 64) / 2; }
__host__ __device__ __forceinline__ int perm32(int rho) { const int n = rho >> 4, i = rho & 15; return 8 * (i >> 2) + 4 * n + (i & 3); }

struct Unit { int pm, pn; };
struct Gemm { const bf16_t* A; const bf16_t* Bt; int M, N, K; };

struct StaticOrder {
    int nM, nN, nwg, G, c;
    __host__ __device__ void init(int M, int N, int G_, int c_) { nM = M / BM; nN = N / BM; nwg = nM * nN; G = G_; c = c_; }
    __host__ __device__ bool next(int i, Unit& u) const {
        const long L = (long)i * G + c; if (L >= nwg) return false;
        int wgid = (int)L; { const int q = nwg / NXCD, r = nwg % NXCD, xcd = wgid % NXCD, off = wgid / NXCD; wgid = (xcd < r ? xcd * (q + 1) : r * (q + 1) + (xcd - r) * q) + off; }
        const int nig = WGM * nN, gid = wgid / nig, fm = gid * WGM, gsz = (nM - fm) < WGM ? (nM - fm) : WGM;
        u.pm = fm + ((wgid % nig) % gsz); u.pn = (wgid % nig) / gsz; return true;
    }
    __device__ __forceinline__ void a_ready(const Unit&) const {}
    __device__ __forceinline__ void done(const Unit&) const {}
};

__device__ __forceinline__ unsigned cvt_pk_bf16(float lo, float hi) { unsigned r; asm volatile("v_cvt_pk_bf16_f32 %0, %1, %2" : "=v"(r) : "v"(lo), "v"(hi)); return r; }
constexpr int E_MP = 16384;
constexpr float E_EPS = 1e-6f;
__device__ __forceinline__ float row_rstd16(const float* ssqp, int row, int fq) {
    const f32x4 p = *(const f32x4*)(ssqp + (size_t)row * 16 + fq * 4);
    float s = (p[0] + p[1]) + (p[2] + p[3]); s += __shfl_xor(s, 16); s += __shfl_xor(s, 32);
    return __builtin_amdgcn_rsqf(s * (1.0f / 1024.0f) + E_EPS);
}
__device__ __forceinline__ u32x4 pack8(const f32x4 a, const f32x4 b) { u32x4 w; w.x = cvt_pk_bf16(a[0], a[1]); w.y = cvt_pk_bf16(a[2], a[3]); w.z = cvt_pk_bf16(b[0], b[1]); w.w = cvt_pk_bf16(b[2], b[3]); return w; }

struct EpiAin {
    static constexpr bool PERM = true, AFTER_DRAIN = false;
    bf16_t* VB; bf16_t* BB; const float* rstd;
    __device__ __forceinline__ void operator()(const f32x4 (&acc)[2][2][4][2], const Unit& u, int wr, int wc, int fr, int fq) const {
        const int row0 = u.pm * BM + wr * 64 + fr;
        if (u.pn < 8) {
            const int ch = u.pn * 128 + wc * 32 + 8 * fq;
#pragma unroll
            for (int ai = 0; ai < 2; ++ai)
#pragma unroll
                for (int m = 0; m < 4; ++m) { const int row = row0 + ai * HALF + m * 16; const float r = rstd[row], r2 = r * r;
                    const f32x4 v0 = acc[ai][0][m][0] * acc[ai][1][m][0] * r2, v1 = acc[ai][0][m][1] * acc[ai][1][m][1] * r2;
                    *(u32x4*)(VB + (size_t)row * 1024 + ch) = pack8(v0, v1); }
        } else {
            const int ch = (u.pn - 8) * 256 + wc * 32 + 8 * fq;
#pragma unroll
            for (int ai = 0; ai < 2; ++ai)
#pragma unroll
                for (int m = 0; m < 4; ++m) { const int row = row0 + ai * HALF + m * 16; const float r = rstd[row];
#pragma unroll
                    for (int bj = 0; bj < 2; ++bj) *(u32x4*)(BB + (size_t)row * 1024 + ch + bj * HALF) = pack8(acc[ai][bj][m][0] * r, acc[ai][bj][m][1] * r); }
        }
    }
};
struct EpiRes {
    static constexpr bool PERM = true, AFTER_DRAIN = false;
    const bf16_t* base; bf16_t* HB; float* ssqp;
    __device__ __forceinline__ void operator()(const f32x4 (&acc)[2][2][4][2], const Unit& u, int wr, int wc, int fr, int fq) const {
        const int row0 = u.pm * BM + wr * 64 + fr, col0 = u.pn * BM + wc * 32 + 8 * fq;
#pragma unroll
        for (int ai = 0; ai < 2; ++ai)
#pragma unroll
            for (int m = 0; m < 4; ++m) { const int row = row0 + ai * HALF + m * 16; const size_t off = (size_t)row * 1024 + col0; float ss = 0.f;
#pragma unroll
                for (int bj = 0; bj < 2; ++bj) { const u32x4 bw = *(const u32x4*)(base + off + bj * HALF);
                    f32x4 h0, h1;
                    h0[0] = __builtin_bit_cast(float, bw.x << 16) + acc[ai][bj][m][0][0]; h0[1] = __builtin_bit_cast(float, bw.x & 0xffff0000u) + acc[ai][bj][m][0][1];
                    h0[2] = __builtin_bit_cast(float, bw.y << 16) + acc[ai][bj][m][0][2]; h0[3] = __builtin_bit_cast(float, bw.y & 0xffff0000u) + acc[ai][bj][m][0][3];
                    h1[0] = __builtin_bit_cast(float, bw.z << 16) + acc[ai][bj][m][1][0]; h1[1] = __builtin_bit_cast(float, bw.z & 0xffff0000u) + acc[ai][bj][m][1][1];
                    h1[2] = __builtin_bit_cast(float, bw.w << 16) + acc[ai][bj][m][1][2]; h1[3] = __builtin_bit_cast(float, bw.w & 0xffff0000u) + acc[ai][bj][m][1][3];
                    const u32x4 o = pack8(h0, h1); *(u32x4*)(HB + off + bj * HALF) = o;
                    if (ssqp) { const float r0 = __builtin_bit_cast(float, o.x << 16), r1 = __builtin_bit_cast(float, o.x & 0xffff0000u), r2 = __builtin_bit_cast(float, o.y << 16), r3 = __builtin_bit_cast(float, o.y & 0xffff0000u),
                                            r4 = __builtin_bit_cast(float, o.z << 16), r5 = __builtin_bit_cast(float, o.z & 0xffff0000u), r6 = __builtin_bit_cast(float, o.w << 16), r7 = __builtin_bit_cast(float, o.w & 0xffff0000u);
                        ss += (r0 * r0 + r1 * r1) + (r2 * r2 + r3 * r3) + (r4 * r4 + r5 * r5) + (r6 * r6 + r7 * r7); } }
                if (ssqp) { ss += __shfl_xor(ss, 16); ss += __shfl_xor(ss, 32); if (fq == 0) ssqp[(size_t)row * 16 + u.pn * 4 + wc] = ss; }
                if (m & 1) asm volatile("" ::: "memory"); }
    }
};
struct EpiFfn {
    static constexpr bool PERM = true, AFTER_DRAIN = false;
    bf16_t* ACT; const float* ssqp;
    __device__ __forceinline__ void operator()(const f32x4 (&acc)[2][2][4][2], const Unit& u, int wr, int wc, int fr, int fq) const {
        const int row0 = u.pm * BM + wr * 64 + fr, ch = u.pn * 128 + wc * 32 + 8 * fq;
#pragma unroll
        for (int ai = 0; ai < 2; ++ai)
#pragma unroll
            for (int m = 0; m < 4; ++m) { const int row = row0 + ai * HALF + m * 16; const float r = row_rstd16(ssqp, row, fq);
                f32x4 o[2];
#pragma unroll
                for (int n = 0; n < 2; ++n)
#pragma unroll
                    for (int e = 0; e < 4; ++e) { const float g = acc[ai][0][m][n][e] * r, up = acc[ai][1][m][n][e] * r;
                        o[n][e] = g * up * __builtin_amdgcn_rcpf(1.0f + __builtin_amdgcn_exp2f(g * -1.4426950408889634f)); }
                *(u32x4*)(ACT + (size_t)row * 2816 + ch) = pack8(o[0], o[1]); }
    }
};
struct EpiKvq {
    static constexpr bool PERM = true, AFTER_DRAIN = false;
    bf16_t* KVB; bf16_t* QB; float* GT; const float* ssqp;
    float *cmp_p, *cmp_s, *slc_p, *slc_s, *win_p, *win_s;
    __device__ __forceinline__ void operator()(const f32x4 (&acc)[2][2][4][2], const Unit& u, int wr, int wc, int fr, int fq) const {
        const int row0 = u.pm * BM + wr * 64 + fr, cw = wc * 32 + 8 * fq;
#pragma unroll
        for (int ai = 0; ai < 2; ++ai)
#pragma unroll
            for (int m = 0; m < 4; ++m) { const int row = row0 + ai * HALF + m * 16; const float r = row_rstd16(ssqp, row, fq);
                if (u.pn < 6) {
                    const int br = u.pn >> 1; float* orow = nullptr;
                    if (row < E_MP) { if (br == 0) orow = cmp_p + (size_t)row * 512; else if (br == 1) orow = slc_p + (size_t)row * 512;
                        else { const int t = row & 8191; if (t >= 7680) orow = win_p + ((size_t)(row >> 13) * 512 + (t - 7680)) * 512; } }
                    else { const int rs = row - E_MP; if (br == 0) orow = cmp_s + (size_t)rs * 512; else if (br == 1) orow = slc_s + (size_t)rs * 512;
                        else orow = win_s + ((size_t)(rs >> 3) * 512 + 504 + (rs & 7)) * 512; }
#pragma unroll
                    for (int bj = 0; bj < 2; ++bj) { const int col = u.pn * BM + bj * HALF + cw; const f32x4 a = acc[ai][bj][m][0] * r, b = acc[ai][bj][m][1] * r;
                        *(u32x4*)(KVB + (size_t)row * 1536 + col) = pack8(a, b);
                        if (orow) { *(f32x4*)(orow + (col & 511)) = a; *(f32x4*)(orow + (col & 511) + 4) = b; } }
                } else if (u.pn < 10) {
#pragma unroll
                    for (int bj = 0; bj < 2; ++bj) { const int col = (u.pn - 6) * BM + bj * HALF + cw;
                        *(u32x4*)(QB + (size_t)row * 1024 + col) = pack8(acc[ai][0 + bj][m][0] * r, acc[ai][0 + bj][m][1] * r); }
                } else {
                    if (cw < 48) {
                        f32x4 s0, s1;
#pragma unroll
                        for (int e = 0; e < 4; ++e) { s0[e] = __builtin_amdgcn_rcpf(1.0f + __builtin_amdgcn_exp2f(acc[ai][0][m][0][e] * r * -1.4426950408889634f));
                                                      s1[e] = __builtin_amdgcn_rcpf(1.0f + __builtin_amdgcn_exp2f(acc[ai][0][m][1][e] * r * -1.4426950408889634f)); }
                        *(f32x4*)(GT + (size_t)row * 48 + cw) = s0; *(f32x4*)(GT + (size_t)row * 48 + cw + 4) = s1; }
                }
            }
    }
};

struct SubOrder {
    int pm0, nM, nwg, Gs, cl;
    __host__ __device__ void init(int pm0_, int nM_, int nN_, int Gs_, int cl_) { pm0 = pm0_; nM = nM_; nwg = nM_ * nN_; Gs = Gs_; cl = cl_; }
    __host__ __device__ bool next(int i, Unit& u) const { if (cl < 0 || cl >= Gs) return false; const int L = i * Gs + cl; if (L >= nwg) return false; u.pm = pm0 + L % nM; u.pn = L / nM; return true; }
    __device__ __forceinline__ void a_ready(const Unit&) const {}
    __device__ __forceinline__ void done(const Unit&) const {}
};
template <class Epi, class Sched, bool ALIGN_EPI = false, bool SP2 = false>
__device__ __forceinline__ void gemm_phase(PG8_LAS unsigned char* lds, const Gemm g, const Sched& S, const Epi& E) {
    const int tid = threadIdx.x, wid = __builtin_amdgcn_readfirstlane(tid >> 6), lane = tid & 63, wr = wid >> 2, wc = wid & 3, fr = lane & 15, fq = lane >> 4;
    const int K = g.K, nt = K / BK;
    unsigned voffA[2], voffB[2];
#pragma unroll
    for (int i = 0; i < 2; ++i) { int R, C; stage_rc(tid * 16 + i * 8192, R, C); const int Rb = Epi::PERM ? ((R & ~31) + perm32(R & 31)) : R;
        voffA[i] = (unsigned)(R * K + C) * 2u; voffB[i] = (unsigned)(Rb * K + C) * 2u; }
    const size_t kstep = (size_t)(BK * 2);
    const size_t hstep = (size_t)HALF * K * 2;
    const size_t tstep = 2 * hstep;
    const unsigned ldsw = (unsigned)wid * 1024u;
    const int aoff = lds_byte(wr * 64 + fr, fq * 8), boff = lds_byte(wc * 32 + fr, fq * 8);
#define PG8_SA(b, h) (((b) * 2 + (h)) * HTB)
#define PG8_SB(b, h) ((4 + (b) * 2 + (h)) * HTB)
#define PG8_STAGE(bufoff, gbase, voff) do { _Pragma("unroll") for (int _i = 0; _i < 2; ++_i) \
        __builtin_amdgcn_global_load_lds((const unsigned*)((const char*)(gbase) + (voff)[_i]), (PG8_LAS unsigned*)(lds + (bufoff) + ldsw + _i * 8192), 16, 0, 0); } while (0)
#define PG8_LDA(dst, b, h) do { _Pragma("unroll") for (int m = 0; m < 4; ++m) _Pragma("unroll") for (int k = 0; k < 2; ++k) dst[m][k] = *(const PG8_LAS bf16x8*)(lds + PG8_SA(b, h) + aoff + m * 2048 + k * 1024); } while (0)
#define PG8_LDB(dst, b, h) do { _Pragma("unroll") for (int n = 0; n < 2; ++n) _Pragma("unroll") for (int k = 0; k < 2; ++k) dst[n][k] = *(const PG8_LAS bf16x8*)(lds + PG8_SB(b, h) + boff + n * 2048 + k * 1024); } while (0)
#define PG8_MMA(ai, bj, At, Bt) do { __builtin_amdgcn_s_setprio(1); _Pragma("unroll") for (int m = 0; m < 4; ++m) _Pragma("unroll") for (int n = 0; n < 2; ++n) _Pragma("unroll") for (int k = 0; k < 2; ++k) \
        acc[ai][bj][m][n] = __builtin_amdgcn_mfma_f32_16x16x32_bf16(Bt[n][k], At[m][k], acc[ai][bj][m][n], 0, 0, 0); __builtin_amdgcn_s_setprio(0); } while (0)
#define PG8_WAIT_V(n) asm volatile("s_waitcnt vmcnt(" #n ")" ::: "memory")
#define PG8_WAIT_L(n) asm volatile("s_waitcnt lgkmcnt(" #n ")" ::: "memory")
#define PG8_BAR __builtin_amdgcn_s_barrier()
#define PG8_SCHED __builtin_amdgcn_sched_barrier(0)
    Unit cur, nxt; int ui = 0;
    if (!S.next(0, cur)) return;
    f32x4 acc[2][2][4][2];
#pragma unroll
    for (int a = 0; a < 2; ++a)
#pragma unroll
        for (int b = 0; b < 2; ++b)
#pragma unroll
            for (int m = 0; m < 4; ++m)
#pragma unroll
                for (int n = 0; n < 2; ++n) acc[a][b][m][n] = (f32x4){0.f, 0.f, 0.f, 0.f};
    bf16x8 At[4][2], B0[2][2], B1[2][2];
    const char* cA = (const char*)g.A + (size_t)cur.pm * tstep; const char* cB = (const char*)g.Bt + (size_t)cur.pn * tstep;
    S.a_ready(cur);
    if constexpr (SP2) {
        PG8_STAGE(PG8_SB(0, 0), cB, voffB); PG8_STAGE(PG8_SB(0, 1), cB + hstep, voffB); PG8_STAGE(PG8_SA(0, 0), cA, voffA); PG8_STAGE(PG8_SA(0, 1), cA + hstep, voffA);
        if (wr == 1) PG8_BAR;
        PG8_WAIT_V(2); PG8_BAR;
        PG8_STAGE(PG8_SB(1, 0), cB + kstep, voffB); PG8_STAGE(PG8_SA(1, 0), cA + kstep, voffA); PG8_STAGE(PG8_SB(1, 1), cB + hstep + kstep, voffB);
        PG8_WAIT_V(6); PG8_BAR;
    } else {
        PG8_STAGE(PG8_SB(0, 0), cB, voffB); PG8_STAGE(PG8_SA(0, 0), cA, voffA); PG8_STAGE(PG8_SB(0, 1), cB + hstep, voffB); PG8_STAGE(PG8_SA(0, 1), cA + hstep, voffA);
        if (wr == 1) PG8_BAR;
        PG8_WAIT_V(4); PG8_BAR;
        PG8_STAGE(PG8_SB(1, 0), cB + kstep, voffB); PG8_STAGE(PG8_SA(1, 0), cA + kstep, voffA); PG8_STAGE(PG8_SB(1, 1), cB + hstep + kstep, voffB);
        PG8_WAIT_V(6); PG8_BAR;
    }
    for (;;) {
        const bool has_next = S.next(ui + 1, nxt);
        const char* nA = has_next ? (const char*)g.A + (size_t)nxt.pm * tstep : cA; const char* nB = has_next ? (const char*)g.Bt + (size_t)nxt.pn * tstep : cB;
        for (int t = 0; t < nt; t += 2) {
            const bool last = (t == nt - 2);
            const char* a1 = cA + (size_t)(t + 1) * kstep;
            const char* a2 = last ? nA : cA + (size_t)(t + 2) * kstep; const char* b2 = last ? nB : cB + (size_t)(t + 2) * kstep;
            const char* a3 = a2 + kstep; const char* b3 = b2 + kstep;
            if (last && has_next) S.a_ready(nxt);
            if constexpr (SP2) {
            PG8_LDB(B0, 0, 0); PG8_LDB(B1, 0, 1); PG8_SCHED; PG8_LDA(At, 0, 0); PG8_STAGE(PG8_SA(1, 1), a1 + hstep, voffA);
            PG8_WAIT_V(8); PG8_WAIT_L(0); PG8_BAR; PG8_MMA(0, 0, At, B0); PG8_MMA(0, 1, At, B1); PG8_BAR; PG8_SCHED;
            PG8_LDA(At, 0, 1); PG8_STAGE(PG8_SB(0, 0), b2, voffB); PG8_STAGE(PG8_SB(0, 1), b2 + hstep, voffB); PG8_STAGE(PG8_SA(0, 0), a2, voffA);
            PG8_WAIT_V(8); PG8_WAIT_L(0); PG8_BAR; PG8_MMA(1, 0, At, B0); PG8_MMA(1, 1, At, B1); PG8_BAR; PG8_SCHED;
            PG8_LDB(B0, 1, 0); PG8_LDB(B1, 1, 1); PG8_SCHED; PG8_LDA(At, 1, 0); PG8_STAGE(PG8_SA(0, 1), a2 + hstep, voffA);
            PG8_WAIT_V(8); PG8_WAIT_L(0); PG8_BAR; PG8_MMA(0, 0, At, B0); PG8_MMA(0, 1, At, B1); PG8_BAR; PG8_SCHED;
            PG8_LDA(At, 1, 1); PG8_STAGE(PG8_SB(1, 0), b3, voffB); PG8_STAGE(PG8_SB(1, 1), b3 + hstep, voffB); PG8_STAGE(PG8_SA(1, 0), a3, voffA);
            PG8_WAIT_V(8); PG8_WAIT_L(0); PG8_BAR; PG8_MMA(1, 0, At, B0); PG8_MMA(1, 1, At, B1); PG8_BAR; PG8_SCHED;
            } else {
            PG8_LDB(B0, 0, 0); PG8_SCHED; PG8_LDA(At, 0, 0); PG8_STAGE(PG8_SA(1, 1), a1 + hstep, voffA);
            PG8_WAIT_L(8); PG8_BAR; PG8_WAIT_L(0); PG8_MMA(0, 0, At, B0); PG8_BAR; PG8_SCHED;
            PG8_LDB(B1, 0, 1); PG8_STAGE(PG8_SB(0, 0), b2, voffB);
            PG8_BAR; PG8_WAIT_L(0); PG8_MMA(0, 1, At, B1); PG8_BAR;
            PG8_LDA(At, 0, 1); PG8_STAGE(PG8_SA(0, 0), a2, voffA);
            PG8_BAR; PG8_WAIT_L(0); PG8_MMA(1, 0, At, B0); PG8_BAR; PG8_SCHED;
            PG8_STAGE(PG8_SB(0, 1), b2 + hstep, voffB);
            PG8_WAIT_V(6); PG8_BAR; PG8_MMA(1, 1, At, B1); PG8_BAR;
            PG8_LDB(B0, 1, 0); PG8_SCHED; PG8_LDA(At, 1, 0); PG8_STAGE(PG8_SA(0, 1), a2 + hstep, voffA);
            PG8_WAIT_L(8); PG8_BAR; PG8_WAIT_L(0); PG8_MMA(0, 0, At, B0); PG8_BAR; PG8_SCHED;
            PG8_LDB(B1, 1, 1); PG8_STAGE(PG8_SB(1, 0), b3, voffB);
            PG8_BAR; PG8_WAIT_L(0); PG8_MMA(0, 1, At, B1); PG8_BAR;
            PG8_LDA(At, 1, 1); PG8_STAGE(PG8_SA(1, 0), a3, voffA);
            PG8_BAR; PG8_WAIT_L(0); PG8_MMA(1, 0, At, B0); PG8_BAR; PG8_SCHED;
            PG8_STAGE(PG8_SB(1, 1), b3 + hstep, voffB);
            PG8_WAIT_V(6); PG8_BAR; PG8_MMA(1, 1, At, B1); PG8_BAR;
            }
        }
        if constexpr (ALIGN_EPI) { if (wr == 0) PG8_BAR; }
        if constexpr (!Epi::AFTER_DRAIN) { E(acc, cur, wr, wc, fr, fq); S.done(cur); }
        if (!has_next) break;
#pragma unroll
        for (int a = 0; a < 2; ++a)
#pragma unroll
            for (int b = 0; b < 2; ++b)
#pragma unroll
                for (int m = 0; m < 4; ++m)
#pragma unroll
                    for (int n = 0; n < 2; ++n) acc[a][b][m][n] = (f32x4){0.f, 0.f, 0.f, 0.f};
        cur = nxt; cA = nA; cB = nB; ++ui;
        if constexpr (ALIGN_EPI) { if (wr == 1) PG8_BAR; }
    }
    PG8_WAIT_V(0);
    if constexpr (!ALIGN_EPI) { if (wr == 0) PG8_BAR; }
    PG8_BAR;
    if constexpr (Epi::AFTER_DRAIN) { E.fused(acc, cur, wr, wc, fr, fq, lds, wid, lane); S.done(cur); }
#undef PG8_SA
#undef PG8_SB
#undef PG8_STAGE
#undef PG8_LDA
#undef PG8_LDB
#undef PG8_MMA
#undef PG8_WAIT_V
#undef PG8_WAIT_L
#undef PG8_BAR
#undef PG8_SCHED
}
}
#ifndef PG8_SP2
#define PG8_SP2 true
#endif
#ifndef PG8_ALIGN
#define PG8_ALIGN true
#endif
constexpr int NWAVES = 8;
constexpr int DM = 1024, TP = 8192, NBP = 2, MP = NBP * TP, NBS = 128, TS = 8, MS = NBS * TS, MT = MP + MS;
constexpr int DFF = 2816, NFF = 2 * DFF, NAIN = 3 * DM, NKVQ = 2816, NKV = 1536, PAST = 2048, NPAGE = 16, PAGE = 128;
constexpr int NCP = 511, NCS = 127;
constexpr float RMS_EPS = 1e-6f;
constexpr float QSCALE = 0.125f * 1.4426950408889634f;
constexpr size_t O_YP = 0, O_YS = O_YP + (size_t)MP * DM, O_CONVP = O_YS + (size_t)MS * DM, O_CONVS = O_CONVP + 2 * 2 * DM, O_CMPP = O_CONVS + (size_t)NBS * 2 * DM,
                 O_CMPS = O_CMPP + (size_t)MP * 512, O_SLCP = O_CMPS + (size_t)MS * 512, O_SLCS = O_SLCP + (size_t)MP * 512, O_WINP = O_SLCS + (size_t)MS * 512,
                 O_WINS = O_WINP + (size_t)NBP * 512 * 512, O_END = O_WINS + (size_t)NBS * 512 * 512;
static_assert(O_END == 69996544, "output size");
constexpr size_t MiB = 1u << 20;
constexpr size_t WS_CTL = 0, CTL_ZERO_BYTES = 1 * MiB;
constexpr size_t WS_WAIN = 2 * MiB, WS_WAOUT = 8 * MiB, WS_WFIN0 = 10 * MiB, WS_WFIN1 = 21 * MiB, WS_WFOUT0 = 32 * MiB, WS_WFOUT1 = 38 * MiB, WS_WKVQ = 44 * MiB, WS_WBOUT = 50 * MiB,
                 WS_W1T = 52 * MiB, WS_W2T = 53 * MiB, WS_PEB = 53 * MiB + 65536, WS_RSTD0 = 54 * MiB, WS_SSQ = 55 * MiB  , WS_GT = 60 * MiB  ,
                 WS_KCP = 64 * MiB  , WS_KCS = 65 * MiB  , WS_SELS = 82 * MiB,
                 WS_XB = 96 * MiB, WS_BB = 132 * MiB, WS_VB = 168 * MiB, WS_Z = 204 * MiB, WS_H = 240 * MiB, WS_HB = 312 * MiB, WS_ACT = 348 * MiB, WS_KVB = 444 * MiB, WS_QB = 496 * MiB, WS_O = 532 * MiB, WS_OTG = 568 * MiB  , WS_END = 600 * MiB;
static_assert(WS_XB + (size_t)MT * DM * 2 <= WS_BB && WS_H + (size_t)MT * DM * 4 <= WS_HB && WS_ACT + (size_t)MT * DFF * 2 <= WS_KVB && WS_KVB + (size_t)MT * NKV * 2 <= WS_QB && WS_O + (size_t)MT * DM * 2 <= WS_OTG, "ws map");
static_assert(WS_SSQ + 4 * (size_t)MT * 16 * 4 <= WS_GT && WS_GT + (size_t)MT * 48 * 4 <= WS_KCP && WS_KCS + (size_t)NBS * 128 * 512 * 2 <= WS_SELS, "ws map 2");
constexpr int CW_TMO = 0, CW_CODE = 1, CW_Q8 = 64, CW_Q7 = 256, CW_BAR = 4096;
constexpr int RING_OFF = 0, RING_BYTES = 155648, LDSCTL_OFF = RING_BYTES, MISC_OFF = LDSCTL_OFF + 320, LDS_BYTES = 159744;

#define GAS __attribute__((address_space(1)))
#define LAS __attribute__((address_space(3)))
typedef unsigned short bf16;
typedef unsigned v4u __attribute__((ext_vector_type(4)));
typedef unsigned v2u __attribute__((ext_vector_type(2)));
typedef float f32x4 __attribute__((ext_vector_type(4)));
typedef short bf16x8 __attribute__((ext_vector_type(8)));
typedef GAS unsigned gu32;
#define RLX_AGENT __ATOMIC_RELAXED, __HIP_MEMORY_SCOPE_AGENT
#define LDS_WAIT() asm volatile("s_waitcnt lgkmcnt(0)" ::: "memory")
#define VM_WAIT() asm volatile("s_waitcnt vmcnt(0)" ::: "memory")
__device__ __forceinline__ unsigned f2bf(float f) { unsigned u = __builtin_bit_cast(unsigned, f); return (u + 0x7fffu + ((u >> 16) & 1u)) >> 16; }
__device__ __forceinline__ unsigned pk2(float lo, float hi) { return f2bf(lo) | (f2bf(hi) << 16); }
__device__ __forceinline__ float bf2f(unsigned h) { return __builtin_bit_cast(float, h << 16); }
#define XB_TMO      128
#define XB_XCNT(j)  (256  + 64 * (j))
#define XB_XSUB(j)  (1280 + 64 * (j))
#define XB_XGEN(j)  (2304 + 64 * (j))
#define XB_TOP      3328
#define XB_TOPGEN   3392
#define XCD_BAR_WORDS 3456
#define XB_SPIN_CAP (1u << 18)

__device__ __forceinline__ unsigned xb_ld(unsigned* p)              { return __hip_atomic_load(p, __ATOMIC_RELAXED, __HIP_MEMORY_SCOPE_AGENT); }
__device__ __forceinline__ unsigned xb_add(unsigned* p, unsigned v) { return __hip_atomic_fetch_add(p, v, __ATOMIC_RELAXED, __HIP_MEMORY_SCOPE_AGENT); }
__device__ __forceinline__ unsigned xb_xcc_id() { return (unsigned)__builtin_amdgcn_s_getreg((3 << 11) | 20) & 0xFu; }
#define XB_SPIN(cond, bar) do { unsigned _sp = 0; while (cond) { __builtin_amdgcn_s_sleep(1); \
    if ((++_sp & 255u) == 0u) { if (xb_ld(&(bar)[XB_TMO])) break; if (_sp > XB_SPIN_CAP) { atomicAdd(&(bar)[XB_TMO], 1u); break; } } } } while (0)

struct XcdBarrier {
    unsigned* bar; unsigned x;
    volatile LAS unsigned* st;
};

__device__ __forceinline__ XcdBarrier xcd_barrier_post(unsigned* bar, volatile LAS unsigned* st) {
    XcdBarrier b; b.bar = bar; b.x = xb_xcc_id(); b.st = st;
    if (threadIdx.x == 0) (void)xb_add(&bar[XB_XCNT(b.x)], 1u);
    return b;
}
__device__ __forceinline__ void xcd_barrier_complete(unsigned* bar, unsigned x, unsigned& nloc, unsigned& nx) {
    const unsigned G = gridDim.x * gridDim.y * gridDim.z;
    unsigned sum, cnt, mine, sp = 0u;
    for (;;) {
        sum = 0u; cnt = 0u; mine = 0u;
#pragma unroll
        for (unsigned j = 0; j < 16; ++j) { const unsigned c = xb_ld(&bar[XB_XCNT(j)]); sum += c; cnt += (c > 0u) ? 1u : 0u; mine = (j == x) ? c : mine; }
        if (sum == G) break;
        __builtin_amdgcn_s_sleep(1);
        if ((++sp & 255u) == 0u) { if (xb_ld(&bar[XB_TMO])) break; if (sp > XB_SPIN_CAP) { atomicAdd(&bar[XB_TMO], 1u); break; } }
    }
    nloc = mine > 0u ? mine : 1u; nx = cnt > 0u ? cnt : 1u;
}

__device__ __forceinline__ void xcd_barrier(const XcdBarrier& b) {
    asm volatile("s_waitcnt vmcnt(0)" ::: "memory");
    __syncthreads();
    if (threadIdx.x == 0) {
        unsigned* bar = b.bar;
        __builtin_amdgcn_s_waitcnt(0);
        unsigned nloc = b.st[0], nx = b.st[1];
        if (nloc == 0u) { xcd_barrier_complete(bar, b.x, nloc, nx); b.st[0] = nloc; b.st[1] = nx; }
        const unsigned old = xb_add(&bar[XB_XSUB(b.x)], 1u);
        const unsigned gen = old / nloc;
        if (old + 1u == (gen + 1u) * nloc) {
            __builtin_amdgcn_fence(__ATOMIC_RELEASE, "agent");
            asm volatile("s_waitcnt vmcnt(0)" ::: "memory");
            const unsigned og = xb_add(&bar[XB_TOP], 1u);
            const unsigned tg = og / nx;
            if (og + 1u == (tg + 1u) * nx) xb_add(&bar[XB_TOPGEN], 1u);
            else XB_SPIN(xb_ld(&bar[XB_TOPGEN]) == tg, bar);
            __builtin_amdgcn_fence(__ATOMIC_ACQUIRE, "agent");
            xb_add(&bar[XB_XGEN(b.x)], 1u);
            asm volatile("s_waitcnt vmcnt(0)" ::: "memory");
        } else {
            XB_SPIN(xb_ld(&bar[XB_XGEN(b.x)]) == gen, bar);
            __builtin_amdgcn_fence(__ATOMIC_ACQUIRE, "agent");
            asm volatile("s_waitcnt vmcnt(0)" ::: "memory");
        }
    }
    __syncthreads();
}

struct Args { const float* in[21]; float* out; unsigned char* ws; int ph_lo, ph_hi; };
struct Frame {
    LAS unsigned char* lds; volatile LAS unsigned* MISC; gu32* ctl;
    int tid, lane, wave, vcu, G;
};
__device__ __forceinline__ float wave_sum(float v) {
#pragma unroll
    for (int o = 1; o < 64; o <<= 1) v += __shfl_xor(v, o);
    return v;
}
__device__ __forceinline__ void tr_item(const float* src, int ldsrc, int scol, int nvalid, const float* kscale, float cscale, bf16* dst, int K, int n0, int k0, LAS float* scr, int lane) {
    { const int c = lane & 31, kh = lane >> 5; float v[32], ks[32];
#pragma unroll
    for (int i = 0; i < 32; ++i) { v[i] = 0.f; ks[i] = 1.f; if (c < nvalid) { v[i] = src[(size_t)(k0 + 2 * i + kh) * ldsrc + scol + c]; if (kscale) ks[i] = kscale[k0 + 2 * i + kh]; } }
#pragma unroll
    for (int i = 0; i < 32; ++i) scr[(2 * i + kh) * 33 + c] = v[i] * cscale * ks[i]; }
    LDS_WAIT(); asm volatile("" ::: "memory");
    const int c = lane & 7;
#pragma unroll
    for (int j = 0; j < 4; ++j) { const int n = (lane >> 3) + 8 * j; const LAS float* s = scr + (8 * c) * 33 + n;
        v4u o; o.x = pk2(s[0 * 33], s[1 * 33]); o.y = pk2(s[2 * 33], s[3 * 33]); o.z = pk2(s[4 * 33], s[5 * 33]); o.w = pk2(s[6 * 33], s[7 * 33]);
        *(GAS v4u*)(dst + (size_t)(n0 + n) * K + k0 + 8 * c) = o; }
    LDS_WAIT(); asm volatile("" ::: "memory");
}
enum { I_XP = 0, I_XS, I_CCMP, I_CSLC, I_SWIN, I_SCONV, I_PT, I_NORMW, I_FNORMW, I_AIN, I_ACONV, I_AOUT, I_BIN, I_BOUT, I_KVNORM, I_KVW, I_PE, I_W1, I_W2, I_FIN, I_FOUT };

__device__ __forceinline__ void p0_prologue(Frame& F, const Args& A, int part, int cu_lo, int cu_cnt) {
    unsigned char* ws = A.ws;
    LAS float* scr = (LAS float*)(F.lds + RING_OFF + F.wave * 16384);
    const int cu = (int)blockIdx.x - cu_lo; if (cu < 0 || cu >= cu_cnt) return;
    const int gw = cu * NWAVES + F.wave, NGW = cu_cnt * NWAVES;
    const float* normw = A.in[I_NORMW];
    constexpr int IT_AIN = (NAIN / 32) * (DM / 64), IT_SQ = (DM / 32) * (DM / 64), IT_FIN = (NFF / 32) * (DM / 64), IT_FOUT = (DM / 32) * (DFF / 64), IT_KVQ = (NKVQ / 32) * (DM / 64),
                  IT_W1 = 2 * (64 / 32) * (2048 / 64), IT_W2 = 2 * 2;
    constexpr int NITEMS = IT_AIN + 2 * IT_SQ + 2 * IT_FIN + 2 * IT_FOUT + IT_KVQ + IT_W1 + IT_W2;
    for (int it = gw; it < NITEMS; it += NGW) {
        int r = it;
        if (r < IT_AIN) { if (part != 0) continue; const int ng = r / 16, kb = r % 16, n0 = ng * 32, pn = n0 >> 8, w = n0 & 255;
            const int scol = pn < 8 ? (w < 128 ? 1024 + pn * 128 + w : 2048 + pn * 128 + (w - 128)) : (pn - 8) * 256 + w;
            tr_item(A.in[I_AIN], NAIN, scol, 32, normw, 1.f, (bf16*)(ws + WS_WAIN), DM, n0, kb * 64, scr, F.lane); continue; } r -= IT_AIN;
        if (r < IT_SQ) { if (part != 0) continue; const int ng = r / 16, kb = r % 16; tr_item(A.in[I_AOUT], DM, ng * 32, 32, nullptr, 1.f, (bf16*)(ws + WS_WAOUT), DM, ng * 32, kb * 64, scr, F.lane); continue; } r -= IT_SQ;
        if (r < IT_SQ) { if (part != 1) continue; const int ng = r / 16, kb = r % 16; tr_item(A.in[I_BOUT], DM, ng * 32, 32, nullptr, 1.f, (bf16*)(ws + WS_WBOUT), DM, ng * 32, kb * 64, scr, F.lane); continue; } r -= IT_SQ;
        if (r < 2 * IT_FIN) { const int l = r / IT_FIN; if (l != part) continue; const int q = r % IT_FIN, ng = q / 16, kb = q % 16, n0 = ng * 32, pn = n0 >> 8, w = n0 & 255;
            const int scol = w < 128 ? pn * 128 + w : DFF + pn * 128 + (w - 128);
            tr_item(A.in[I_FIN] + (size_t)l * DM * NFF, NFF, scol, 32, normw + (l * 2 + 1) * DM, 1.f, (bf16*)(ws + (l ? WS_WFIN1 : WS_WFIN0)), DM, n0, kb * 64, scr, F.lane); continue; } r -= 2 * IT_FIN;
        if (r < 2 * IT_FOUT) { const int l = r / IT_FOUT; if (l != part) continue; const int q = r % IT_FOUT, ng = q / 44, kb = q % 44;
            tr_item(A.in[I_FOUT] + (size_t)l * DFF * DM, DM, ng * 32, 32, nullptr, 1.f, (bf16*)(ws + (l ? WS_WFOUT1 : WS_WFOUT0)), DFF, ng * 32, kb * 64, scr, F.lane); continue; } r -= 2 * IT_FOUT;
        if (part != 1) continue;
        if (r < IT_KVQ) { const int ng = r / 16, kb = r % 16, n0 = ng * 32; bf16* dst = (bf16*)(ws + WS_WKVQ);
            if (n0 < NKV) tr_item(A.in[I_KVW], NKV, n0, 32, A.in[I_KVNORM], 1.f, dst, DM, n0, kb * 64, scr, F.lane);
            else if (n0 < NKV + 1024) tr_item(A.in[I_BIN], 1072, n0 - NKV, 32, normw + 2 * DM, QSCALE, dst, DM, n0, kb * 64, scr, F.lane);
            else { const int g0 = n0 - (NKV + 1024); const int nv = g0 >= 48 ? 0 : (48 - g0 < 32 ? 48 - g0 : 32);
                tr_item(A.in[I_BIN], 1072, 1024 + (nv ? g0 : 0), nv, normw + 2 * DM, 1.f, dst, DM, n0, kb * 64, scr, F.lane); }
            continue; } r -= IT_KVQ;
        if (r < IT_W1) { const int k = r / 64, q = r % 64, ng = q / 32, kb = q % 32;
            tr_item(A.in[I_W1] + (size_t)k * 2048 * 64, 64, ng * 32, 32, nullptr, 1.f, (bf16*)(ws + WS_W1T) + (size_t)k * 64 * 2048, 2048, ng * 32, kb * 64, scr, F.lane); continue; } r -= IT_W1;
        { const int k = r / 2, ng = r % 2;
            tr_item(A.in[I_W2] + (size_t)k * 64 * 64, 64, ng * 32, 32, nullptr, 1.f, (bf16*)(ws + WS_W2T) + (size_t)k * 64 * 64, 64, ng * 32, 0, scr, F.lane); }
    }
    if (part == 1) for (int o = gw; o < 128; o += NGW) { const int k = o >> 6, h = o & 63; const float* pe = A.in[I_PE] + (size_t)k * 2048; const float* w1 = A.in[I_W1] + (size_t)k * 2048 * 64 + h;
        float s = 0.f; for (int i = F.lane; i < 2048; i += 64) s += pe[i] * w1[(size_t)i * 64];
        s = wave_sum(s); if (F.lane == 0) ((float*)(ws + WS_PEB))[o] = s; }
    if (part == 0) for (int m0 = 2 * gw; m0 < MT; m0 += 2 * NGW) {
        f32x4 v[2][4]; float s[2];
#pragma unroll
        for (int r = 0; r < 2; ++r) { const int m = m0 + r; const float* xrow = m < MP ? A.in[I_XP] + (size_t)m * DM : A.in[I_XS] + (size_t)(m - MP) * DM;
            const GAS f32x4* xr = (const GAS f32x4*)xrow + F.lane;
#pragma unroll
            for (int j = 0; j < 4; ++j) v[r][j] = xr[64 * j]; }
#pragma unroll
        for (int r = 0; r < 2; ++r) { const int m = m0 + r; s[r] = 0.f;
#pragma unroll
            for (int j = 0; j < 4; ++j) s[r] += (v[r][j].x * v[r][j].x + v[r][j].y * v[r][j].y) + (v[r][j].z * v[r][j].z + v[r][j].w * v[r][j].w);
            s[r] = wave_sum(s[r]);
            GAS v2u* o8 = (GAS v2u*)((bf16*)(ws + WS_XB) + (size_t)m * DM) + F.lane;
#pragma unroll
            for (int j = 0; j < 4; ++j) { v2u wv; wv.x = pk2(v[r][j].x, v[r][j].y); wv.y = pk2(v[r][j].z, v[r][j].w); o8[64 * j] = wv; }
            if (F.lane == 0) ((float*)(ws + WS_RSTD0))[m] = __builtin_amdgcn_rsqf(s[r] * (1.0f / DM) + RMS_EPS); }
    }
}
__device__ __forceinline__ void p_wincopy(Frame& F, const Args& A, int cu_lo, int cu_cnt) {
    const int cu = (int)blockIdx.x - cu_lo; if (cu < 0 || cu >= cu_cnt) return;
    const GAS f32x4* src = (const GAS f32x4*)A.in[I_SWIN]; GAS f32x4* dst = (GAS f32x4*)(A.out + O_WINS);
    const size_t per = (size_t)504 * 128, total = (size_t)NBS * per; const size_t gt = (size_t)cu * 512 + F.tid, GT_ = (size_t)cu_cnt * 512;
    for (size_t i = gt; i < total; i += 4 * GT_) { f32x4 v[4];
#pragma unroll
        for (int j = 0; j < 4; ++j) { const size_t ii = i + j * GT_; if (ii < total) { const size_t n = ii / per, rem = ii % per; v[j] = __builtin_nontemporal_load(src + n * (512 * 128) + 8 * 128 + rem); } }
#pragma unroll
        for (int j = 0; j < 4; ++j) { const size_t ii = i + j * GT_; if (ii < total) { const size_t n = ii / per, rem = ii % per; __builtin_nontemporal_store(v[j], dst + n * (512 * 128) + rem); } } }
}
__device__ __forceinline__ void p2_conv(Frame& F, const Args& A, int row_lo, int row_hi, int cu_lo, int cu_cnt) {
    unsigned char* ws = A.ws; const bf16* VB = (const bf16*)(ws + WS_VB); const bf16* BB = (const bf16*)(ws + WS_BB); bf16* Z = (bf16*)(ws + WS_Z);
    const float* cw = A.in[I_ACONV]; const float* sc = A.in[I_SCONV];
    const int cu = (int)blockIdx.x - cu_lo; if (cu < 0 || cu >= cu_cnt) return;
    const size_t gt = (size_t)cu * 512 + F.tid, GT_ = (size_t)cu_cnt * 512, total = (size_t)(row_hi - row_lo) * 128;
    const int c8 = (int)(gt & 127) * 8;
    float cw0[8], cw1[8], cw2[8];
#pragma unroll
    for (int e = 0; e < 8; ++e) { cw0[e] = cw[c8 + e]; cw1[e] = cw[DM + c8 + e]; cw2[e] = cw[2 * DM + c8 + e]; }
    for (size_t i = gt; i < total; i += GT_) {
        const int row = row_lo + (int)(i >> 7); int t, tlen; const float* pre = nullptr;
        if (row < MP) { t = row & (TP - 1); tlen = TP; } else { const int rs = row - MP; t = rs & 7; tlen = TS; pre = sc + (size_t)(rs >> 3) * 2 * DM; }
        const v4u vb = *(const GAS v4u*)(BB + (size_t)row * DM + c8), v2 = *(const GAS v4u*)(VB + (size_t)row * DM + c8);
        float f1[8], f0[8];
        if (t >= 1) { const v4u q = *(const GAS v4u*)(VB + (size_t)(row - 1) * DM + c8);
#pragma unroll
            for (int e = 0; e < 4; ++e) { f1[2 * e] = bf2f(q[e] & 0xffffu); f1[2 * e + 1] = bf2f(q[e] >> 16); } }
        else {
#pragma unroll
            for (int e = 0; e < 8; ++e) f1[e] = pre ? pre[DM + c8 + e] : 0.f; }
        if (t >= 2) { const v4u q = *(const GAS v4u*)(VB + (size_t)(row - 2) * DM + c8);
#pragma unroll
            for (int e = 0; e < 4; ++e) { f0[2 * e] = bf2f(q[e] & 0xffffu); f0[2 * e + 1] = bf2f(q[e] >> 16); } }
        else {
#pragma unroll
            for (int e = 0; e < 8; ++e) f0[e] = pre ? pre[(size_t)t * DM + c8 + e] : 0.f; }
        float z[8], vv[8];
#pragma unroll
        for (int e = 0; e < 4; ++e) { vv[2 * e] = bf2f(v2[e] & 0xffffu); vv[2 * e + 1] = bf2f(v2[e] >> 16); }
#pragma unroll
        for (int e = 0; e < 8; ++e) { const float b = bf2f((vb[e >> 1] >> ((e & 1) * 16)) & 0xffffu);
            z[e] = b * (cw0[e] * f0[e] + cw1[e] * f1[e] + cw2[e] * vv[e]); }
        v4u o; o.x = pk2(z[0], z[1]); o.y = pk2(z[2], z[3]); o.z = pk2(z[4], z[5]); o.w = pk2(z[6], z[7]);
        *(GAS v4u*)(Z + (size_t)row * DM + c8) = o;
        if (t >= tlen - 2) { float* dst = row < MP ? A.out + O_CONVP + ((size_t)(row >> 13) * 2 + (t - (tlen - 2))) * DM + c8
                                                  : A.out + O_CONVS + ((size_t)((row - MP) >> 3) * 2 + (t - (tlen - 2))) * DM + c8;
#pragma unroll
            for (int e = 0; e < 8; ++e) dst[e] = vv[e]; }
    }
}
__device__ __forceinline__ void p_final(Frame& F, const Args& A, int row_lo, int row_hi, int cu_lo, int cu_cnt) {
    const bf16* HB = (const bf16*)(A.ws + WS_HB); const GAS f32x4* fw = (const GAS f32x4*)A.in[I_FNORMW];
    const int cu = (int)blockIdx.x - cu_lo; if (cu < 0 || cu >= cu_cnt) return;
    const int gw = cu * NWAVES + F.wave, NGW = cu_cnt * NWAVES;
    f32x4 w[4];
#pragma unroll
    for (int j = 0; j < 4; ++j) w[j] = fw[4 * F.lane + j];
    for (int m = row_lo + gw; m < row_hi; m += NGW) {
        const GAS v4u* xr = (const GAS v4u*)(HB + (size_t)m * DM) + 2 * F.lane; const v4u a = xr[0], b = xr[1]; f32x4 v[4]; float s = 0.f;
        v[0] = (f32x4){bf2f(a.x & 0xffffu), bf2f(a.x >> 16), bf2f(a.y & 0xffffu), bf2f(a.y >> 16)}; v[1] = (f32x4){bf2f(a.z & 0xffffu), bf2f(a.z >> 16), bf2f(a.w & 0xffffu), bf2f(a.w >> 16)};
        v[2] = (f32x4){bf2f(b.x & 0xffffu), bf2f(b.x >> 16), bf2f(b.y & 0xffffu), bf2f(b.y >> 16)}; v[3] = (f32x4){bf2f(b.z & 0xffffu), bf2f(b.z >> 16), bf2f(b.w & 0xffffu), bf2f(b.w >> 16)};
#pragma unroll
        for (int j = 0; j < 4; ++j) s += (v[j].x * v[j].x + v[j].y * v[j].y) + (v[j].z * v[j].z + v[j].w * v[j].w);
        const float r = __builtin_amdgcn_rsqf(wave_sum(s) * (1.0f / DM) + RMS_EPS);
        GAS f32x4* o = (GAS f32x4*)(A.out + (m < MP ? O_YP + (size_t)m * DM : O_YS + (size_t)(m - MP) * DM)) + 4 * F.lane;
#pragma unroll
        for (int j = 0; j < 4; ++j) o[j] = v[j] * r * w[j];
    }
}
__device__ __forceinline__ void p_zero16(Frame& F, void* p, size_t bytes) {
    GAS v4u* d = (GAS v4u*)p; const size_t n = bytes / 16, gt = (size_t)F.vcu * 512 + F.tid, GT_ = (size_t)F.G * 512;
    for (size_t i = gt; i < n; i += GT_) d[i] = (v4u){0u, 0u, 0u, 0u};
}
constexpr int P7_IMG_BYTES = 144 * 512, P7_HID = 2 * P7_IMG_BYTES, P7_HID_STRIDE = 144;
static_assert(P7_HID + 32 * P7_HID_STRIDE <= RING_BYTES, "compress LDS");
__device__ __forceinline__ int p7_swz(int pos_l, int g, int dchunk) { return pos_l * 512 + g * 128 + ((dchunk ^ ((pos_l >> 4) & 3) ^ ((g >> 1) << 2)) << 4); }
struct P7Unit { int isp, seq, seg; };
__device__ __forceinline__ bool p7_unit(int i, int cu2, int ncu2, P7Unit& U) {
    if (i == 0) { if (cu2 >= NBP * 64) return false; U.isp = 1; U.seq = cu2 >> 6; U.seg = cu2 & 63; return true; }
    const int v = (i - 1) * ncu2 + cu2; if (v >= NBS * NPAGE) return false; U.isp = 0; U.seq = v >> 4; U.seg = v & 15; return true;
}
struct P7Batch { f32x4 a[3], b[3]; };
template <int C0, int NCH> __device__ __forceinline__ void p7_load(P7Batch& R, const P7Unit& U, int k, const Args& A, int tid) {
    asm volatile("" : "+v"(tid));
    const int pos0 = U.seg * 128;
    if (U.isp) { const bf16* KVB = (const bf16*)(A.ws + WS_KVB);
#pragma unroll
        for (int i = 0; i < NCH; ++i) { const int c = tid + (C0 + i) * 512, pos_l = c >> 5, g = (c >> 3) & 3, dc = c & 7, pos = pos0 + pos_l; v4u r = (v4u){0u, 0u, 0u, 0u};
            if (pos < TP) r = *(const GAS v4u*)(KVB + ((size_t)U.seq * TP + pos) * NKV + k * 256 + g * 64 + dc * 8);
            R.a[i] = __builtin_bit_cast(f32x4, r); }
    } else { const int* ptab = (const int*)A.in[I_PT]; const float* cache = A.in[I_CCMP];
        const int pgA = ptab[U.seq * NPAGE + U.seg], pgB = U.seg < 15 ? ptab[U.seq * NPAGE + U.seg + 1] : 0;
#pragma unroll
        for (int i = 0; i < NCH; ++i) { const int c = tid + (C0 + i) * 512, pos_l = c >> 5, g = (c >> 3) & 3, dc = c & 7, pos = pos0 + pos_l;
            R.a[i] = (f32x4){0.f, 0.f, 0.f, 0.f}; R.b[i] = R.a[i];
            if (pos < PAST) { const float* s = cache + ((size_t)(pos_l < 128 ? pgA : pgB) * PAGE + (pos_l & 127)) * 512 + k * 256 + g * 64 + dc * 8; R.a[i] = *(const GAS f32x4*)s; R.b[i] = *(const GAS f32x4*)(s + 4); } }
    }
}
template <int C0, int NCH> __device__ __forceinline__ void p7_store(const P7Batch& R, const P7Unit& U, LAS unsigned char* img, int tid) {
    asm volatile("" : "+v"(tid));
#pragma unroll
    for (int i = 0; i < NCH; ++i) { const int c = tid + (C0 + i) * 512, pos_l = c >> 5, g = (c >> 3) & 3, dc = c & 7; v4u o;
        if (U.isp) o = __builtin_bit_cast(v4u, R.a[i]);
        else { o.x = pg8::cvt_pk_bf16(R.a[i][0], R.a[i][1]); o.y = pg8::cvt_pk_bf16(R.a[i][2], R.a[i][3]); o.z = pg8::cvt_pk_bf16(R.b[i][0], R.b[i][1]); o.w = pg8::cvt_pk_bf16(R.b[i][2], R.b[i][3]); }
        *(LAS v4u*)(img + p7_swz(pos_l, g, dc)) = o; }
}
__device__ __forceinline__ void p7_compress(Frame& F, const Args& A, int mode, int budget) {
    unsigned char* ws = A.ws; LAS unsigned char* L = F.lds + RING_OFF; LAS unsigned char* hidp = L + P7_HID;
    const bf16* W1T = (const bf16*)(ws + WS_W1T); const bf16* W2T = (const bf16*)(ws + WS_W2T); const float* PEB = (const float*)(ws + WS_PEB);
    const int lane = F.lane, w = F.wave, tid = F.tid, l15 = lane & 15, lq = lane >> 4;
    const int k = F.vcu & 1, cu2 = F.vcu >> 1, ncu2 = (F.G + 1 - k) >> 1;
    constexpr int NTK = NBS * NPAGE;
    unsigned* qctr = (unsigned*)(F.ctl + CW_Q7 + 64 * k);
    P7Unit U, Un; P7Batch R; bool have; int tnext = NTK, tnext2 = NTK;
    if (mode == 0) { have = p7_unit(0, cu2, ncu2, U); }
    else {
        if (budget <= 0) return;
        const unsigned n0 = budget >= 3 ? 3u : (unsigned)budget;
        if (tid == 0) F.MISC[17] = __hip_atomic_fetch_add(qctr, n0, __ATOMIC_RELAXED, __HIP_MEMORY_SCOPE_AGENT);
        __syncthreads();
        const int t0 = (int)F.MISC[17];
        __syncthreads();
        have = t0 < NTK; U.isp = 0; U.seq = t0 >> 4; U.seg = t0 & 15;
        if (n0 >= 2 && t0 + 1 < NTK) tnext = t0 + 1;
        if (n0 >= 3 && t0 + 2 < NTK) tnext2 = t0 + 2;
    }
    if (!have) return;
    bf16x8 bw[8][4];
#pragma unroll
    for (int kl = 0; kl < 8; ++kl)
#pragma unroll
        for (int nt = 0; nt < 4; ++nt) bw[kl][nt] = *(const GAS bf16x8*)(W1T + ((size_t)(k * 64 + nt * 16 + l15)) * 2048 + (8 * w + kl) * 32 + lq * 8);
    p7_load<0, 3>(R, U, k, A, tid); p7_store<0, 3>(R, U, L, tid); p7_load<3, 3>(R, U, k, A, tid); p7_store<3, 3>(R, U, L, tid); p7_load<6, 3>(R, U, k, A, tid); p7_store<6, 3>(R, U, L, tid);
    __syncthreads();
    int buf = 0, nrun = 0;
    while (have) {
        LAS unsigned char* img = L + buf * P7_IMG_BYTES; LAS unsigned char* nimg = L + (buf ^ 1) * P7_IMG_BYTES; LAS float* red = (LAS float*)img;
        const bool hn = tnext < NTK; Un.isp = 0; Un.seq = tnext >> 4; Un.seg = tnext & 15;
        const bool want3 = mode == 1 && tnext2 < NTK && nrun + 3 < budget; unsigned tk = 0u;
        if (want3 && tid == 0) tk = __hip_atomic_fetch_add(qctr, 1u, __ATOMIC_RELAXED, __HIP_MEMORY_SCOPE_AGENT);
        const int ntok = (U.isp ? U.seg == 63 : U.seg == 15) ? 7 : 8;
        f32x4 acc[2][4];
#pragma unroll
        for (int a = 0; a < 2; ++a)
#pragma unroll
            for (int b = 0; b < 4; ++b) acc[a][b] = (f32x4){0.f, 0.f, 0.f, 0.f};
        if (hn) p7_load<0, 3>(R, Un, k, A, tid);
#pragma unroll
        for (int kl = 0; kl < 8; ++kl) { const int ks = 8 * w + kl, j = ks >> 1, dh = ks & 1; bf16x8 afr[2];
            if (kl == 3 && hn) { p7_store<0, 3>(R, Un, nimg, tid); p7_load<3, 3>(R, Un, k, A, tid); }
            if (kl == 6 && hn) { p7_store<3, 3>(R, Un, nimg, tid); p7_load<6, 3>(R, Un, k, A, tid); }
#pragma unroll
            for (int mt = 0; mt < 2; ++mt) { const int tok = mt * 4 + (l15 >> 2), g = l15 & 3, pos_l = 16 * tok + j; afr[mt] = *(const LAS bf16x8*)(img + p7_swz(pos_l, g, dh * 4 + lq)); }
#pragma unroll
            for (int mt = 0; mt < 2; ++mt)
#pragma unroll
                for (int nt = 0; nt < 4; ++nt) acc[mt][nt] = __builtin_amdgcn_mfma_f32_16x16x32_bf16(afr[mt], bw[kl][nt], acc[mt][nt], 0, 0, 0);
        }
        if (hn) p7_store<6, 3>(R, Un, nimg, tid);
        __syncthreads();
#pragma unroll
        for (int mt = 0; mt < 2; ++mt)
#pragma unroll
            for (int nt = 0; nt < 4; ++nt)
#pragma unroll
                for (int rg = 0; rg < 4; ++rg) red[(w * 32 + mt * 16 + 4 * lq + rg) * 64 + nt * 16 + l15] = acc[mt][nt][rg];
        if (want3 && tid == 0) F.MISC[17] = tk;
        __syncthreads();
        { const int row = tid >> 4, col = (tid & 15) * 4; f32x4 s = *(const LAS f32x4*)(red + row * 64 + col);
#pragma unroll
            for (int ww = 1; ww < 8; ++ww) s += *(const LAS f32x4*)(red + (ww * 32 + row) * 64 + col);
            const f32x4 pb = *(const GAS f32x4*)(PEB + k * 64 + col); float h[4];
#pragma unroll
            for (int e = 0; e < 4; ++e) { const float x = s[e] + pb[e]; h[e] = x * __builtin_amdgcn_rcpf(1.0f + __builtin_amdgcn_exp2f(x * -1.4426950408889634f)); }
            v2u o; o.x = pg8::cvt_pk_bf16(h[0], h[1]); o.y = pg8::cvt_pk_bf16(h[2], h[3]); *(LAS v2u*)(hidp + row * P7_HID_STRIDE + col * 2) = o; }
        const int t3 = want3 ? (int)F.MISC[17] : NTK;
        __syncthreads();
        { const int mt = w >> 2, nt = w & 3; f32x4 a2 = (f32x4){0.f, 0.f, 0.f, 0.f};
#pragma unroll
            for (int k2 = 0; k2 < 2; ++k2) { const bf16x8 af = *(const LAS bf16x8*)(hidp + (mt * 16 + l15) * P7_HID_STRIDE + k2 * 64 + lq * 16);
                const bf16x8 bf = *(const GAS bf16x8*)(W2T + ((size_t)(k * 64 + nt * 16 + l15)) * 64 + k2 * 32 + lq * 8);
                a2 = __builtin_amdgcn_mfma_f32_16x16x32_bf16(af, bf, a2, 0, 0, 0); }
            const int tok = mt * 4 + lq; bf16* kc = U.isp ? (bf16*)(ws + WS_KCP) + (((size_t)U.seq * 512 + U.seg * 8 + tok) * 2 + k) * 256 : (bf16*)(ws + WS_KCS) + (((size_t)U.seq * 128 + U.seg * 8 + tok) * 2 + k) * 256;
#pragma unroll
            for (int rg = 0; rg < 4; ++rg) kc[rg * 64 + nt * 16 + l15] = (bf16)(tok < ntok ? f2bf(a2[rg]) : 0u); }
        U = Un; have = hn; tnext = tnext2; tnext2 = t3 < NTK ? t3 : NTK; ++nrun; buf ^= 1;
    }
    __syncthreads();
}
constexpr int KT_STRIDE = 144, VT_STRIDE = 160;
constexpr float S_NEG = -1.0e30f, M_INIT = -1000.0f, RESC_THR = 8.0f;
typedef short s16x4 __attribute__((ext_vector_type(4)));
struct AttState { float m[2], l[2]; f32x4 o[2][4]; f32x4 lo[2]; };
__device__ __forceinline__ void att_init(AttState& st) {
#pragma unroll
    for (int c = 0; c < 2; ++c) { st.m[c] = M_INIT; st.l[c] = 0.f; st.lo[c] = (f32x4){0.f, 0.f, 0.f, 0.f};
#pragma unroll
        for (int d = 0; d < 4; ++d) st.o[c][d] = (f32x4){0.f, 0.f, 0.f, 0.f}; }
}
__device__ __forceinline__ s16x4 tr_read(const LAS unsigned char* p) { return __builtin_bit_cast(s16x4, __builtin_amdgcn_ds_read_tr16_b64_v4i16((LAS s16x4*)p)); }
template <int NKT, int MODE>
__device__ __forceinline__ void wave_block(const LAS unsigned char* kt, const LAS unsigned char* vt, const bf16x8 (&qf)[2][2], AttState& st, const float (&bias)[2], const bool (&act)[2],
                                           bool boundary, const int (&lo)[2], const int (&hi)[2], int lane, LAS float* imp_row0, int imp_blk0, int imp_stride) {
    const int l15 = lane & 15, lq = lane >> 4;
    if (!act[0] && !act[1]) return;
    bf16x8 kf[NKT][2];
#pragma unroll
    for (int t = 0; t < NKT; ++t)
#pragma unroll
        for (int ks = 0; ks < 2; ++ks) kf[t][ks] = *(const LAS bf16x8*)(kt + (t * 16 + l15) * KT_STRIDE + ks * 64 + lq * 16);
    bf16x8 pfr[2][NKT / 2];
#pragma unroll
    for (int c = 0; c < 2; ++c) {
        if (!act[c]) continue;
        const float c0 = bias[c] - st.m[c];
        f32x4 s[NKT];
#pragma unroll
        for (int t = 0; t < NKT; ++t) { s[t] = (f32x4){c0, c0, c0, c0};
            s[t] = __builtin_amdgcn_mfma_f32_16x16x32_bf16(kf[t][0], qf[c][0], s[t], 0, 0, 0);
            s[t] = __builtin_amdgcn_mfma_f32_16x16x32_bf16(kf[t][1], qf[c][1], s[t], 0, 0, 0); }
        if (boundary) { const int l2 = lo[c] - 4 * lq, h2 = hi[c] - 4 * lq;
#pragma unroll
            for (int t = 0; t < NKT; ++t)
#pragma unroll
                for (int r = 0; r < 4; ++r) { const int kk = t * 16 + r; if (kk < l2 || kk > h2) s[t][r] = S_NEG; } }
        float mx = s[0][0];
#pragma unroll
        for (int t = 0; t < NKT; ++t)
#pragma unroll
            for (int r = 0; r < 4; ++r) mx = fmaxf(mx, s[t][r]);
        mx = fmaxf(mx, __shfl_xor(mx, 16)); mx = fmaxf(mx, __shfl_xor(mx, 32));
        if (MODE == 1) {
            const float dl = fmaxf(mx, 0.f), f = __builtin_amdgcn_exp2f(-dl); st.m[c] += dl; float a = 0.f;
#pragma unroll
            for (int t = 0; t < NKT; ++t)
#pragma unroll
                for (int r = 0; r < 4; ++r) a += __builtin_amdgcn_exp2f(s[t][r] - dl);
            st.l[c] = st.l[c] * f + a;
            continue;
        }
        if (MODE == 0) {
            if (__any(mx > RESC_THR)) {
                const float dl = fmaxf(mx, 0.f), f = __builtin_amdgcn_exp2f(-dl); st.m[c] += dl; st.l[c] *= f;
#pragma unroll
                for (int t = 0; t < NKT; ++t) s[t] = s[t] - dl;
#pragma unroll
                for (int r = 0; r < 4; ++r) { const float fr = __shfl(f, 4 * lq + r);
#pragma unroll
                    for (int dt = 0; dt < 4; ++dt) st.o[c][dt][r] *= fr; }
            }
        }
        float a = 0.f;
#pragma unroll
        for (int t = 0; t < NKT; ++t)
#pragma unroll
            for (int r = 0; r < 4; ++r) { s[t][r] = __builtin_amdgcn_exp2f(s[t][r]); a += s[t][r]; }
        if (MODE == 0) st.l[c] += a;
        if (MODE == 2) {
            const float li = st.l[c];
#pragma unroll
            for (int t = 0; t < NKT; ++t) { s[t] = s[t] * li;
                float ia = 2.f * (s[t][0] + s[t][1] + s[t][2]) + s[t][3], ib = s[t][3];
                ia += __shfl_xor(ia, 1); ia += __shfl_xor(ia, 2); ib += __shfl_xor(ib, 1); ib += __shfl_xor(ib, 2);
                if ((l15 & 3) == 0) { LAS float* ir = imp_row0 + (c * 4 + (l15 >> 2)) * imp_stride + imp_blk0 + 4 * t + lq; atomicAdd((float*)ir, ia); atomicAdd((float*)(ir + 1), ib); } }
        }
#pragma unroll
        for (int G = 0; G < NKT / 2; ++G) {
            v4u pw; pw.x = pg8::cvt_pk_bf16(s[2 * G][0], s[2 * G][1]); pw.y = pg8::cvt_pk_bf16(s[2 * G][2], s[2 * G][3]); pw.z = pg8::cvt_pk_bf16(s[2 * G + 1][0], s[2 * G + 1][1]); pw.w = pg8::cvt_pk_bf16(s[2 * G + 1][2], s[2 * G + 1][3]);
            pfr[c][G] = __builtin_bit_cast(bf16x8, pw); }
    }
    if (MODE == 1) return;
    asm volatile("" ::: "memory");
    const LAS unsigned char* vb = vt + (4 * lq + (l15 >> 2)) * VT_STRIDE + (l15 & 3) * 8;
#pragma unroll
    for (int G = 0; G < NKT / 2; ++G) {
        bf16x8 vf[4];
#pragma unroll
        for (int dt = 0; dt < 4; ++dt) { const s16x4 a = tr_read(vb + (32 * G) * VT_STRIDE + dt * 32), b = tr_read(vb + (32 * G + 16) * VT_STRIDE + dt * 32);
            vf[dt] = (bf16x8){a[0], a[1], a[2], a[3], b[0], b[1], b[2], b[3]}; }
#pragma unroll
        for (int c = 0; c < 2; ++c) { if (!act[c]) continue;
#pragma unroll
            for (int dt = 0; dt < 4; ++dt) st.o[c][dt] = __builtin_amdgcn_mfma_f32_16x16x32_bf16(pfr[c][G], vf[dt], st.o[c][dt], 0, 0, 0); }
        asm volatile("" ::: "memory");
    }
}
__device__ __forceinline__ void att_finish(const AttState& st, int c, int lane, float (&linv)[4]) {
    float l = st.l[c]; l += __shfl_xor(l, 16); l += __shfl_xor(l, 32);
    const float li = 1.0f / fmaxf(l, 1e-30f);
#pragma unroll
    for (int r = 0; r < 4; ++r) linv[r] = __shfl(li, 4 * (lane >> 4) + r);
}
__device__ __forceinline__ void select_blocks(float v0, float v1, int cur, int lane, unsigned long long& sel0, unsigned long long& sel1) {
    const unsigned k0 = __float_as_uint(v0), k1 = __float_as_uint(v1);
    const bool e0 = lane >= 1 && lane <= cur - 2, e1 = (lane + 64) <= cur - 2;
    const int nforced = cur >= 2 ? 3 : cur + 1, need = 16 - nforced, nelig = cur - 2 > 0 ? cur - 2 : 0;
    unsigned long long s0 = 1ull, s1 = 0ull;
    if (cur < 64) s0 |= 1ull << cur; else s1 |= 1ull << (cur - 64);
    if (cur >= 1) { if (cur - 1 < 64) s0 |= 1ull << (cur - 1); else s1 |= 1ull << (cur - 65); }
    if (nelig <= need) { s0 |= __ballot(e0); s1 |= __ballot(e1); }
    else {
        unsigned T = 0u;
        for (int bit = 30; bit >= 0; --bit) { const unsigned cand = T | (1u << bit);
            const int cnt = __popcll(__ballot(e0 && k0 >= cand)) + __popcll(__ballot(e1 && k1 >= cand));
            if (cnt >= need) T = cand; }
        const unsigned long long g0 = __ballot(e0 && k0 > T), g1 = __ballot(e1 && k1 > T);
        unsigned long long q0 = __ballot(e0 && k0 == T), q1 = __ballot(e1 && k1 == T);
        int rem = need - (__popcll(g0) + __popcll(g1));
        s0 |= g0; s1 |= g1;
        while (rem > 0 && (q0 | q1)) { if (q0) { const unsigned long long b = q0 & (~q0 + 1ull); s0 |= b; q0 ^= b; } else { const unsigned long long b = q1 & (~q1 + 1ull); s1 |= b; q1 ^= b; } --rem; }
    }
    sel0 = s0; sel1 = s1;
}

__device__ __forceinline__ void select_blocks4(const float (&v0)[4], const float (&v1)[4], int cur, int lane, unsigned long long (&sel0)[4], unsigned long long (&sel1)[4]) {
    const bool e0 = lane >= 1 && lane <= cur - 2, e1 = (lane + 64) <= cur - 2;
    const int nforced = cur >= 2 ? 3 : cur + 1, need = 16 - nforced, nelig = cur - 2 > 0 ? cur - 2 : 0;
    unsigned long long f0 = 1ull, f1 = 0ull;
    if (cur < 64) f0 |= 1ull << cur; else f1 |= 1ull << (cur - 64);
    if (cur >= 1) { if (cur - 1 < 64) f0 |= 1ull << (cur - 1); else f1 |= 1ull << (cur - 65); }
    if (nelig <= need) { const unsigned long long a = f0 | __ballot(e0), b = f1 | __ballot(e1);
#pragma unroll
        for (int t = 0; t < 4; ++t) { sel0[t] = a; sel1[t] = b; }
        return; }
    unsigned k0[4], k1[4], T[4];
#pragma unroll
    for (int t = 0; t < 4; ++t) { k0[t] = __float_as_uint(v0[t]); k1[t] = __float_as_uint(v1[t]); T[t] = 0u; }
    for (int bit = 30; bit >= 0; --bit) {
#pragma unroll
        for (int t = 0; t < 4; ++t) { const unsigned cand = T[t] | (1u << bit);
            const int cnt = __popcll(__ballot(e0 && k0[t] >= cand)) + __popcll(__ballot(e1 && k1[t] >= cand));
            if (cnt >= need) T[t] = cand; } }
#pragma unroll
    for (int t = 0; t < 4; ++t) {
        const unsigned long long g0 = __ballot(e0 && k0[t] > T[t]), g1 = __ballot(e1 && k1[t] > T[t]);
        unsigned long long q0 = __ballot(e0 && k0[t] == T[t]), q1 = __ballot(e1 && k1[t] == T[t]);
        int rem = need - (__popcll(g0) + __popcll(g1)); unsigned long long s0 = f0 | g0, s1 = f1 | g1;
        while (rem > 0 && (q0 | q1)) { if (q0) { const unsigned long long b = q0 & (~q0 + 1ull); s0 |= b; q0 ^= b; } else { const unsigned long long b = q1 & (~q1 + 1ull); s1 |= b; q1 ^= b; } --rem; }
        sel0[t] = s0; sel1[t] = s1; }
}
__device__ __forceinline__ unsigned pick4(const unsigned (&a)[4], int i) { return i == 0 ? a[0] : i == 1 ? a[1] : i == 2 ? a[2] : a[3]; }
constexpr int P8_GB = 65536, P8_SELB = 2 * P8_GB, P8_IMP = P8_GB  , P8_END = P8_SELB + 64 * 16;
static_assert(P8_END <= RING_BYTES && 64 * 132 * 4 <= P8_GB, "attention LDS");
__device__ __forceinline__ float amax3(float a, float b, float c) { float r; asm("v_max3_f32 %0, %1, %2, %3" : "=v"(r) : "v"(a), "v"(b), "v"(c)); return r; }
__device__ __forceinline__ float amax2(float a, float b) { float r; asm("v_max_f32_e32 %0, %1, %2" : "=v"(r) : "v"(a), "v"(b)); return r; }
__device__ __forceinline__ float rowmax4(float x) {
    auto r = __builtin_amdgcn_permlane16_swap(__float_as_uint(x), __float_as_uint(x), false, false); x = amax2(__uint_as_float(r[0]), __uint_as_float(r[1]));
    auto q = __builtin_amdgcn_permlane32_swap(__float_as_uint(x), __float_as_uint(x), false, false); return amax2(__uint_as_float(q[0]), __uint_as_float(q[1]));
}
__device__ __forceinline__ float rowsum4(float x) {
    auto r = __builtin_amdgcn_permlane16_swap(__float_as_uint(x), __float_as_uint(x), false, false); x = __uint_as_float(r[0]) + __uint_as_float(r[1]);
    auto q = __builtin_amdgcn_permlane32_swap(__float_as_uint(x), __float_as_uint(x), false, false); return __uint_as_float(q[0]) + __uint_as_float(q[1]);
}
__device__ __forceinline__ float quad_sum(float x) {
    x += __builtin_bit_cast(float, __builtin_amdgcn_mov_dpp(__builtin_bit_cast(int, x), 0xB1, 0xF, 0xF, true));
    x += __builtin_bit_cast(float, __builtin_amdgcn_mov_dpp(__builtin_bit_cast(int, x), 0x4E, 0xF, 0xF, true));
    return x;
}
struct TileAddr { int kofs[2]; int vofs[4]; };
__device__ __forceinline__ void tile_addr(TileAddr& T, int lane) {
    const int l15 = lane & 15, lq = lane >> 4, qp = l15 >> 2, p = l15 & 3, r7 = ((lq & 1) << 2) | qp;
#pragma unroll
    for (int ks = 0; ks < 2; ++ks) T.kofs[ks] = l15 * 128 + (((ks * 4 + lq) ^ (l15 & 7)) << 4);
#pragma unroll
    for (int dt = 0; dt < 4; ++dt) T.vofs[dt] = (4 * lq + qp) * 128 + (((dt * 2 + (p >> 1)) ^ r7) << 4) + (p & 1) * 8;
}
template <int MODE>
__device__ __forceinline__ void wave_block2(const LAS unsigned char* kt, const LAS unsigned char* vt, const TileAddr& T, const bf16x8 (&qf)[2][2], AttState& st, const float (&bias)[2], const bool (&act)[2],
                                            bool boundary, const int (&lo)[2], const int (&hi)[2], int lane, LAS float* imp_row0, int imp_blk0, int imp_stride) {
    const int l15 = lane & 15, lq = lane >> 4;
    if (!act[0] && !act[1]) return;
    bf16x8 kf[4][2];
#pragma unroll
    for (int t = 0; t < 4; ++t)
#pragma unroll
        for (int ks = 0; ks < 2; ++ks) kf[t][ks] = *(const LAS bf16x8*)(kt + t * 2048 + T.kofs[ks]);
    f32x4 s[2][4];
#pragma unroll
    for (int c = 0; c < 2; ++c) { if (!act[c]) continue;
        const float c0 = MODE == 2 ? (bias[c] - st.m[c]) + st.l[c] : bias[c] - st.m[c];
#pragma unroll
        for (int t = 0; t < 4; ++t) { s[c][t] = (f32x4){c0, c0, c0, c0};
            s[c][t] = __builtin_amdgcn_mfma_f32_16x16x32_bf16(kf[t][0], qf[c][0], s[c][t], 0, 0, 0);
            s[c][t] = __builtin_amdgcn_mfma_f32_16x16x32_bf16(kf[t][1], qf[c][1], s[c][t], 0, 0, 0); } }
    bf16x8 vf[2][4];
    if (MODE != 1) {
#pragma unroll
        for (int G = 0; G < 2; ++G)
#pragma unroll
            for (int dt = 0; dt < 4; ++dt) { const s16x4 a = tr_read(vt + G * 4096 + T.vofs[dt]), b = tr_read(vt + G * 4096 + 2048 + T.vofs[dt]);
                vf[G][dt] = (bf16x8){a[0], a[1], a[2], a[3], b[0], b[1], b[2], b[3]}; }
    }
    bf16x8 pfr[2][2];
#pragma unroll
    for (int c = 0; c < 2; ++c) {
        if (!act[c]) continue;
        if (boundary) { const int l2 = lo[c] - 4 * lq, h2 = hi[c] - 4 * lq;
#pragma unroll
            for (int t = 0; t < 4; ++t)
#pragma unroll
                for (int r = 0; r < 4; ++r) { const int kk = t * 16 + r; if (kk < l2 || kk > h2) s[c][t][r] = S_NEG; } }
        float mx;
        asm("v_max3_f32 %0, %1, %2, %3\n\tv_max3_f32 %0, %0, %4, %5\n\tv_max3_f32 %0, %0, %6, %7\n\tv_max3_f32 %0, %0, %8, %9\n\tv_max3_f32 %0, %0, %10, %11\n\t"
            "v_max3_f32 %0, %0, %12, %13\n\tv_max3_f32 %0, %0, %14, %15\n\tv_max_f32_e32 %0, %0, %16"
            : "=&v"(mx) : "v"(s[c][0][0]), "v"(s[c][0][1]), "v"(s[c][0][2]), "v"(s[c][0][3]), "v"(s[c][1][0]), "v"(s[c][1][1]), "v"(s[c][1][2]), "v"(s[c][1][3]),
                          "v"(s[c][2][0]), "v"(s[c][2][1]), "v"(s[c][2][2]), "v"(s[c][2][3]), "v"(s[c][3][0]), "v"(s[c][3][1]), "v"(s[c][3][2]), "v"(s[c][3][3]));
        if (MODE != 0) mx = rowmax4(mx);
        if (MODE == 1) {
            if (__any(mx > RESC_THR)) { const float dl = fmaxf(mx, 0.f), f = __builtin_amdgcn_exp2f(-dl); st.m[c] += dl; st.l[c] *= f;
#pragma unroll
                for (int t = 0; t < 4; ++t) s[c][t] = s[c][t] - dl; }
            float a = 0.f;
#pragma unroll
            for (int t = 0; t < 4; ++t)
#pragma unroll
                for (int r = 0; r < 4; ++r) a += __builtin_amdgcn_exp2f(s[c][t][r]);
            st.l[c] += a;
            continue;
        }
        if (MODE == 0) {
            if (__any(mx > RESC_THR)) {
                mx = rowmax4(mx);
                const float dl = fmaxf(mx, 0.f), f = __builtin_amdgcn_exp2f(-dl); st.m[c] += dl;
#pragma unroll
                for (int t = 0; t < 4; ++t) s[c][t] = s[c][t] - dl;
#pragma unroll
                for (int r = 0; r < 4; ++r) { const float fr = __shfl(f, 4 * lq + r); st.lo[c][r] *= fr;
#pragma unroll
                    for (int dt = 0; dt < 4; ++dt) st.o[c][dt][r] *= fr; }
            }
        }
#pragma unroll
        for (int t = 0; t < 4; ++t)
#pragma unroll
            for (int r = 0; r < 4; ++r) s[c][t][r] = __builtin_amdgcn_exp2f(s[c][t][r]);
        if (MODE == 2) {
#pragma unroll
            for (int t = 0; t < 4; ++t) {
                float ia = 2.f * (s[c][t][0] + s[c][t][1] + s[c][t][2]) + s[c][t][3], ib = s[c][t][3];
                ia = quad_sum(ia); ib = quad_sum(ib);
                if ((l15 & 3) == 0) { LAS float* ir = imp_row0 + (c * 4 + (l15 >> 2)) * imp_stride + imp_blk0 + 4 * t + lq; atomicAdd((float*)ir, ia); atomicAdd((float*)(ir + 1), ib); } }
        }
#pragma unroll
        for (int G = 0; G < 2; ++G) {
            v4u pw; pw.x = pg8::cvt_pk_bf16(s[c][2 * G][0], s[c][2 * G][1]); pw.y = pg8::cvt_pk_bf16(s[c][2 * G][2], s[c][2 * G][3]); pw.z = pg8::cvt_pk_bf16(s[c][2 * G + 1][0], s[c][2 * G + 1][1]); pw.w = pg8::cvt_pk_bf16(s[c][2 * G + 1][2], s[c][2 * G + 1][3]);
            pfr[c][G] = __builtin_bit_cast(bf16x8, pw); }
    }
    if (MODE == 1) return;
#pragma unroll
    for (int G = 0; G < 2; ++G)
#pragma unroll
        for (int c = 0; c < 2; ++c) { if (!act[c]) continue;
#pragma unroll
            for (int dt = 0; dt < 4; ++dt) st.o[c][dt] = __builtin_amdgcn_mfma_f32_16x16x32_bf16(pfr[c][G], vf[G][dt], st.o[c][dt], 0, 0, 0);
            if (MODE == 0) { const v4u ow = (v4u){0x3f803f80u, 0x3f803f80u, 0x3f803f80u, 0x3f803f80u};
                st.lo[c] = __builtin_amdgcn_mfma_f32_16x16x32_bf16(pfr[c][G], __builtin_bit_cast(bf16x8, ow), st.lo[c], 0, 0, 0); } }
}
__device__ __forceinline__ void glds16(const void* gsrc, unsigned lds_dst) { unsigned keep;
    asm volatile("s_mov_b32 %0, m0\n\ts_mov_b32 m0, %2\n\ts_nop 0\n\tglobal_load_lds_dwordx4 %1, off\n\ts_mov_b32 m0, %0" : "=&s"(keep) : "v"(gsrc), "s"(lds_dst) : "memory"); }
__device__ __forceinline__ void p8_dma_group(const bf16* kbase, const bf16* vbase, size_t row_stride, int blk0, int nblk, LAS unsigned char* gb, int w, int lane) {
    asm volatile("" : "+v"(lane));
    const size_t loff = (size_t)(8 * w + (lane >> 3)) * row_stride + (((lane & 7) ^ (lane >> 3)) << 3);
#pragma unroll
    for (int i = 0; i < 4; ++i) { const int blk = blk0 + (i < nblk ? i : nblk - 1); const size_t boff = (size_t)blk * 64 * row_stride + loff;
        glds16(kbase + boff, (unsigned)__builtin_amdgcn_readfirstlane((unsigned)(uintptr_t)(gb + i * 16384 + w * 1024)));
        glds16(vbase + boff, (unsigned)__builtin_amdgcn_readfirstlane((unsigned)(uintptr_t)(gb + i * 16384 + 8192 + w * 1024))); }
}
#define P8_WAITV(n) asm volatile("s_waitcnt vmcnt(" #n ")" ::: "memory")
#define P8_BARRIER() do { asm volatile("s_waitcnt lgkmcnt(0)" ::: "memory"); __builtin_amdgcn_s_barrier(); asm volatile("" ::: "memory"); } while (0)

__device__ __forceinline__ void p8_prompt_unit(Frame& F, const Args& A, int b, int qb, int g) {
    unsigned char* ws = A.ws; const bf16* KVB = (const bf16*)(ws + WS_KVB); const bf16* QB = (const bf16*)(ws + WS_QB); const bf16* KCP = (const bf16*)(ws + WS_KCP);
    const float* GT = (const float*)(ws + WS_GT); bf16* O = (bf16*)(ws + WS_O);
    LAS unsigned char* L = F.lds + RING_OFF; LAS float* IMP = (LAS float*)(L + P8_IMP); LAS unsigned* SELB = (LAS unsigned*)(L + P8_SELB);
    const int lane = F.lane, w = F.wave, l15 = lane & 15, lq = lane >> 4;
    const size_t rowbase = (size_t)b * TP + (size_t)qb * 64;
    float* OTG = (float*)(ws + WS_OTG) + ((size_t)F.vcu * NWAVES + w) * 2048 + lane;
    TileAddr T; tile_addr(T, lane);
    bf16x8 qf[2][2];
#pragma unroll
    for (int c = 0; c < 2; ++c)
#pragma unroll
        for (int ks = 0; ks < 2; ++ks) qf[c][ks] = *(const GAS bf16x8*)(QB + (rowbase + 8 * w + 4 * c + (l15 >> 2)) * DM + g * 256 + (l15 & 3) * 64 + ks * 32 + lq * 8);
    int tl[2]; tl[0] = 8 * w + (l15 >> 2); tl[1] = tl[0] + 4;
    for (int i = lane; i < 8 * 132; i += 64) IMP[w * 8 * 132 + i] = 0.f;
    AttState st; const float zb[2] = {0.f, 0.f}; const bool on[2] = {true, true};
    auto combine = [&](int br) {
#pragma unroll
        for (int c = 0; c < 2; ++c) { float linv[4];
            if (br == 0) {
#pragma unroll
                for (int r = 0; r < 4; ++r) linv[r] = 1.f; }
            else {
#pragma unroll
                for (int r = 0; r < 4; ++r) linv[r] = 1.0f / fmaxf(st.lo[c][r], 1e-30f); }
#pragma unroll
            for (int r = 0; r < 4; ++r) { const float gt = GT[(rowbase + 8 * w + 4 * c + lq) * 48 + g * 12 + r * 3 + br] * linv[r];
#pragma unroll
                for (int d = 0; d < 4; ++d) { float* p = OTG + ((c * 4 + d) * 4 + r) * 64; const float v = gt * st.o[c][d][r];
                    if (br == 0) *p = v; else if (br == 1) *p += v;
                    else O[(rowbase + 8 * w + 4 * c + lq) * DM + g * 256 + r * 64 + d * 16 + l15] = (bf16)f2bf(*p + v); } } }
    };
    const int ncv = 4 * qb + 3, ncb = (ncv + 63) >> 6, ncg = (ncb + 3) >> 2;
    const bf16* kc0 = KCP + (size_t)b * 512 * 512 + g * 64;
    int clo[2] = {0, 0}, chi[2];
    att_init(st);
    const int imin = (qb * 64 - 31) >> 4;
    {
        { int ln = lane; asm volatile("" : "+v"(ln)); const size_t loff = (size_t)(8 * w + (ln >> 3)) * 512 + (((ln & 7) ^ (ln >> 3)) << 3);
          for (int i = 0; i < ncb; ++i) glds16(kc0 + (size_t)i * 64 * 512 + loff, (unsigned)__builtin_amdgcn_readfirstlane((unsigned)(uintptr_t)(L + i * 8192 + w * 1024))); }
        P8_WAITV(0); P8_BARRIER();
        for (int blk = 0; blk < ncb; ++blk) {
#pragma unroll
            for (int c = 0; c < 2; ++c) chi[c] = ((qb * 64 + tl[c] - 31) >> 4) - 64 * blk;
            wave_block2<1>(L + blk * 8192, L, T, qf, st, zb, on, 64 * blk + 63 > imin, clo, chi, lane, nullptr, 0, 0); }
        P8_BARRIER();
    }
#pragma unroll
    for (int c = 0; c < 2; ++c) st.l[c] = -__builtin_amdgcn_logf(fmaxf(rowsum4(st.l[c]), 1e-30f));
    for (int gi = 0; gi < ncg; ++gi) {
        const int nb = ncb - 4 * gi < 4 ? ncb - 4 * gi : 4;
        p8_dma_group(kc0, kc0 + 256, 512, 4 * gi, nb, L, w, lane);
        P8_WAITV(0); P8_BARRIER();
        for (int i = 0; i < nb; ++i) { const int blk = 4 * gi + i;
#pragma unroll
            for (int c = 0; c < 2; ++c) chi[c] = ((qb * 64 + tl[c] - 31) >> 4) - 64 * blk;
            wave_block2<2>(L + i * 16384, L + i * 16384 + 8192, T, qf, st, zb, on, 64 * blk + 63 > imin, clo, chi, lane, IMP + w * 8 * 132, blk * 16, 132); }
        P8_BARRIER();
    }
    combine(0);
    LDS_WAIT();
    for (int h4 = 0; h4 < 2; ++h4) { float v0[4], v1[4]; unsigned long long s0[4], s1[4];
#pragma unroll
        for (int t = 0; t < 4; ++t) { const LAS float* ir = IMP + (w * 8 + h4 * 4 + t) * 132; v0[t] = ir[lane]; v1[t] = ir[lane + 64]; }
        select_blocks4(v0, v1, qb, lane, s0, s1);
#pragma unroll
        for (int t = 0; t < 4; ++t) if (lane == 0) { LAS unsigned* sb = SELB + (w * 8 + h4 * 4 + t) * 4; sb[0] = (unsigned)s0[t]; sb[1] = (unsigned)(s0[t] >> 32); sb[2] = (unsigned)s1[t]; sb[3] = (unsigned)(s1[t] >> 32); } }
    LDS_WAIT();
    unsigned mysel[2][4], usel[2][4];
#pragma unroll
    for (int c = 0; c < 2; ++c)
#pragma unroll
        for (int i = 0; i < 4; ++i) { mysel[c][i] = SELB[tl[c] * 4 + i];
            usel[c][i] = __builtin_amdgcn_readfirstlane(SELB[(8 * w + 4 * c + 0) * 4 + i] | SELB[(8 * w + 4 * c + 1) * 4 + i] | SELB[(8 * w + 4 * c + 2) * 4 + i] | SELB[(8 * w + 4 * c + 3) * 4 + i]); }
    P8_BARRIER();
    {
        att_init(st);
        const bf16* k0 = KVB + (size_t)b * TP * NKV + 512 + g * 64; int lo2[2] = {0, 0}, hi2[2] = {tl[0], tl[1]};
        const int nblk = qb + 1, ng = (nblk + 3) >> 2;
        p8_dma_group(k0, k0 + 256, NKV, 0, nblk < 4 ? nblk : 4, L, w, lane);
        for (int gi = 0; gi < ng; ++gi) {
            LAS unsigned char* gb = L + (gi & 1) * P8_GB;
            if (gi + 1 < ng) { const int n2 = nblk - 4 * (gi + 1); p8_dma_group(k0, k0 + 256, NKV, 4 * (gi + 1), n2 < 4 ? n2 : 4, L + ((gi + 1) & 1) * P8_GB, w, lane); P8_WAITV(8); }
            else P8_WAITV(0);
            P8_BARRIER();
            const int nb = nblk - 4 * gi < 4 ? nblk - 4 * gi : 4;
            for (int i = 0; i < nb; ++i) { const int jb = 4 * gi + i; float bias[2]; bool act[2];
#pragma unroll
                for (int c = 0; c < 2; ++c) { bias[c] = ((pick4(mysel[c], jb >> 5) >> (jb & 31)) & 1u) ? 0.f : S_NEG; act[c] = ((pick4(usel[c], jb >> 5) >> (jb & 31)) & 1u) != 0u; }
                wave_block2<0>(gb + i * 16384, gb + i * 16384 + 8192, T, qf, st, bias, act, jb == qb, lo2, hi2, lane, nullptr, 0, 0); }
            P8_BARRIER();
        }
        combine(1);
    }
    {
        att_init(st);
        const int jb0 = qb >= 8 ? qb - 8 : 0, nblk = qb - jb0 + 1, ng = (nblk + 3) >> 2;
        const bf16* k0 = KVB + ((size_t)b * TP + (size_t)jb0 * 64) * NKV + 1024 + g * 64;
        p8_dma_group(k0, k0 + 256, NKV, 0, nblk < 4 ? nblk : 4, L, w, lane);
        for (int gi = 0; gi < ng; ++gi) {
            LAS unsigned char* gb = L + (gi & 1) * P8_GB;
            if (gi + 1 < ng) { const int n2 = nblk - 4 * (gi + 1); p8_dma_group(k0, k0 + 256, NKV, 4 * (gi + 1), n2 < 4 ? n2 : 4, L + ((gi + 1) & 1) * P8_GB, w, lane); P8_WAITV(8); }
            else P8_WAITV(0);
            P8_BARRIER();
            const int nb = nblk - 4 * gi < 4 ? nblk - 4 * gi : 4;
            for (int i = 0; i < nb; ++i) { const int jb = jb0 + 4 * gi + i; int lo2[2], hi2[2]; const bool low = (qb >= 8 && jb == qb - 8), top = (jb == qb);
#pragma unroll
                for (int c = 0; c < 2; ++c) { lo2[c] = low ? tl[c] : 0; hi2[c] = top ? tl[c] : 63; }
                wave_block2<0>(gb + i * 16384, gb + i * 16384 + 8192, T, qf, st, zb, on, low || top, lo2, hi2, lane, nullptr, 0, 0); }
            P8_BARRIER();
        }
        combine(2);
    }
}
constexpr int P8S_WAVE = 11008, P8S_KT = 0, P8S_VT = 32 * KT_STRIDE, P8S_IMP = P8S_VT + 32 * VT_STRIDE, P8S_OL = 8 * P8S_WAVE, P8S_ML = P8S_OL + 8 * 8192, P8S_END = P8S_ML + 8 * 256;
static_assert(P8S_IMP + 8 * 40 * 4 <= P8S_WAVE && P8S_END <= RING_BYTES, "sample attention LDS");
struct P8sRegs { f32x4 k[8], v[8]; };
__device__ __forceinline__ void p8s_load_f32(P8sRegs& R, const float* kp, const float* vp, int lane) {
    asm volatile("" : "+v"(lane)); const int r0 = lane >> 4, ch = lane & 15;
#pragma unroll
    for (int i = 0; i < 8; ++i) { R.k[i] = *(const GAS f32x4*)(kp + (size_t)(4 * i + r0) * 512 + ch * 4); R.v[i] = *(const GAS f32x4*)(vp + (size_t)(4 * i + r0) * 512 + ch * 4); }
}
__device__ __forceinline__ void p8s_store_f32(const P8sRegs& R, LAS unsigned char* kt, LAS unsigned char* vt, int lane) {
    asm volatile("" : "+v"(lane)); const int r0 = lane >> 4, ch = lane & 15;
#pragma unroll
    for (int i = 0; i < 8; ++i) { v2u a, b; a.x = pg8::cvt_pk_bf16(R.k[i][0], R.k[i][1]); a.y = pg8::cvt_pk_bf16(R.k[i][2], R.k[i][3]); b.x = pg8::cvt_pk_bf16(R.v[i][0], R.v[i][1]); b.y = pg8::cvt_pk_bf16(R.v[i][2], R.v[i][3]);
        *(LAS v2u*)(kt + (4 * i + r0) * KT_STRIDE + ch * 8) = a; *(LAS v2u*)(vt + (4 * i + r0) * VT_STRIDE + ch * 8) = b; }
}
__device__ __forceinline__ void p8s_stage_bf16(const bf16* kp, const bf16* vp, size_t stride, int nrows, LAS unsigned char* kt, LAS unsigned char* vt, int lane) {
    asm volatile("" : "+v"(lane));
    v4u rk[4], rv[4]; const int r0 = lane >> 3, ch = lane & 7;
#pragma unroll
    for (int i = 0; i < 4; ++i) { const int row = 8 * i + r0; rk[i] = (v4u){0u, 0u, 0u, 0u}; rv[i] = rk[i];
        if (row < nrows) { rk[i] = *(const GAS v4u*)(kp + (size_t)row * stride + ch * 8); rv[i] = *(const GAS v4u*)(vp + (size_t)row * stride + ch * 8); } }
#pragma unroll
    for (int i = 0; i < 4; ++i) { const int row = 8 * i + r0; *(LAS v4u*)(kt + row * KT_STRIDE + ch * 16) = rk[i]; *(LAS v4u*)(vt + row * VT_STRIDE + ch * 16) = rv[i]; }
}
__device__ __forceinline__ void p8_sample_pair(Frame& F, const Args& A, int u, bool valid) {
    unsigned char* ws = A.ws; const bf16* KVB = (const bf16*)(ws + WS_KVB); const bf16* QB = (const bf16*)(ws + WS_QB); const bf16* KCS = (const bf16*)(ws + WS_KCS);
    const float* GT = (const float*)(ws + WS_GT); bf16* O = (bf16*)(ws + WS_O); const int* ptab = (const int*)A.in[I_PT];
    const int n = u >> 2, g = u & 3, sp = F.wave & 3, q0 = F.wave & 4;
    LAS unsigned char* L = F.lds + RING_OFF + F.wave * P8S_WAVE; LAS unsigned char* kt = L + P8S_KT; LAS unsigned char* vt = L + P8S_VT; LAS float* IMP = (LAS float*)(L + P8S_IMP);
    LAS float* OL = (LAS float*)(F.lds + RING_OFF + P8S_OL); LAS float* ML = (LAS float*)(F.lds + RING_OFF + P8S_ML);
    const int lane = F.lane, l15 = lane & 15, lq = lane >> 4;
    const size_t rowbase = (size_t)MP + (size_t)n * TS;
    bf16x8 qf[2][2];
#pragma unroll
    for (int c = 0; c < 2; ++c)
#pragma unroll
        for (int ks = 0; ks < 2; ++ks) qf[c][ks] = *(const GAS bf16x8*)(QB + (rowbase + 4 * c + (l15 >> 2)) * DM + g * 256 + (l15 & 3) * 64 + ks * 32 + lq * 8);
    int tl[2]; tl[0] = l15 >> 2; tl[1] = tl[0] + 4;
    for (int i = lane; i < 8 * 40; i += 64) IMP[i] = 0.f;
    AttState st; const float zb[2] = {0.f, 0.f}; const bool on[2] = {true, true};
    f32x4 fin[2];
    auto publish = [&]() {
#pragma unroll
        for (int c = 0; c < 2; ++c) { float l = st.l[c]; l += __shfl_xor(l, 16); l += __shfl_xor(l, 32);
            if (lq == 0) { ML[((F.wave * 2 + c) * 16 + l15) * 2] = st.m[c]; ML[((F.wave * 2 + c) * 16 + l15) * 2 + 1] = l; }
#pragma unroll
            for (int d = 0; d < 4; ++d)
#pragma unroll
                for (int r = 0; r < 4; ++r) OL[(F.wave * 32 + (c * 4 + d) * 4 + r) * 64 + lane] = st.o[c][d][r]; }
    };
    auto merge = [&](int br) {
#pragma unroll
        for (int k = 0; k < 2; ++k) { const int p = 2 * sp + k, c = p >> 2, d = p & 3;
#pragma unroll
            for (int r = 0; r < 4; ++r) { const int qrow = 4 * lq + r; float mi[4], li[4], M = -3.0e38f;
#pragma unroll
                for (int i = 0; i < 4; ++i) { mi[i] = ML[(((q0 + i) * 2 + c) * 16 + qrow) * 2]; li[i] = ML[(((q0 + i) * 2 + c) * 16 + qrow) * 2 + 1]; M = fmaxf(M, mi[i]); }
                float Ls = 0.f, Os = 0.f;
#pragma unroll
                for (int i = 0; i < 4; ++i) { const float wgt = __builtin_amdgcn_exp2f(mi[i] - M); Ls += wgt * li[i]; Os += wgt * OL[((q0 + i) * 32 + (c * 4 + d) * 4 + r) * 64 + lane]; }
                const float gt = GT[(rowbase + 4 * c + lq) * 48 + g * 12 + r * 3 + br];
                fin[k][r] += gt * Os / fmaxf(Ls, 1e-30f); } }
    };
#define WSYNC() do { LDS_WAIT(); asm volatile("" ::: "memory"); } while (0)
    if (valid) {
    const bf16* kc0 = KCS + (size_t)n * 128 * 512 + g * 64;
    int clo[2] = {0, 0}, chi[2];
    att_init(st);
    for (int pass = 0; pass < 2; ++pass) {
        if (pass == 1) {
#pragma unroll
            for (int c = 0; c < 2; ++c) { float l = st.l[c]; l += __shfl_xor(l, 16); l += __shfl_xor(l, 32); st.l[c] = 1.0f / fmaxf(l, 1e-30f); } }
        for (int hb = 0; hb < 4; ++hb) {
            WSYNC(); p8s_stage_bf16(kc0 + (size_t)hb * 32 * 512, kc0 + (size_t)hb * 32 * 512 + 256, 512, 32, kt, vt, lane); WSYNC();
            chi[0] = 126 - 32 * hb; chi[1] = chi[0];
            if (pass == 0) wave_block<2, 1>(kt, vt, qf, st, zb, on, hb == 3, clo, chi, lane, nullptr, 0, 0);
            else           wave_block<2, 2>(kt, vt, qf, st, zb, on, hb == 3, clo, chi, lane, IMP, hb * 8, 40);
        }
    }
#pragma unroll
    for (int c = 0; c < 2; ++c)
#pragma unroll
        for (int d = 0; d < 4; ++d)
#pragma unroll
            for (int r = 0; r < 4; ++r) OL[(F.wave * 32 + (c * 4 + d) * 4 + r) * 64 + lane] = st.o[c][d][r];
    WSYNC();
#pragma unroll
    for (int k = 0; k < 2; ++k) { const int p = 2 * sp + k, c = p >> 2, d = p & 3;
#pragma unroll
        for (int r = 0; r < 4; ++r) fin[k][r] = GT[(rowbase + 4 * c + lq) * 48 + g * 12 + r * 3 + 0] * OL[(F.wave * 32 + (c * 4 + d) * 4 + r) * 64 + lane]; }
    }
    unsigned mysel[2][2] = {{0u, 0u}, {0u, 0u}};
    if (valid) {
    WSYNC();
    unsigned selw[8][2];
#pragma unroll
    for (int t8 = 0; t8 < 8; ++t8) { unsigned long long s0, s1; const float v0 = lane < 33 ? IMP[t8 * 40 + lane] : 0.f; select_blocks(v0, 0.f, 32, lane, s0, s1); selw[t8][0] = (unsigned)s0; selw[t8][1] = (unsigned)(s0 >> 32); }
#pragma unroll
    for (int c = 0; c < 2; ++c)
#pragma unroll
        for (int i = 0; i < 2; ++i) { const int tt = l15 >> 2; const unsigned a0 = selw[4 * c + 0][i], a1 = selw[4 * c + 1][i], a2 = selw[4 * c + 2][i], a3 = selw[4 * c + 3][i];
            mysel[c][i] = tt == 0 ? a0 : tt == 1 ? a1 : tt == 2 ? a2 : a3; }
    }
    __syncthreads();
    if (valid) {
        att_init(st);
        const float* cache = A.in[I_CSLC]; int lo2[2] = {0, 0}, hi2[2] = {tl[0], tl[1]};
        P8sRegs R;
        { const int pg = ptab[n * NPAGE + (sp >> 2)]; const float* kp = cache + ((size_t)pg * PAGE + (sp & 3) * 32) * 512 + g * 64; p8s_load_f32(R, kp, kp + 256, lane); }
        for (int hb = sp; hb < 64; hb += 4) {
            WSYNC(); p8s_store_f32(R, kt, vt, lane);
            if (hb + 4 < 64) { const int h2 = hb + 4, pg = ptab[n * NPAGE + (h2 >> 2)]; const float* kp = cache + ((size_t)pg * PAGE + (h2 & 3) * 32) * 512 + g * 64; p8s_load_f32(R, kp, kp + 256, lane); }
            WSYNC();
            const int jb = hb >> 1; float bias[2];
#pragma unroll
            for (int c = 0; c < 2; ++c) bias[c] = (((jb < 32 ? mysel[c][0] : mysel[c][1]) >> (jb & 31)) & 1u) ? 0.f : S_NEG;
            wave_block<2, 0>(kt, vt, qf, st, bias, on, false, lo2, hi2, lane, nullptr, 0, 0);
        }
        if (sp == 0) {
            WSYNC(); { const bf16* kp = KVB + rowbase * NKV + 512 + g * 64; p8s_stage_bf16(kp, kp + 256, NKV, 8, kt, vt, lane); } WSYNC();
            wave_block<2, 0>(kt, vt, qf, st, zb, on, true, lo2, hi2, lane, nullptr, 0, 0);
        }
        publish();
    }
    __syncthreads();
    if (valid) merge(1);
    __syncthreads();
    if (valid) {
        att_init(st);
        const float* sw = A.in[I_SWIN] + (size_t)n * 512 * 512 + g * 64;
        P8sRegs R;
        p8s_load_f32(R, sw + (size_t)sp * 32 * 512, sw + (size_t)sp * 32 * 512 + 256, lane);
        for (int hb = sp; hb < 16; hb += 4) {
            WSYNC(); p8s_store_f32(R, kt, vt, lane);
            if (hb + 4 < 16) p8s_load_f32(R, sw + (size_t)(hb + 4) * 32 * 512, sw + (size_t)(hb + 4) * 32 * 512 + 256, lane);
            WSYNC();
            int lo2[2], hi2[2];
#pragma unroll
            for (int c = 0; c < 2; ++c) { lo2[c] = tl[c] - 32 * hb; hi2[c] = 512 + tl[c] - 32 * hb; }
            wave_block<2, 0>(kt, vt, qf, st, zb, on, hb == 0, lo2, hi2, lane, nullptr, 0, 0);
        }
        if (sp == 0) {
            WSYNC(); { const bf16* kp = KVB + rowbase * NKV + 1024 + g * 64; p8s_stage_bf16(kp, kp + 256, NKV, 8, kt, vt, lane); } WSYNC();
            int lo2[2], hi2[2];
#pragma unroll
            for (int c = 0; c < 2; ++c) { lo2[c] = tl[c] - 512; hi2[c] = tl[c]; }
            wave_block<2, 0>(kt, vt, qf, st, zb, on, true, lo2, hi2, lane, nullptr, 0, 0);
        }
        publish();
    }
    __syncthreads();
    if (valid) { merge(2);
#pragma unroll
        for (int k = 0; k < 2; ++k) { const int p = 2 * sp + k, c = p >> 2, d = p & 3;
#pragma unroll
            for (int r = 0; r < 4; ++r) O[(rowbase + 4 * c + lq) * DM + g * 256 + r * 64 + d * 16 + l15] = (bf16)f2bf(fin[k][r]); } }
    __syncthreads();
#undef WSYNC
}
__device__ __forceinline__ void p8_attention(Frame& F, const Args& A) {
    for (int ub = 2 * F.vcu; ub < NBS * 4; ub += 2 * F.G) { const int u = ub + (F.wave >> 2); p8_sample_pair(F, A, u < NBS * 4 ? u : 0, u < NBS * 4); }
    __syncthreads();
    unsigned tk = 0u;
    if (F.tid == 0) tk = __hip_atomic_fetch_add((unsigned*)(F.ctl + CW_Q8), 1u, __ATOMIC_RELAXED, __HIP_MEMORY_SCOPE_AGENT);
    for (;;) {
        if (F.tid == 0) F.MISC[16] = tk;
        __syncthreads();
        const int u = (int)F.MISC[16];
        __syncthreads();
        if (u >= NBP * 128 * 4) break;
        if (F.tid == 0) tk = __hip_atomic_fetch_add((unsigned*)(F.ctl + CW_Q8), 1u, __ATOMIC_RELAXED, __HIP_MEMORY_SCOPE_AGENT);
        const int qb = 127 - (u >> 3), b = (u >> 2) & 1, g = u & 3; p8_prompt_unit(F, A, b, qb, g);
    }
}
constexpr int N_PHASES = 15;
__global__ void __launch_bounds__(NWAVES * 64, 2) yoco_fwd(Args args) {
    extern __shared__ __attribute__((aligned(16))) unsigned char lds[];
    Frame F;
    F.lds = (LAS unsigned char*)lds; F.MISC = (volatile LAS unsigned*)(F.lds + MISC_OFF);
    F.tid = threadIdx.x; F.lane = F.tid & 63; F.wave = __builtin_amdgcn_readfirstlane(F.tid >> 6);
    F.G = gridDim.x; { const int bx = blockIdx.x; F.vcu = (F.G % 8 == 0) ? (bx % 8) * (F.G / 8) + bx / 8 : bx; }
    unsigned char* ws = args.ws;
    F.ctl = (gu32*)(ws + WS_CTL);
    for (int u = F.tid; u < (LDS_BYTES - LDSCTL_OFF) / 4; u += NWAVES * 64) ((LAS unsigned*)(F.lds + LDSCTL_OFF))[u] = 0u;
    __syncthreads();
    const int lo = args.ph_lo, hi = args.ph_hi;
    const bool multi = (hi - lo) > 1;
    XcdBarrier bar; bar.bar = (unsigned*)(F.ctl + CW_BAR); bar.x = 0; bar.st = nullptr;
    if (multi) bar = xcd_barrier_post((unsigned*)(F.ctl + CW_BAR), F.MISC + 8);
#define IN(k) (lo <= (k) && (k) < hi)
#define SEAM(k) do { if (IN(k) && IN((k) + 1)) xcd_barrier(bar); } while (0)
    bf16* const XB = (bf16*)(ws + WS_XB); bf16* const BBp = (bf16*)(ws + WS_BB); bf16* const VBp = (bf16*)(ws + WS_VB); bf16* const Zp = (bf16*)(ws + WS_Z);
    float* const Hp = (float*)(ws + WS_H); bf16* const HBp = (bf16*)(ws + WS_HB); bf16* const ACTp = (bf16*)(ws + WS_ACT); bf16* const KVBp = (bf16*)(ws + WS_KVB);
    bf16* const QBp = (bf16*)(ws + WS_QB); bf16* const Op = (bf16*)(ws + WS_O); float* const GTp = (float*)(ws + WS_GT);
    float* const SSQ = (float*)(ws + WS_SSQ); constexpr size_t SSQ_STRIDE = (size_t)MT * 16;
    const int c = (int)blockIdx.x;

    const bf16* const WAIN = (const bf16*)(ws + WS_WAIN); const bf16* const WAOUT = (const bf16*)(ws + WS_WAOUT); const bf16* const WKVQ = (const bf16*)(ws + WS_WKVQ); const bf16* const WBOUT = (const bf16*)(ws + WS_WBOUT);
    float* const SSQ0 = SSQ, * const SSQ1 = SSQ + SSQ_STRIDE, * const SSQ2 = SSQ + 2 * SSQ_STRIDE;
#define GEMM(EPI, E, SCH, S, Ap, Wp, N_, K_) pg8::gemm_phase<pg8::EPI, pg8::SCH, PG8_ALIGN, PG8_SP2>(F.lds + RING_OFF, pg8::Gemm{Ap, Wp, MT, N_, K_}, S, E)
    if (IN(0)) { p0_prologue(F, args, 0, 0, F.G); }
    SEAM(0);
    if (IN(1)) { pg8::StaticOrder S; S.init(MP, NAIN, F.G, c); pg8::EpiAin E{VBp, BBp, (const float*)(ws + WS_RSTD0)}; GEMM(EpiAin, E, StaticOrder, S, XB, WAIN, NAIN, DM); }
    SEAM(1);
    if (IN(2)) { if (c < 48) { pg8::SubOrder S; S.init(64, 4, 12, 48, c); pg8::EpiAin E{VBp, BBp, (const float*)(ws + WS_RSTD0)}; GEMM(EpiAin, E, SubOrder, S, XB, WAIN, NAIN, DM); }
                 else p2_conv(F, args, 0, MP, 48, F.G - 48); }
    SEAM(2);
    if (IN(3)) { { pg8::StaticOrder S; S.init(MP, DM, F.G, c); pg8::EpiRes E{XB, HBp, SSQ0}; GEMM(EpiRes, E, StaticOrder, S, Zp, WAOUT, DM, DM); }
                 p2_conv(F, args, MP, MT, 0, F.G); }
    SEAM(3);
    if (IN(4)) { if (c >= 240) { pg8::SubOrder S; S.init(64, 4, 4, 16, c - 240); pg8::EpiRes E{XB, HBp, SSQ0}; GEMM(EpiRes, E, SubOrder, S, Zp, WAOUT, DM, DM); }
                 { pg8::StaticOrder S; S.init(MP, NFF, F.G, c); pg8::EpiFfn E{ACTp, SSQ0}; GEMM(EpiFfn, E, StaticOrder, S, HBp, (const bf16*)(ws + WS_WFIN0), NFF, DM); } }
    SEAM(4);
    if (IN(5)) { { pg8::StaticOrder S; S.init(MP, DM, F.G, c); pg8::EpiRes E{HBp, HBp, SSQ1}; GEMM(EpiRes, E, StaticOrder, S, ACTp, (const bf16*)(ws + WS_WFOUT0), DM, DFF); }
                 if (c < 88) { pg8::SubOrder S; S.init(64, 4, 22, 88, c); pg8::EpiFfn E{ACTp, SSQ0}; GEMM(EpiFfn, E, SubOrder, S, HBp, (const bf16*)(ws + WS_WFIN0), NFF, DM); }
                 else p0_prologue(F, args, 1, 88, F.G - 88); }
    SEAM(5);
    if (IN(6)) { pg8::EpiKvq EK{KVBp, QBp, GTp, SSQ1, args.out + O_CMPP, args.out + O_CMPS, args.out + O_SLCP, args.out + O_SLCS, args.out + O_WINP, args.out + O_WINS};
                 if (c >= 240) { pg8::SubOrder S; S.init(64, 4, 4, 16, c - 240); pg8::EpiRes E{HBp, HBp, SSQ1}; GEMM(EpiRes, E, SubOrder, S, ACTp, (const bf16*)(ws + WS_WFOUT0), DM, DFF); }
                 else { pg8::StaticOrder S; S.init(MP, NKVQ, 240, c); GEMM(EpiKvq, EK, StaticOrder, S, HBp, WKVQ, NKVQ, DM); } }
    SEAM(6);
    if (IN(7)) { if (c < 44) { pg8::SubOrder S; S.init(64, 4, 11, 44, c); pg8::EpiKvq EK{KVBp, QBp, GTp, SSQ1, args.out + O_CMPP, args.out + O_CMPS, args.out + O_SLCP, args.out + O_SLCS, args.out + O_WINP, args.out + O_WINS};
                     GEMM(EpiKvq, EK, SubOrder, S, HBp, WKVQ, NKVQ, DM); }
                 p7_compress(F, args, 0, 1); p7_compress(F, args, 1, 4096); }
    SEAM(7);
    if (IN(9)) { p8_attention(F, args); }
    SEAM(9);
    if (IN(10)) { pg8::StaticOrder S; S.init(MP, DM, F.G, c); pg8::EpiRes E{HBp, HBp, SSQ2}; GEMM(EpiRes, E, StaticOrder, S, Op, WBOUT, DM, DM); }
    SEAM(10);
    if (IN(11)) { if (c >= 240) { pg8::SubOrder S; S.init(64, 4, 4, 16, c - 240); pg8::EpiRes E{HBp, HBp, SSQ2}; GEMM(EpiRes, E, SubOrder, S, Op, WBOUT, DM, DM); }
                  { pg8::StaticOrder S; S.init(MP, NFF, F.G, c); pg8::EpiFfn E{ACTp, SSQ2}; GEMM(EpiFfn, E, StaticOrder, S, HBp, (const bf16*)(ws + WS_WFIN1), NFF, DM); } }
    SEAM(11);
    if (IN(12)) { { pg8::StaticOrder S; S.init(MP, DM, F.G, c); pg8::EpiRes E{HBp, HBp, nullptr}; GEMM(EpiRes, E, StaticOrder, S, ACTp, (const bf16*)(ws + WS_WFOUT1), DM, DFF); }
                  if (c < 88) { pg8::SubOrder S; S.init(64, 4, 22, 88, c); pg8::EpiFfn E{ACTp, SSQ2}; GEMM(EpiFfn, E, SubOrder, S, HBp, (const bf16*)(ws + WS_WFIN1), NFF, DM); } }
    SEAM(12);
    if (IN(13)) { if (c >= 240) { pg8::SubOrder S; S.init(64, 4, 4, 16, c - 240); pg8::EpiRes E{HBp, HBp, nullptr}; GEMM(EpiRes, E, SubOrder, S, ACTp, (const bf16*)(ws + WS_WFOUT1), DM, DFF); }
                  else { p_final(F, args, 0, MP, 0, 240); p_wincopy(F, args, 0, 240); } }
    SEAM(13);
    if (IN(14)) { p_final(F, args, MP, MT, 0, F.G); }
#undef GEMM
#undef IN
#undef SEAM
}

#ifndef MK_PER_PHASE
#define MK_PER_PHASE 0
#endif
extern "C" void kernel_launch(void* const* d_in, const int* in_sizes, int n_in, void* d_out, int out_size, void* d_ws, size_t ws_size, hipStream_t stream) {
    static int grid = 0;
    if (grid == 0) {
        if (n_in != 21 || out_size != (int)O_END || ws_size < WS_END) { fprintf(stderr, "kernel_launch: unexpected shapes (n_in %d out %d ws %zu)\n", n_in, out_size, ws_size); grid = -1; return; }
        int dev = 0, cus = 0, per_cu = 0;
        if (hipGetDevice(&dev) != hipSuccess || hipDeviceGetAttribute(&cus, hipDeviceAttributeMultiprocessorCount, dev) != hipSuccess) { grid = -1; return; }
        if (hipFuncSetAttribute((const void*)yoco_fwd, hipFuncAttributeMaxDynamicSharedMemorySize, LDS_BYTES) != hipSuccess) { fprintf(stderr, "kernel_launch: hipFuncSetAttribute failed\n"); grid = -1; return; }
        if (hipOccupancyMaxActiveBlocksPerMultiprocessor(&per_cu, (const void*)yoco_fwd, NWAVES * 64, LDS_BYTES) != hipSuccess || per_cu < 1) { fprintf(stderr, "kernel_launch: occupancy query says %d\n", per_cu); }
        (void)hipGetLastError();
        grid = cus;
    }
    if (grid < 0) return;
    if (hipMemsetAsync((char*)d_ws + WS_CTL, 0, CTL_ZERO_BYTES, stream) != hipSuccess) return;
    Args a{};
    for (int i = 0; i < 21; ++i) a.in[i] = (const float*)d_in[i];
    a.out = (float*)d_out; a.ws = (unsigned char*)d_ws;
#if MK_PER_PHASE
    for (int p = 0; p < N_PHASES; ++p) { a.ph_lo = p; a.ph_hi = p + 1; hipLaunchKernelGGL(yoco_fwd, dim3(grid), dim3(NWAVES * 64), LDS_BYTES, stream, a); }
#else
    a.ph_lo = 0; a.ph_hi = N_PHASES; hipLaunchKernelGGL(yoco_fwd, dim3(grid), dim3(NWAVES * 64), LDS_BYTES, stream, a);
#endif
}
```
